# Optimizing an MI355X kernel written in HIP

```python
import math
import jax, jax.numpy as jnp
from jax import lax
import numpy as np


D_MODEL = 1024
BATCH = 2
SEQ = 8192
DEPTH = 1

CHUNK = 64
N_META = 16
Q_BLOCK = 128
LEAD = Q_BLOCK * ((N_META + Q_BLOCK - 1) // Q_BLOCK)
PAD = LEAD - N_META

MIX = D_MODEL
D_MLSTM = MIX // 2
D_SB = MIX - D_MLSTM
MLSTM_HEADS = 4
MLSTM_DH = D_MLSTM // MLSTM_HEADS
SB_HEADS = 8
SB_DH = D_SB // SB_HEADS
CONV_W = 4
FORGET_BIAS_LO = 3.0
FORGET_BIAS_HI = 6.0

PEER_HEADS = 8
N_KEYS = 128
N_EXPERTS = N_KEYS * N_KEYS
PEER_TOPK = 16
PEER_QDIM = 256
PEER_HALF = PEER_QDIM // 2
TOK_BLOCK = 128

EPS = 1e-6
D_IN_PROJ = 3 * D_MLSTM + 2 * MLSTM_HEADS + 3 * D_SB

kernel_name = 'hybrid_mlstm_stickbreak_peer'


def _split_points():
    sizes = (D_MLSTM, D_MLSTM, D_MLSTM, MLSTM_HEADS, MLSTM_HEADS, D_SB, D_SB, D_SB)
    return [int(s) for s in np.cumsum(sizes)[:-1]]


def rmsnorm(x, g):
    xf = x.astype(jnp.float32)
    y = xf * lax.rsqrt(jnp.mean(xf * xf, axis=-1, keepdims=True) + EPS)
    return (y * g.astype(jnp.float32)).astype(x.dtype)


def mlstm_mixer(u, v, o_pre, i_pre, f_pre, conv_w, conv_b, w_q, w_k, b_i, b_f, skip, gn_g, valid):
    B, L, _ = u.shape
    H, dh = MLSTM_HEADS, MLSTM_DH
    f32 = jnp.float32
    u = jnp.where(valid[None, :, None], u, jnp.zeros_like(u))
    c = lax.conv_general_dilated(u, conv_w[:, None, :].astype(u.dtype), window_strides=(1,),
                                 padding=[(CONV_W - 1, 0)], dimension_numbers=('NWC', 'WIO', 'NWC'),
                                 feature_group_count=D_MLSTM) + conv_b
    c = jax.nn.silu(c)
    ch = c.reshape(B, L, H, dh)
    q = jnp.einsum('blhd,hde->blhe', ch, w_q).astype(f32)
    k = (jnp.einsum('blhd,hde->blhe', ch, w_k) * (dh ** -0.5)).astype(f32)
    vv = v.reshape(B, L, H, dh).astype(f32)
    vmask = valid[None, :, None]
    logi = jnp.where(vmask, (i_pre + b_i).astype(f32), -jnp.inf)
    logf = jnp.where(vmask, jax.nn.log_sigmoid((f_pre + b_f).astype(f32)), 0.0)

    NC = L // CHUNK
    def chunk_vec(t):
        return t.reshape(B, NC, CHUNK, H, dh).transpose(1, 0, 3, 2, 4)
    def chunk_gate(t):
        return t.reshape(B, NC, CHUNK, H).transpose(1, 0, 3, 2)
    tril = jnp.tril(jnp.ones((CHUNK, CHUNK), dtype=bool))

    def step(carry, xs):
        C, n, m = carry
        qc, kc, vc, li, lf = xs
        b = jnp.cumsum(lf, axis=-1)
        D = b[..., :, None] - b[..., None, :] + li[..., None, :]
        D = jnp.where(tril, D, -jnp.inf)
        inter = b + m[..., None]
        m_t = jnp.maximum(inter, jnp.max(D, axis=-1))
        w_intra = jnp.exp(D - m_t[..., None])
        w_inter = jnp.exp(inter - m_t)
        s = jnp.einsum('bhtd,bhsd->bhts', qc, kc) * w_intra
        num = w_inter[..., None] * jnp.einsum('bhed,bhtd->bhte', C, qc) + jnp.einsum('bhts,bhse->bhte', s, vc)
        den = w_inter * jnp.einsum('bhd,bhtd->bht', n, qc) + jnp.sum(s, axis=-1)
        h = num / jnp.maximum(jnp.abs(den), jnp.exp(-m_t))[..., None]
        bL = b[..., -1]
        g = bL[..., None] - b + li
        m_new = jnp.maximum(bL + m, jnp.max(g, axis=-1))
        decay = jnp.exp(bL + m - m_new)
        w = jnp.exp(g - m_new[..., None])
        C_new = decay[..., None, None] * C + jnp.einsum('bhs,bhse,bhsd->bhed', w, vc, kc)
        n_new = decay[..., None] * n + jnp.einsum('bhs,bhsd->bhd', w, kc)
        return (C_new, n_new, m_new), h

    init = (jnp.zeros((B, H, dh, dh), f32), jnp.zeros((B, H, dh), f32), jnp.zeros((B, H), f32))
    _, hs = lax.scan(step, init, (chunk_vec(q), chunk_vec(k), chunk_vec(vv), chunk_gate(logi), chunk_gate(logf)))
    h = hs.transpose(1, 0, 3, 2, 4).reshape(B, L, H, dh)
    h = h * jax.nn.sigmoid(o_pre.astype(f32)).reshape(B, L, H, dh)
    mu = jnp.mean(h, axis=-1, keepdims=True)
    var = jnp.mean(jnp.square(h - mu), axis=-1, keepdims=True)
    hn = ((h - mu) * lax.rsqrt(var + EPS)).reshape(B, L, D_MLSTM)
    out = hn * gn_g.astype(f32) + skip.astype(f32) * c.astype(f32)
    return out.astype(u.dtype)


def stick_breaking_mixer(q, k, v, norm_g, valid):
    B, L, _ = q.shape
    H, dh = SB_HEADS, SB_DH
    f32 = jnp.float32
    qh = (q.reshape(B, L, H, dh).transpose(0, 2, 1, 3) * (dh ** -0.5)).astype(f32)
    kh = k.reshape(B, L, H, dh).transpose(0, 2, 1, 3).astype(f32)
    vh = v.reshape(B, L, H, dh).transpose(0, 2, 1, 3).astype(f32)
    spos = jnp.arange(L)

    def block(bi):
        qb = lax.dynamic_slice_in_dim(qh, bi * Q_BLOCK, Q_BLOCK, axis=2)
        z = jnp.einsum('bhtd,bhsd->bhts', qb, kh)
        tpos = bi * Q_BLOCK + jnp.arange(Q_BLOCK)
        mask = (spos[None, :] < tpos[:, None]) & valid[None, :]
        lneg = jnp.where(mask, jax.nn.log_sigmoid(-z), 0.0)
        rexcl = lax.cumsum(lneg, axis=3, reverse=True) - lneg
        A = jnp.where(mask, jnp.exp(jax.nn.log_sigmoid(z) + rexcl), 0.0)
        return jnp.einsum('bhts,bhsd->bhtd', A, vh)

    o = lax.map(block, jnp.arange(L // Q_BLOCK))
    o = o.transpose(1, 2, 0, 3, 4).reshape(B, H, L, dh).transpose(0, 2, 1, 3)
    o = o * lax.rsqrt(jnp.mean(o * o, axis=-1, keepdims=True) + EPS)
    return (o.reshape(B, L, D_SB) * norm_g.astype(f32)).astype(q.dtype)


def peer_ffn(n, w_query, sub_keys, expert_u, expert_v):
    B, L, D = n.shape
    T, Hh, K = TOK_BLOCK, PEER_HEADS, PEER_TOPK
    xb = n.reshape(B * L // T, T, D)

    def block(xt):
        q = (xt @ w_query).reshape(T, Hh, 2, PEER_HALF)
        s = jnp.einsum('thpc,pnc->thpn', q, sub_keys).astype(jnp.float32)
        sv, si = lax.top_k(s, K)
        cand = (sv[:, :, 0, :, None] + sv[:, :, 1, None, :]).reshape(T, Hh, K * K)
        cidx = (si[:, :, 0, :, None] * N_KEYS + si[:, :, 1, None, :]).reshape(T, Hh, K * K)
        fv, fi = lax.top_k(cand, K)
        eidx = jnp.take_along_axis(cidx, fi, axis=-1)
        g = jax.nn.softmax(fv, axis=-1)
        ue = expert_u[eidx]
        ve = expert_v[eidx]
        act = jax.nn.gelu(jnp.einsum('td,thkd->thk', xt, ue).astype(jnp.float32), approximate=False)
        return jnp.einsum('thk,thkd->td', (g * act).astype(xt.dtype), ve)

    return lax.map(block, xb).reshape(B, L, D)


def setup_inputs(seed: int = 0) -> dict:
    key = jax.random.key(seed)
    ks = jax.random.split(key, 20)
    f32 = jnp.float32
    def nrm(k, shape, scale):
        return jax.random.normal(k, shape, f32) * scale
    H, dh = MLSTM_HEADS, MLSTM_DH
    return {
        'x': nrm(ks[0], (BATCH, SEQ, D_MODEL), 1.0),
        'meta': nrm(ks[1], (N_META, D_MODEL), 1.0),
        'norm_mix_g': 1.0 + nrm(ks[2], (DEPTH, D_MODEL), 0.02),
        'w_in': nrm(ks[3], (DEPTH, D_MODEL, D_IN_PROJ), D_MODEL ** -0.5),
        'conv_w': nrm(ks[4], (DEPTH, CONV_W, D_MLSTM), CONV_W ** -0.5),
        'conv_b': nrm(ks[5], (DEPTH, D_MLSTM), 0.02),
        'w_qm': nrm(ks[6], (DEPTH, H, dh, dh), dh ** -0.5),
        'w_km': nrm(ks[7], (DEPTH, H, dh, dh), dh ** -0.5),
        'b_i': nrm(ks[8], (DEPTH, H), 0.1),
        'b_f': jnp.linspace(FORGET_BIAS_LO, FORGET_BIAS_HI, H, dtype=f32)[None, :] + nrm(ks[9], (DEPTH, H), 0.01),
        'mlstm_skip': 1.0 + nrm(ks[10], (DEPTH, D_MLSTM), 0.02),
        'mlstm_gn_g': 1.0 + nrm(ks[11], (DEPTH, D_MLSTM), 0.02),
        'sb_norm_g': 1.0 + nrm(ks[12], (DEPTH, D_SB), 0.02),
        'w_out': nrm(ks[13], (DEPTH, MIX, D_MODEL), MIX ** -0.5),
        'norm_ffn_g': 1.0 + nrm(ks[14], (DEPTH, D_MODEL), 0.02),
        'w_query': nrm(ks[15], (DEPTH, D_MODEL, PEER_HEADS * PEER_QDIM), D_MODEL ** -0.5),
        'sub_keys': nrm(ks[16], (DEPTH, 2, N_KEYS, PEER_HALF), PEER_HALF ** -0.5),
        'expert_u': nrm(ks[17], (DEPTH, N_EXPERTS, D_MODEL), D_MODEL ** -0.5),
        'expert_v': nrm(ks[18], (DEPTH, N_EXPERTS, D_MODEL), 0.5),
        'norm_final_g': 1.0 + nrm(ks[19], (D_MODEL,), 0.02),
    }


def reference(x, meta, norm_mix_g, w_in, conv_w, conv_b, w_qm, w_km, b_i, b_f, mlstm_skip, mlstm_gn_g,
              sb_norm_g, w_out, norm_ffn_g, w_query, sub_keys, expert_u, expert_v, norm_final_g):
    B, S, D = x.shape
    lead = jnp.concatenate([jnp.zeros((B, PAD, D), x.dtype),
                            jnp.broadcast_to(meta.astype(x.dtype)[None], (B, N_META, D))], axis=1)
    h = jnp.concatenate([lead, x], axis=1)
    L = S + LEAD
    valid = jnp.arange(L) >= PAD
    splits = _split_points()
    for l in range(DEPTH):
        n = rmsnorm(h, norm_mix_g[l])
        proj = n @ w_in[l]
        u, vm, o_pre, i_pre, f_pre, qs, ks_, vs = jnp.split(proj, splits, axis=-1)
        ym = mlstm_mixer(u, vm, o_pre, i_pre, f_pre, conv_w[l], conv_b[l], w_qm[l], w_km[l],
                         b_i[l], b_f[l], mlstm_skip[l], mlstm_gn_g[l], valid)
        ys = stick_breaking_mixer(qs, ks_, vs, sb_norm_g[l], valid)
        h = h + jnp.concatenate([ym, ys], axis=-1) @ w_out[l]
        n = rmsnorm(h, norm_ffn_g[l])
        h = h + peer_ffn(n, w_query[l], sub_keys[l], expert_u[l], expert_v[l])
    return rmsnorm(h[:, LEAD:], norm_final_g)
```

```cpp
#include <hip/hip_runtime.h>
#include <hip/hip_cooperative_groups.h>
#include <cstdio>
#include <cstdint>
namespace cg = cooperative_groups;

namespace pg8 {
#define PG8_LAS __attribute__((address_space(3)))
typedef unsigned short bf16_t;
typedef short bf16x8 __attribute__((ext_vector_type(8)));
typedef float f32x4 __attribute__((ext_vector_type(4)));
typedef unsigned u32x4 __attribute__((ext_vector_type(4)));
typedef unsigned u32x2 __attribute__((ext_vector_type(2)));
constexpr int BM = 256, BK = 64, HALF = 128, HTB = HALF * BK * 2  , STAGE_BYTES = 8 * HTB, NXCD = 8, WGM = 8;

__host__ __device__ __forceinline__ int lds_byte(int r, int c) { const int st = (r >> 4) * 2 + (c >> 5), rr = r & 15, cc = c & 31, ob = rr * 64 + cc * 2; return st * 1024 + (ob ^ (((ob >> 9) & 1) << 5)); }
__host__ __device__ __forceinline__ void stage_rc(int b, int& R, int& C) { const int st = b / 1024, sb = b % 1024, swz = sb ^ (((sb >> 9) & 1) << 5); R = (st >> 1) * 16 + swz / 64; C = (st & 1) * 32 + (swz % 64) / 2; }
__host__ __device__ __forceinline__ int perm32(int rho) { const int n = rho >> 4, i = rho & 15; return 8 * (i >> 2) + 4 * n + (i & 3); }

struct Unit { int pm, pn; };
struct Gemm { const bf16_t* A; const bf16_t* Bt; int M, N, K, lda, ldb; };

struct StaticOrder {
    int nM, nN, nwg, G, c;
    __host__ __device__ void init(int M, int N, int G_, int c_) { nM = M / BM; nN = N / BM; nwg = nM * nN; G = G_; c = c_; }
    __host__ __device__ bool next(int i, Unit& u) const {
        const long L = (long)i * G + c; if (L >= nwg) return false;
        int wgid = (int)L; { const int q = nwg / NXCD, r = nwg % NXCD, xcd = wgid % NXCD, off = wgid / NXCD; wgid = (xcd < r ? xcd * (q + 1) : r * (q + 1) + (xcd - r) * q) + off; }
        const int nig = WGM * nN, gid = wgid / nig, fm = gid * WGM, gsz = (nM - fm) < WGM ? (nM - fm) : WGM;
        u.pm = fm + ((wgid % nig) % gsz); u.pn = (wgid % nig) / gsz; return true;
    }
    __device__ __forceinline__ void a_ready(const Unit&) const {}
    __device__ __forceinline__ void done(const Unit&) const {}
};

__device__ __forceinline__ unsigned cvt_pk_bf16(float lo, float hi) { unsigned r; asm volatile("v_cvt_pk_bf16_f32 %0, %1, %2" : "=v"(r) : "v"(lo), "v"(hi)); return r; }

template <int MODE> struct EpiRowScaleBf16 {
    static constexpr bool PERM = true, AFTER_DRAIN = false;
    bf16_t* O; int ldc; const float* rs; float eps;
    __device__ __forceinline__ void operator()(const f32x4 (&acc)[2][2][4][2], const Unit& u, int wr, int wc, int fr, int fq) const {
        const int row0 = u.pm * BM + wr * 64 + fr; const int col0 = u.pn * BM + wc * 32 + 8 * fq;
#pragma unroll
        for (int ai = 0; ai < 2; ++ai)
#pragma unroll
            for (int m = 0; m < 4; ++m) { const int row = row0 + ai * HALF + m * 16; float sc;
                if (MODE == 0) sc = rs[row];
                else { const f32x4* q = (const f32x4*)(rs + (size_t)row * 16); const f32x4 a = q[0], b = q[1], c = q[2], d = q[3];
                       const float s = ((a[0] + a[1]) + (a[2] + a[3])) + ((b[0] + b[1]) + (b[2] + b[3])) + ((c[0] + c[1]) + (c[2] + c[3])) + ((d[0] + d[1]) + (d[2] + d[3]));
                       sc = 1.0f / sqrtf(s * (1.0f / 1024.0f) + eps); }
                bf16_t* rowp = O + (size_t)row * ldc + col0;
#pragma unroll
                for (int bj = 0; bj < 2; ++bj) { const f32x4 v0 = acc[ai][bj][m][0] * sc, v1 = acc[ai][bj][m][1] * sc;
                    u32x4 w; w.x = cvt_pk_bf16(v0[0], v0[1]); w.y = cvt_pk_bf16(v0[2], v0[3]); w.z = cvt_pk_bf16(v1[0], v1[1]); w.w = cvt_pk_bf16(v1[2], v1[3]);
                    *(u32x4*)(rowp + bj * HALF) = w; } }
    }
};
struct EpiResidual {
    static constexpr bool PERM = false, AFTER_DRAIN = false;
    const float* base; float* out; bf16_t* outb; float* ssq; int ldc;
    __device__ __forceinline__ void operator()(const f32x4 (&acc)[2][2][4][2], const Unit& u, int wr, int wc, int fr, int fq) const {
        const int col0 = u.pn * BM + wc * 32 + 4 * fq;
#pragma unroll
        for (int ai = 0; ai < 2; ++ai)
#pragma unroll
            for (int m = 0; m < 4; ++m) { const int row = u.pm * BM + ai * HALF + wr * 64 + m * 16 + fr; const size_t off = (size_t)row * ldc + col0; float s = 0.f;
#pragma unroll
                for (int bj = 0; bj < 2; ++bj)
#pragma unroll
                    for (int n = 0; n < 2; ++n) { const size_t o = off + bj * HALF + n * 16; const f32x4 h = *(const f32x4*)(base + o) + acc[ai][bj][m][n];
                        u32x2 w; w.x = cvt_pk_bf16(h[0], h[1]); w.y = cvt_pk_bf16(h[2], h[3]); *(u32x2*)(outb + o) = w;
                        s += (h[0] * h[0] + h[1] * h[1]) + (h[2] * h[2] + h[3] * h[3]); }
                s += __shfl_xor(s, 16); s += __shfl_xor(s, 32);
                if (fq == 0) ssq[(size_t)row * 16 + u.pn * 4 + wc] = s; }
    }
};
template <class Epi, class Sched, bool ALIGN_EPI = false, bool SP2 = false>
__device__ __forceinline__ void gemm_phase(PG8_LAS unsigned char* lds, const Gemm g, const Sched& S, const Epi& E) {
    const int tid = threadIdx.x, wid = __builtin_amdgcn_readfirstlane(tid >> 6), lane = tid & 63, wr = wid >> 2, wc = wid & 3, fr = lane & 15, fq = lane >> 4;
    const int K = g.K, nt = K / BK;
    unsigned voffA[2], voffB[2];
#pragma unroll
    for (int i = 0; i < 2; ++i) { int R, C; stage_rc(tid * 16 + i * 8192, R, C); const int Rb = Epi::PERM ? ((R & ~31) + perm32(R & 31)) : R;
        voffA[i] = (unsigned)(R * g.lda + C) * 2u; voffB[i] = (unsigned)(Rb * g.ldb + C) * 2u; }
    const size_t kstep = (size_t)(BK * 2);
    const size_t hstepA = (size_t)HALF * g.lda * 2, hstepB = (size_t)HALF * g.ldb * 2;
    const size_t tstepA = 2 * hstepA, tstepB = 2 * hstepB;
    const unsigned ldsw = (unsigned)wid * 1024u;
    const int aoff = lds_byte(wr * 64 + fr, fq * 8), boff = lds_byte(wc * 32 + fr, fq * 8);
#define PG8_SA(b, h) (((b) * 2 + (h)) * HTB)
#define PG8_SB(b, h) ((4 + (b) * 2 + (h)) * HTB)
#define PG8_STAGE(bufoff, gbase, voff) do { _Pragma("unroll") for (int _i = 0; _i < 2; ++_i) \
        __builtin_amdgcn_global_load_lds((const unsigned*)((const char*)(gbase) + (voff)[_i]), (PG8_LAS unsigned*)(lds + (bufoff) + ldsw + _i * 8192), 16, 0, 0); } while (0)
#define PG8_LDA(dst, b, h) do { _Pragma("unroll") for (int m = 0; m < 4; ++m) _Pragma("unroll") for (int k = 0; k < 2; ++k) dst[m][k] = *(const PG8_LAS bf16x8*)(lds + PG8_SA(b, h) + aoff + m * 2048 + k * 1024); } while (0)
#define PG8_LDB(dst, b, h) do { _Pragma("unroll") for (int n = 0; n < 2; ++n) _Pragma("unroll") for (int k = 0; k < 2; ++k) dst[n][k] = *(const PG8_LAS bf16x8*)(lds + PG8_SB(b, h) + boff + n * 2048 + k * 1024); } while (0)
#define PG8_MMA(ai, bj, At, Bt) do { __builtin_amdgcn_s_setprio(1); _Pragma("unroll") for (int m = 0; m < 4; ++m) _Pragma("unroll") for (int n = 0; n < 2; ++n) _Pragma("unroll") for (int k = 0; k < 2; ++k) \
        acc[ai][bj][m][n] = __builtin_amdgcn_mfma_f32_16x16x32_bf16(Bt[n][k], At[m][k], acc[ai][bj][m][n], 0, 0, 0); __builtin_amdgcn_s_setprio(0); } while (0)
#define PG8_WAIT_V(n) asm volatile("s_waitcnt vmcnt(" #n ")" ::: "memory")
#define PG8_WAIT_L(n) asm volatile("s_waitcnt lgkmcnt(" #n ")" ::: "memory")
#define PG8_BAR __builtin_amdgcn_s_barrier()
#define PG8_SCHED __builtin_amdgcn_sched_barrier(0)
    Unit cur, nxt; int ui = 0;
    if (!S.next(0, cur)) return;
    f32x4 acc[2][2][4][2];
#pragma unroll
    for (int a = 0; a < 2; ++a)
#pragma unroll
        for (int b = 0; b < 2; ++b)
#pragma unroll
            for (int m = 0; m < 4; ++m)
#pragma unroll
                for (int n = 0; n < 2; ++n) acc[a][b][m][n] = (f32x4){0.f, 0.f, 0.f, 0.f};
    bf16x8 At[4][2], B0[2][2], B1[2][2];
    const char* cA = (const char*)g.A + (size_t)cur.pm * tstepA; const char* cB = (const char*)g.Bt + (size_t)cur.pn * tstepB;
    S.a_ready(cur);
    if constexpr (SP2) {
        PG8_STAGE(PG8_SB(0, 0), cB, voffB); PG8_STAGE(PG8_SB(0, 1), cB + hstepB, voffB); PG8_STAGE(PG8_SA(0, 0), cA, voffA); PG8_STAGE(PG8_SA(0, 1), cA + hstepA, voffA);
        if (wr == 1) PG8_BAR;
        PG8_WAIT_V(2); PG8_BAR;
        PG8_STAGE(PG8_SB(1, 0), cB + kstep, voffB); PG8_STAGE(PG8_SA(1, 0), cA + kstep, voffA); PG8_STAGE(PG8_SB(1, 1), cB + hstepB + kstep, voffB);
        PG8_WAIT_V(6); PG8_BAR;
    } else {
        PG8_STAGE(PG8_SB(0, 0), cB, voffB); PG8_STAGE(PG8_SA(0, 0), cA, voffA); PG8_STAGE(PG8_SB(0, 1), cB + hstepB, voffB); PG8_STAGE(PG8_SA(0, 1), cA + hstepA, voffA);
        if (wr == 1) PG8_BAR;
        PG8_WAIT_V(4); PG8_BAR;
        PG8_STAGE(PG8_SB(1, 0), cB + kstep, voffB); PG8_STAGE(PG8_SA(1, 0), cA + kstep, voffA); PG8_STAGE(PG8_SB(1, 1), cB + hstepB + kstep, voffB);
        PG8_WAIT_V(6); PG8_BAR;
    }
    for (;;) {
        const bool has_next = S.next(ui + 1, nxt);
        const char* nA = has_next ? (const char*)g.A + (size_t)nxt.pm * tstepA : cA; const char* nB = has_next ? (const char*)g.Bt + (size_t)nxt.pn * tstepB : cB;
        for (int t = 0; t < nt; t += 2) {
            const bool last = (t == nt - 2);
            const char* a1 = cA + (size_t)(t + 1) * kstep;
            const char* a2 = last ? nA : cA + (size_t)(t + 2) * kstep; const char* b2 = last ? nB : cB + (size_t)(t + 2) * kstep;
            const char* a3 = a2 + kstep; const char* b3 = b2 + kstep;
            if (last && has_next) S.a_ready(nxt);
            if constexpr (SP2) {
            PG8_LDB(B0, 0, 0); PG8_LDB(B1, 0, 1); PG8_SCHED; PG8_LDA(At, 0, 0); PG8_STAGE(PG8_SA(1, 1), a1 + hstepA, voffA);
            PG8_WAIT_V(8); PG8_WAIT_L(0); PG8_BAR; PG8_MMA(0, 0, At, B0); PG8_MMA(0, 1, At, B1); PG8_BAR; PG8_SCHED;
            PG8_LDA(At, 0, 1); PG8_STAGE(PG8_SB(0, 0), b2, voffB); PG8_STAGE(PG8_SB(0, 1), b2 + hstepB, voffB); PG8_STAGE(PG8_SA(0, 0), a2, voffA);
            PG8_WAIT_V(8); PG8_WAIT_L(0); PG8_BAR; PG8_MMA(1, 0, At, B0); PG8_MMA(1, 1, At, B1); PG8_BAR; PG8_SCHED;
            PG8_LDB(B0, 1, 0); PG8_LDB(B1, 1, 1); PG8_SCHED; PG8_LDA(At, 1, 0); PG8_STAGE(PG8_SA(0, 1), a2 + hstepA, voffA);
            PG8_WAIT_V(8); PG8_WAIT_L(0); PG8_BAR; PG8_MMA(0, 0, At, B0); PG8_MMA(0, 1, At, B1); PG8_BAR; PG8_SCHED;
            PG8_LDA(At, 1, 1); PG8_STAGE(PG8_SB(1, 0), b3, voffB); PG8_STAGE(PG8_SB(1, 1), b3 + hstepB, voffB); PG8_STAGE(PG8_SA(1, 0), a3, voffA);
            PG8_WAIT_V(8); PG8_WAIT_L(0); PG8_BAR; PG8_MMA(1, 0, At, B0); PG8_MMA(1, 1, At, B1); PG8_BAR; PG8_SCHED;
            } else {
            PG8_LDB(B0, 0, 0); PG8_SCHED; PG8_LDA(At, 0, 0); PG8_STAGE(PG8_SA(1, 1), a1 + hstepA, voffA);
            PG8_WAIT_L(8); PG8_BAR; PG8_WAIT_L(0); PG8_MMA(0, 0, At, B0); PG8_BAR; PG8_SCHED;
            PG8_LDB(B1, 0, 1); PG8_STAGE(PG8_SB(0, 0), b2, voffB);
            PG8_BAR; PG8_WAIT_L(0); PG8_MMA(0, 1, At, B1); PG8_BAR;
            PG8_LDA(At, 0, 1); PG8_STAGE(PG8_SA(0, 0), a2, voffA);
            PG8_BAR; PG8_WAIT_L(0); PG8_MMA(1, 0, At, B0); PG8_BAR; PG8_SCHED;
            PG8_STAGE(PG8_SB(0, 1), b2 + hstepB, voffB);
            PG8_WAIT_V(6); PG8_BAR; PG8_MMA(1, 1, At, B1); PG8_BAR;
            PG8_LDB(B0, 1, 0); PG8_SCHED; PG8_LDA(At, 1, 0); PG8_STAGE(PG8_SA(0, 1), a2 + hstepA, voffA);
            PG8_WAIT_L(8); PG8_BAR; PG8_WAIT_L(0); PG8_MMA(0, 0, At, B0); PG8_BAR; PG8_SCHED;
            PG8_LDB(B1, 1, 1); PG8_STAGE(PG8_SB(1, 0), b3, voffB);
            PG8_BAR; PG8_WAIT_L(0); PG8_MMA(0, 1, At, B1); PG8_BAR;
            PG8_LDA(At, 1, 1); PG8_STAGE(PG8_SA(1, 0), a3, voffA);
            PG8_BAR; PG8_WAIT_L(0); PG8_MMA(1, 0, At, B0); PG8_BAR; PG8_SCHED;
            PG8_STAGE(PG8_SB(1, 1), b3 + hstepB, voffB);
            PG8_WAIT_V(6); PG8_BAR; PG8_MMA(1, 1, At, B1); PG8_BAR;
            }
        }
        if constexpr (ALIGN_EPI) { if (wr == 0) PG8_BAR; }
        if constexpr (!Epi::AFTER_DRAIN) { E(acc, cur, wr, wc, fr, fq); S.done(cur); }
        if (!has_next) break;
#pragma unroll
        for (int a = 0; a < 2; ++a)
#pragma unroll
            for (int b = 0; b < 2; ++b)
#pragma unroll
                for (int m = 0; m < 4; ++m)
#pragma unroll
                    for (int n = 0; n < 2; ++n) acc[a][b][m][n] = (f32x4){0.f, 0.f, 0.f, 0.f};
        cur = nxt; cA = nA; cB = nB; ++ui;
        if constexpr (ALIGN_EPI) { if (wr == 1) PG8_BAR; }
    }
    PG8_WAIT_V(0);
    if constexpr (!ALIGN_EPI) { if (wr == 0) PG8_BAR; }
    PG8_BAR;
    if constexpr (Epi::AFTER_DRAIN) { E.fused(acc, cur, wr, wc, fr, fq, lds, wid, lane); S.done(cur); }
#undef PG8_SA
#undef PG8_SB
#undef PG8_STAGE
#undef PG8_LDA
#undef PG8_LDB
#undef PG8_MMA
#undef PG8_WAIT_V
#undef PG8_WAIT_L
#undef PG8_BAR
#undef PG8_SCHED
}
}
#define PG8_SP2 true
#define PG8_ALIGN true

#define GAS __attribute__((address_space(1)))
#define LAS __attribute__((address_space(3)))
typedef unsigned short bf16;
typedef unsigned v4u __attribute__((ext_vector_type(4)));
typedef unsigned v2u __attribute__((ext_vector_type(2)));
typedef float f32x4 __attribute__((ext_vector_type(4)));
typedef float f32x2 __attribute__((ext_vector_type(2)));
typedef short bf16x8 __attribute__((ext_vector_type(8)));
#define RLX_AGENT __ATOMIC_RELAXED, __HIP_MEMORY_SCOPE_AGENT

constexpr int NWAVES = 8, NTHR = 512;
constexpr int SEQ = 8192, DM = 1024, MROWS = 16384, NMETA = 16;
constexpr int NIN = 3080, NPROJ = 3072;
constexpr int CU_ = 0, CV_ = 512, CO_ = 1024, CQS = 1536, CKS = 2048, CVS = 2560;
constexpr int OU_ = 0, OV_ = 512, OI_ = 1536, OF_ = 1540, OKS = 2056, OVS = 2568;
constexpr float EPS = 1e-6f;
constexpr int NEXP = 16384;

constexpr size_t KiB = 1024, MiB = 1024 * 1024;
constexpr size_t WS_CTL = 0, CTL_ZERO_BYTES = 64 * KiB;
constexpr size_t WS_RSTD1 = 64 * KiB;
constexpr size_t WS_SSQ   = WS_RSTD1 + 64 * KiB;
constexpr size_t WS_GI    = WS_SSQ + 1 * MiB;
constexpr size_t WS_GF    = WS_GI + 256 * KiB;
constexpr size_t WS_BT    = WS_GF + 256 * KiB;
constexpr size_t WS_NU    = WS_BT + 256 * KiB;
constexpr size_t WS_NS    = WS_NU + 512 * KiB;
constexpr size_t WS_AC    = WS_NS + 512 * KiB;
constexpr size_t WS_BC    = WS_AC + 4 * KiB;
constexpr size_t WS_MIN   = WS_BC + 4 * KiB;
constexpr size_t WS_PRM   = WS_MIN + 4 * KiB;
constexpr size_t WS_KM    = WS_PRM + 196 * KiB;
constexpr size_t WS_WQMT  = WS_KM + 32 * KiB;
constexpr size_t WS_WKMT  = WS_WQMT + 128 * KiB;
constexpr size_t WS_SKB   = WS_WKMT + 128 * KiB;
constexpr size_t WS_RSTDM = WS_SKB + 64 * KiB;
constexpr size_t WS_RS2 = WS_RSTDM + 4 * KiB;
constexpr size_t WS_ESC = WS_RS2 + 64 * KiB;
constexpr size_t WS_SMALL_END = WS_ESC + 128 * KiB;
static_assert(WS_SMALL_END <= 4 * MiB, "small region");
constexpr size_t WS_WINT = 4 * MiB, WS_WOUTT = 10 * MiB, WS_WQT = 12 * MiB;
constexpr size_t WS_EU = 16 * MiB, WS_EV = 32 * MiB;
constexpr size_t WS_PR = 80 * MiB;
constexpr size_t WS_QP = WS_PR;
constexpr size_t WS_QK = 176 * MiB;
constexpr size_t WS_XB = WS_QK, WS_H1B = WS_QK;
constexpr size_t WS_U = 208 * MiB;
constexpr size_t WS_PRMP = WS_U, WS_TK = WS_U;
constexpr size_t WS_CB = 240 * MiB;
constexpr size_t WS_END = 256 * MiB;

constexpr int LDS_BYTES = 147456, LDSCTL_OFF = LDS_BYTES - 256;

__device__ __forceinline__ unsigned f2bf(float f) { unsigned u = __builtin_bit_cast(unsigned, f); return (u + 0x7fffu + ((u >> 16) & 1u)) >> 16; }
__device__ __forceinline__ unsigned pk2(float lo, float hi) { return f2bf(lo) | (f2bf(hi) << 16); }
__device__ __forceinline__ unsigned pk_fp8x4(f32x4 v) {
    const float a = fminf(fmaxf(v[0], -448.f), 448.f), b = fminf(fmaxf(v[1], -448.f), 448.f), c = fminf(fmaxf(v[2], -448.f), 448.f), d = fminf(fmaxf(v[3], -448.f), 448.f);
    int r = __builtin_amdgcn_cvt_pk_fp8_f32(a, b, 0, false); r = __builtin_amdgcn_cvt_pk_fp8_f32(c, d, r, true); return (unsigned)r; }
__device__ __forceinline__ unsigned pk_fp4x8(f32x4 a, f32x4 b) {
    unsigned r = 0u; r = __builtin_amdgcn_cvt_scalef32_pk_fp4_f32(r, a[0], a[1], 1.0f, 0); r = __builtin_amdgcn_cvt_scalef32_pk_fp4_f32(r, a[2], a[3], 1.0f, 1);
    r = __builtin_amdgcn_cvt_scalef32_pk_fp4_f32(r, b[0], b[1], 1.0f, 2); r = __builtin_amdgcn_cvt_scalef32_pk_fp4_f32(r, b[2], b[3], 1.0f, 3); return r; }
__device__ __forceinline__ float bf2f(unsigned h) { return __builtin_bit_cast(float, h << 16); }
template <int CTRL> __device__ __forceinline__ float dpp_f(float v) { return __builtin_bit_cast(float, __builtin_amdgcn_update_dpp(0, __builtin_bit_cast(int, v), CTRL, 0xf, 0xf, true)); }
__device__ __forceinline__ float rdl_f(float v, int l) { return __builtin_bit_cast(float, __builtin_amdgcn_readlane(__builtin_bit_cast(int, v), l)); }
__device__ __forceinline__ float wave_sum(float v) {
    v += dpp_f<0xB1>(v); v += dpp_f<0x4E>(v); v += dpp_f<0x124>(v); v += dpp_f<0x128>(v);
    return (rdl_f(v, 0) + rdl_f(v, 16)) + (rdl_f(v, 32) + rdl_f(v, 48));
}
__device__ __forceinline__ float wave_max(float v) {
    v = fmaxf(v, dpp_f<0xB1>(v)); v = fmaxf(v, dpp_f<0x4E>(v)); v = fmaxf(v, dpp_f<0x124>(v)); v = fmaxf(v, dpp_f<0x128>(v));
    return fmaxf(fmaxf(rdl_f(v, 0), rdl_f(v, 16)), fmaxf(rdl_f(v, 32), rdl_f(v, 48)));
}
__device__ __forceinline__ float logsigmoidf_(float a) { return fminf(a, 0.f) - log1pf(__expf(-fabsf(a))); }
__device__ __forceinline__ float siluf_(float a) { return a / (1.f + __expf(-a)); }
template <int KS> __device__ __forceinline__ f32x4 mma_rows(const LAS bf16* a, const LAS bf16* b, f32x4 acc) {
#pragma unroll
    for (int k = 0; k < KS; ++k) { const bf16x8 av = *(const LAS bf16x8*)(a + 32 * k), bv = *(const LAS bf16x8*)(b + 32 * k); acc = __builtin_amdgcn_mfma_f32_16x16x32_bf16(av, bv, acc, 0, 0, 0); }
    return acc;
}
#define XB_TMO      128
#define XB_XCNT(j)  (256  + 64 * (j))
#define XB_XSUB(j)  (1280 + 64 * (j))
#define XB_XGEN(j)  (2304 + 64 * (j))
#define XB_TOP      3328
#define XB_TOPGEN   3392
#define XCD_BAR_WORDS 3456
#define XB_SPIN_CAP (1u << 18)

__device__ __forceinline__ unsigned xb_ld(unsigned* p)              { return __hip_atomic_load(p, __ATOMIC_RELAXED, __HIP_MEMORY_SCOPE_AGENT); }
__device__ __forceinline__ unsigned xb_add(unsigned* p, unsigned v) { return __hip_atomic_fetch_add(p, v, __ATOMIC_RELAXED, __HIP_MEMORY_SCOPE_AGENT); }
__device__ __forceinline__ unsigned xb_xcc_id() { return (unsigned)__builtin_amdgcn_s_getreg((3 << 11) | 20) & 0xFu; }
#define XB_SPIN(cond, bar) do { unsigned _sp = 0; while (cond) { __builtin_amdgcn_s_sleep(1); \
    if ((++_sp & 255u) == 0u) { if (xb_ld(&(bar)[XB_TMO])) break; if (_sp > XB_SPIN_CAP) { atomicAdd(&(bar)[XB_TMO], 1u); break; } } } } while (0)

struct XcdBarrier {
    unsigned* bar; unsigned x;
    volatile LAS unsigned* st;
};

__device__ __forceinline__ XcdBarrier xcd_barrier_post(unsigned* bar, volatile LAS unsigned* st) {
    XcdBarrier b; b.bar = bar; b.x = xb_xcc_id(); b.st = st;
    if (threadIdx.x == 0) (void)xb_add(&bar[XB_XCNT(b.x)], 1u);
    return b;
}
__device__ __forceinline__ void xcd_barrier_complete(unsigned* bar, unsigned x, unsigned& nloc, unsigned& nx) {
    const unsigned G = gridDim.x * gridDim.y * gridDim.z;
    unsigned sum, cnt, mine, sp = 0u;
    for (;;) {
        sum = 0u; cnt = 0u; mine = 0u;
#pragma unroll
        for (unsigned j = 0; j < 16; ++j) { const unsigned c = xb_ld(&bar[XB_XCNT(j)]); sum += c; cnt += (c > 0u) ? 1u : 0u; mine = (j == x) ? c : mine; }
        if (sum == G) break;
        __builtin_amdgcn_s_sleep(1);
        if ((++sp & 255u) == 0u) { if (xb_ld(&bar[XB_TMO])) break; if (sp > XB_SPIN_CAP) { atomicAdd(&bar[XB_TMO], 1u); break; } }
    }
    nloc = mine > 0u ? mine : 1u; nx = cnt > 0u ? cnt : 1u;
}

__device__ __forceinline__ void xcd_barrier(const XcdBarrier& b) {
    asm volatile("s_waitcnt vmcnt(0)" ::: "memory");
    __syncthreads();
    if (threadIdx.x == 0) {
        unsigned* bar = b.bar;
        __builtin_amdgcn_s_waitcnt(0);
        unsigned nloc = b.st[0], nx = b.st[1];
        if (nloc == 0u) { xcd_barrier_complete(bar, b.x, nloc, nx); b.st[0] = nloc; b.st[1] = nx; }
        const unsigned old = xb_add(&bar[XB_XSUB(b.x)], 1u);
        const unsigned gen = old / nloc;
        if (old + 1u == (gen + 1u) * nloc) {
            __builtin_amdgcn_fence(__ATOMIC_RELEASE, "agent");
            asm volatile("s_waitcnt vmcnt(0)" ::: "memory");
            const unsigned og = xb_add(&bar[XB_TOP], 1u);
            const unsigned tg = og / nx;
            if (og + 1u == (tg + 1u) * nx) xb_add(&bar[XB_TOPGEN], 1u);
            else XB_SPIN(xb_ld(&bar[XB_TOPGEN]) == tg, bar);
            __builtin_amdgcn_fence(__ATOMIC_ACQUIRE, "agent");
            xb_add(&bar[XB_XGEN(b.x)], 1u);
            asm volatile("s_waitcnt vmcnt(0)" ::: "memory");
        } else {
            XB_SPIN(xb_ld(&bar[XB_XGEN(b.x)]) == gen, bar);
            __builtin_amdgcn_fence(__ATOMIC_ACQUIRE, "agent");
            asm volatile("s_waitcnt vmcnt(0)" ::: "memory");
        }
    }
    __syncthreads();
}

struct Params { const float* in[20]; float* out; unsigned char* ws; };
struct Frame {
    LAS unsigned char* lds;
    int tid, lane, wave, vcu, G;
    const float *x, *meta, *g_mix, *w_in, *conv_w, *conv_b, *w_qm, *w_km, *b_i, *b_f, *skip, *gn_g, *sb_g, *w_out, *g_ffn, *w_query, *sub_keys, *eu, *ev, *g_fin;
    float* out; unsigned char* ws;
};
#define WSP(T, off) ((T*)(F.ws + (off)))

__device__ __forceinline__ void p0_transpose_item(const float* W, int ldw, int k0, int srccol0, bf16* WT, int K, int dstrow0, const float* gk, float cs, LAS float* scr, int lane, const float* META, float* PRMP) {
#pragma unroll 8
    for (int i = 0; i < 32; ++i) { const int kk = 2 * i + (lane >> 5); const float sc = gk ? gk[k0 + kk] * cs : cs; scr[kk * 33 + (lane & 31)] = W[(size_t)(k0 + kk) * ldw + srccol0 + (lane & 31)] * sc; }
    if (META) { LAS float* mb = scr + 64 * 33;
#pragma unroll
        for (int i = 0; i < 16; ++i) mb[i * 64 + lane] = META[(size_t)i * DM + k0 + lane]; }
    const int c = lane & 7;
#pragma unroll
    for (int j = 0; j < 4; ++j) { const int n = (lane >> 3) + 8 * j; const LAS float* s = scr + (8 * c) * 33 + n;
        v4u o; o.x = pk2(s[0 * 33], s[1 * 33]); o.y = pk2(s[2 * 33], s[3 * 33]); o.z = pk2(s[4 * 33], s[5 * 33]); o.w = pk2(s[6 * 33], s[7 * 33]);
        *(v4u*)(WT + (size_t)(dstrow0 + n) * K + k0 + 8 * c) = o; }
    if (META) { const LAS float* mb = scr + 64 * 33; const int n = lane & 31, r0 = (lane >> 5) * 8; float acc[8];
#pragma unroll
        for (int r = 0; r < 8; ++r) acc[r] = 0.f;
#pragma unroll 4
        for (int kk = 0; kk < 64; kk += 4) { const float w0 = scr[kk * 33 + n], w1 = scr[(kk + 1) * 33 + n], w2 = scr[(kk + 2) * 33 + n], w3 = scr[(kk + 3) * 33 + n];
#pragma unroll
            for (int r = 0; r < 8; ++r) { const f32x4 m = *(const LAS f32x4*)(mb + (r0 + r) * 64 + kk); acc[r] += (m[0] * w0 + m[1] * w1) + (m[2] * w2 + m[3] * w3); } }
#pragma unroll
        for (int r = 0; r < 8; ++r) PRMP[((size_t)(k0 >> 6) * 16 + r0 + r) * NIN + srccol0 + n] = acc[r]; }
}

__device__ __forceinline__ void p0_pack_row_i4(Frame& F, f32x4 (&a)[4], const f32x4 (&gf)[4], int r, int lane) {
    const bool isu = r < NEXP; float ss = 0.f;
#pragma unroll
    for (int j = 0; j < 4; ++j) { if (isu) a[j] = a[j] * gf[j]; ss += (a[j][0] * a[j][0] + a[j][1] * a[j][1]) + (a[j][2] * a[j][2] + a[j][3] * a[j][3]); }
    ss = wave_sum(ss);
    const float rms = sqrtf(ss * (1.0f / DM)); const float step = rms > 0.f ? 0.3125f * rms : 1.0f, inv = 1.0f / step;
    v2u o;
#pragma unroll
    for (int d = 0; d < 2; ++d) { unsigned w = 0u;
#pragma unroll
        for (int n = 0; n < 8; ++n) { const int i = 8 * d + n; const float q = floorf(a[i >> 2][i & 3] * inv); const int k = (int)fminf(fmaxf(q, -8.f), 7.f); w |= ((unsigned)k & 0xfu) << (4 * n); }
        o[d] = w; }
    *((v2u*)(F.ws + (isu ? WS_EU : WS_EV) + (size_t)(r & (NEXP - 1)) * (DM / 2)) + lane) = o;
    if (lane == 0) WSP(float, WS_ESC)[r] = step;
}

__device__ __forceinline__ void p0_prologue(Frame& F) {
    LAS float* scr = (LAS float*)(F.lds + 32768 + F.wave * 14336);
    LAS float* wg = (LAS float*)F.lds;
    const int gw = F.vcu * NWAVES + F.wave, NGW = F.G * NWAVES, lane = F.lane;
    for (int i = F.tid; i < 8192; i += NTHR) { const int jj = i >> 10, k = i & 1023; wg[i] = F.w_in[(size_t)k * NIN + OI_ + jj] * F.g_mix[k]; }
    {
        constexpr int I_IN = 16 * 96, I_OUT = 16 * 32, I_Q = 16 * 64, I_M = 2 * 4;
        constexpr int NITEMS = I_IN + I_OUT + I_Q + 8 * I_M;
        for (int it = gw; it < NITEMS; it += NGW) {
            int r = it;
            if (r < I_IN) { const int kb = r / 96, nb = r % 96; const int n0 = 32 * nb; p0_transpose_item(F.w_in, NIN, 64 * kb, n0 + (n0 >= 1536 ? 8 : 0), WSP(bf16, WS_WINT), DM, n0, F.g_mix, 1.f, scr, lane, F.meta, WSP(float, WS_PRMP)); continue; } r -= I_IN;
            if (r < I_OUT) { const int kb = r / 32, nb = r % 32; p0_transpose_item(F.w_out, DM, 64 * kb, 32 * nb, WSP(bf16, WS_WOUTT), DM, 32 * nb, nullptr, 1.f, scr, lane, nullptr, nullptr); continue; } r -= I_OUT;
            if (r < I_Q) { const int kb = r / 64, nb = r % 64; p0_transpose_item(F.w_query, 2048, 64 * kb, 32 * nb, WSP(bf16, WS_WQT), DM, 32 * nb, F.g_ffn, 1.f, scr, lane, nullptr, nullptr); continue; } r -= I_Q;
            { const int mat = r / I_M, q = r % I_M, kb = q / 4, nb = q % 4, h = mat & 3;
              const float* W = (mat < 4 ? F.w_qm : F.w_km) + (size_t)h * 16384; bf16* WT = WSP(bf16, mat < 4 ? WS_WQMT : WS_WKMT) + (size_t)h * 16384;
              p0_transpose_item(W, 128, 64 * kb, 32 * nb, WT, 128, 32 * nb, nullptr, mat < 4 ? 1.f : 0.08838834764831845f, scr, lane, nullptr, nullptr); }
        }
        for (int i = gw * 64 + lane; i < 32768 / 4; i += NGW * 64) { const f32x4 v = ((const f32x4*)F.sub_keys)[i]; v2u o; o.x = pk2(v[0], v[1]); o.y = pk2(v[2], v[3]); ((v2u*)WSP(bf16, WS_SKB))[i] = o; }
    }
    __syncthreads();
    {
        float bi[4], bfv[4];
#pragma unroll
        for (int j = 0; j < 4; ++j) { bi[j] = F.b_i[j]; bfv[j] = F.b_f[j]; }
        f32x4 v[4], vn[4];
        { const f32x4* xr = (const f32x4*)(F.x + (size_t)gw * DM) + lane;
#pragma unroll
          for (int j = 0; j < 4; ++j) v[j] = xr[64 * j]; }
        for (int m = gw; m < MROWS + NMETA; m += NGW) {
            const int mn = m + NGW;
            if (mn < MROWS + NMETA) { const f32x4* xr = (const f32x4*)(mn < MROWS ? F.x + (size_t)mn * DM : F.meta + (size_t)(mn - MROWS) * DM) + lane;
#pragma unroll
                for (int j = 0; j < 4; ++j) vn[j] = xr[64 * j]; }
            float ss = 0.f; float g8[8];
#pragma unroll
            for (int jj = 0; jj < 8; ++jj) g8[jj] = 0.f;
#pragma unroll
            for (int j = 0; j < 4; ++j) ss += (v[j][0] * v[j][0] + v[j][1] * v[j][1]) + (v[j][2] * v[j][2] + v[j][3] * v[j][3]);
#pragma unroll
            for (int j = 0; j < 4; ++j)
#pragma unroll
                for (int jj = 0; jj < 8; ++jj) { const f32x4 w = *(const LAS f32x4*)(wg + jj * 1024 + 256 * j + 4 * lane); g8[jj] += (v[j][0] * w[0] + v[j][1] * w[1]) + (v[j][2] * w[2] + v[j][3] * w[3]); }
            ss = wave_sum(ss);
#pragma unroll
            for (int jj = 0; jj < 8; ++jj) g8[jj] = wave_sum(g8[jj]);
            const float rstd = 1.0f / sqrtf(ss * (1.0f / DM) + EPS);
            if (m < MROWS) {
                v2u* o8 = (v2u*)(WSP(bf16, WS_XB) + (size_t)m * DM) + lane;
#pragma unroll
                for (int j = 0; j < 4; ++j) { v2u o; o.x = pk2(v[j][0], v[j][1]); o.y = pk2(v[j][2], v[j][3]); o8[64 * j] = o; }
                if (lane == 0) WSP(float, WS_RSTD1)[m] = rstd;
#pragma unroll
                for (int jj = 0; jj < 4; ++jj) if (lane == jj) { WSP(float, WS_GI)[m * 4 + jj] = g8[jj] * rstd + bi[jj]; WSP(float, WS_GF)[m * 4 + jj] = logsigmoidf_(g8[4 + jj] * rstd + bfv[jj]); }
            } else {
                const int r = m - MROWS;
                if (lane == 0) WSP(float, WS_RSTDM)[r] = rstd;
#pragma unroll
                for (int jj = 0; jj < 8; ++jj) if (lane == jj) WSP(float, WS_PRM)[(size_t)r * NIN + OI_ + jj] = g8[jj] * rstd;
            }
#pragma unroll
            for (int j = 0; j < 4; ++j) v[j] = vn[j];
        }
    }
    {
        f32x4 gf[4];
#pragma unroll
        for (int j = 0; j < 4; ++j) gf[j] = ((const f32x4*)F.g_ffn)[lane + 64 * j];
        for (int r = gw; r < 2 * NEXP; r += 2 * NGW) {
            const int r2 = r + NGW; const bool has2 = r2 < 2 * NEXP;
            const f32x4* s1 = (const f32x4*)((r >= NEXP ? F.ev : F.eu) + (size_t)(r & (NEXP - 1)) * DM) + lane;
            const f32x4* s2 = (const f32x4*)((r2 >= NEXP ? F.ev : F.eu) + (size_t)(r2 & (NEXP - 1)) * DM) + lane;
            f32x4 a[4], b[4];
#pragma unroll
            for (int j = 0; j < 4; ++j) { a[j] = s1[64 * j]; if (has2) b[j] = s2[64 * j]; }
            if (r < NEXP) p0_pack_row_i4(F, a, gf, r, lane);
            else { v2u o; o[0] = pk_fp4x8(a[0] * 4.0f, a[1] * 4.0f); o[1] = pk_fp4x8(a[2] * 4.0f, a[3] * 4.0f); *((v2u*)(F.ws + WS_EV + (size_t)(r - NEXP) * (DM / 2)) + lane) = o; }
            if (has2) { if (r2 < NEXP) p0_pack_row_i4(F, b, gf, r2, lane);
                else { v2u o; o[0] = pk_fp4x8(b[0] * 4.0f, b[1] * 4.0f); o[1] = pk_fp4x8(b[2] * 4.0f, b[3] * 4.0f); *((v2u*)(F.ws + WS_EV + (size_t)(r2 - NEXP) * (DM / 2)) + lane) = o; } }
        }
    }
}

__device__ __forceinline__ void p1_meta_tail(Frame& F) {
    const float* P = WSP(float, WS_PRMP);
    if (F.vcu >= 4 && F.vcu < 8) {
        const int part = F.vcu - 4, per = 16 * NIN / 4;
        for (int i = part * per + F.tid; i < (part + 1) * per; i += NTHR) { const int r = i / NIN, n = i - r * NIN; if (n >= OI_ && n < OI_ + 8) continue; float s = 0.f;
#pragma unroll
            for (int kp = 0; kp < 16; ++kp) s += P[(size_t)kp * 16 * NIN + i];
            WSP(float, WS_PRM)[i] = s * WSP(float, WS_RSTDM)[r]; }
    } else if (F.vcu < 4) {
        const int h = F.vcu; LAS float* um = (LAS float*)F.lds; LAS float* cm = um + 2048;
        for (int i = F.tid; i < 2048; i += NTHR) { const int t = i >> 7, ch = i & 127; float s = 0.f;
#pragma unroll
            for (int kp = 0; kp < 16; ++kp) s += P[(size_t)(kp * 16 + t) * NIN + OU_ + h * 128 + ch];
            um[i] = s * WSP(float, WS_RSTDM)[t]; }
        __syncthreads();
        for (int i = F.tid; i < 2048; i += NTHR) { const int t = i >> 7, ch = i & 127, c = h * 128 + ch; float s = F.conv_b[c];
#pragma unroll
            for (int j = 0; j < 4; ++j) { const int tt = t - 3 + j; if (tt >= 0) s += F.conv_w[j * 512 + c] * um[tt * 128 + ch]; }
            cm[i] = siluf_(s); }
        __syncthreads();
        { const int t = F.tid >> 5;
#pragma unroll
          for (int jj = 0; jj < 4; ++jj) { const int e = (F.tid & 31) + 32 * jj; float s = 0.f;
              for (int d = 0; d < 128; ++d) s += cm[t * 128 + d] * F.w_km[(size_t)h * 16384 + d * 128 + e];
              WSP(float, WS_KM)[(h * 16 + t) * 128 + e] = s * 0.08838834764831845f; } }
        __syncthreads();
    }
}

constexpr int L2_WQ = 0, L2_WK = 34816, L2_C = 69632, L2_KT = 87040, L2_WV = 105472, L2_U = 123904, L2_TAB = 141056;
__device__ __forceinline__ void p2_mlstm_local(Frame& F) {
    const int bh = F.vcu >> 5, b = bh >> 2, h = bh & 3, tid = F.tid, lane = F.lane, wave = F.wave, g = lane >> 4, l15 = lane & 15;
    LAS bf16* WQ = (LAS bf16*)(F.lds + L2_WQ); LAS bf16* WK = (LAS bf16*)(F.lds + L2_WK); LAS bf16* Cs = (LAS bf16*)(F.lds + L2_C);
    LAS bf16* KT = (LAS bf16*)(F.lds + L2_KT); LAS bf16* WV = (LAS bf16*)(F.lds + L2_WV); LAS bf16* Us = (LAS bf16*)(F.lds + L2_U);
    LAS float* TAB = (LAS float*)(F.lds + L2_TAB);
    const bf16* PR = WSP(bf16, WS_PR); const float* PRM = WSP(float, WS_PRM);
    for (int i = tid; i < 2048; i += NTHR) { const int e = i >> 4, c8 = (i & 15) * 8;
        *(LAS v4u*)(WQ + e * 136 + c8) = *(const v4u*)(WSP(bf16, WS_WQMT) + (size_t)h * 16384 + e * 128 + c8);
        *(LAS v4u*)(WK + e * 136 + c8) = *(const v4u*)(WSP(bf16, WS_WKMT) + (size_t)h * 16384 + e * 128 + c8); }
    v4u ur[3], vr[2]; float gli = 0.f, glf = 0.f;
#define P2_FETCH_U(chunkx) do { const int _m0 = b * SEQ + (chunkx) * 64; _Pragma("unroll") for (int _k = 0; _k < 3; ++_k) { const int _i = tid + NTHR * _k; if (_i < 67 * 16) { const int _rr = _i >> 4, _c8 = (_i & 15) * 8, _t = _rr - 3; \
            if ((chunkx) == 0 && _t < 0) { const float* _s = PRM + (size_t)(NMETA + _t) * NIN + OU_ + h * 128 + _c8; ur[_k].x = pk2(_s[0], _s[1]); ur[_k].y = pk2(_s[2], _s[3]); ur[_k].z = pk2(_s[4], _s[5]); ur[_k].w = pk2(_s[6], _s[7]); } \
            else ur[_k] = *(const v4u*)(PR + (size_t)(_m0 + _t) * NPROJ + CU_ + h * 128 + _c8); } } \
        if (tid < 64) { gli = WSP(float, WS_GI)[(_m0 + tid) * 4 + h]; glf = WSP(float, WS_GF)[(_m0 + tid) * 4 + h]; } } while (0)
#define P2_FETCH_V(chunkx) do { const int _m0 = b * SEQ + (chunkx) * 64; _Pragma("unroll") for (int _k = 0; _k < 2; ++_k) { const int _i = tid + NTHR * _k; vr[_k] = *(const v4u*)(PR + (size_t)(_m0 + (_i >> 4)) * NPROJ + CV_ + h * 128 + (_i & 15) * 8); } } while (0)
    P2_FETCH_U(F.vcu & 31); P2_FETCH_V(F.vcu & 31);
    for (int ui = 0; ui < 4; ++ui) {
        const int chunk = (F.vcu & 31) + 32 * ui; const int m0 = b * SEQ + chunk * 64;
        __syncthreads();
#pragma unroll
        for (int k = 0; k < 3; ++k) { const int i = tid + NTHR * k; if (i < 67 * 16) *(LAS v4u*)(Us + (i >> 4) * 128 + (i & 15) * 8) = ur[k]; }
        if (tid < 64) { TAB[tid] = gli; TAB[64 + tid] = glf; }
        if (ui + 1 < 4) P2_FETCH_U(chunk + 32);
        __syncthreads();
        { const int ch = tid & 127, c = h * 128 + ch; const float w0 = F.conv_w[c], w1 = F.conv_w[512 + c], w2 = F.conv_w[1024 + c], w3 = F.conv_w[1536 + c], cb = F.conv_b[c];
#pragma unroll 4
          for (int jj = 0; jj < 16; ++jj) { const int t = (tid >> 7) + 4 * jj;
              const float s = cb + w0 * bf2f(Us[t * 128 + ch]) + w1 * bf2f(Us[(t + 1) * 128 + ch]) + w2 * bf2f(Us[(t + 2) * 128 + ch]) + w3 * bf2f(Us[(t + 3) * 128 + ch]);
              const unsigned cv = f2bf(siluf_(s)); Cs[t * 136 + ch] = (bf16)cv; } }
        if (wave == 0) {
            const float li = TAB[lane], lf = TAB[64 + lane]; float bs = lf;
#pragma unroll
            for (int o = 1; o < 64; o <<= 1) { const float t = __shfl_up(bs, o); if (lane >= o) bs += t; }
            const float bL = __shfl(bs, 63); const float gg = bL - bs + li; const float Bc = wave_max(gg);
            TAB[128 + lane] = bs; TAB[192 + lane] = __expf(gg - Bc);
            WSP(float, WS_BT)[(m0 + lane) * 4 + h] = bs;
            if (lane == 0) { WSP(float, WS_AC)[bh * 128 + chunk] = bL; WSP(float, WS_BC)[bh * 128 + chunk] = Bc; }
        }
        __syncthreads();
        {
            bf16* Qg = WSP(bf16, WS_QK); bf16* Kg = Qg + (size_t)MROWS * 512;
#pragma unroll
            for (int tt = 0; tt < 4; ++tt) {
                f32x4 aq = {0.f, 0.f, 0.f, 0.f}, ak = {0.f, 0.f, 0.f, 0.f};
                aq = mma_rows<4>(WQ + (16 * wave + l15) * 136 + 8 * g, Cs + (16 * tt + l15) * 136 + 8 * g, aq);
                ak = mma_rows<4>(WK + (16 * wave + l15) * 136 + 8 * g, Cs + (16 * tt + l15) * 136 + 8 * g, ak);
                const int t = 16 * tt + l15, e0 = 16 * wave + 4 * g; const size_t go = (size_t)(m0 + t) * 512 + h * 128 + e0;
                v2u oq; oq.x = pk2(aq[0], aq[1]); oq.y = pk2(aq[2], aq[3]); *(v2u*)(Qg + go) = oq;
                v2u ok; ok.x = pk2(ak[0], ak[1]); ok.y = pk2(ak[2], ak[3]); *(v2u*)(Kg + go) = ok;
                KT[(e0 + 0) * 72 + t] = (bf16)(ok.x & 0xffffu); KT[(e0 + 1) * 72 + t] = (bf16)(ok.x >> 16); KT[(e0 + 2) * 72 + t] = (bf16)(ok.y & 0xffffu); KT[(e0 + 3) * 72 + t] = (bf16)(ok.y >> 16);
            }
            for (int i = tid; i < 1024; i += NTHR) { const int t = i >> 4, c8 = (i & 15) * 8; *(v4u*)(WSP(bf16, WS_CB) + (size_t)(m0 + t) * 512 + h * 128 + c8) = *(const LAS v4u*)(Cs + t * 136 + c8); }
#pragma unroll
            for (int k = 0; k < 2; ++k) { const int i = tid + NTHR * k; const int s = i >> 4, e8 = (i & 15) * 8; const v4u pv = vr[k]; const float w = TAB[192 + s];
#pragma unroll
                for (int q = 0; q < 4; ++q) { WV[(e8 + 2 * q) * 72 + s] = (bf16)f2bf(bf2f(pv[q] & 0xffffu) * w); WV[(e8 + 2 * q + 1) * 72 + s] = (bf16)f2bf(__uint_as_float(pv[q] & 0xffff0000u) * w); } }
            if (ui + 1 < 4) P2_FETCH_V(chunk + 32);
        }
        __syncthreads();
        {
            bf16* Ug = WSP(bf16, WS_U) + (size_t)(bh * 128 + chunk) * 16384;
#pragma unroll
            for (int et = 0; et < 8; ++et) { f32x4 a = {0.f, 0.f, 0.f, 0.f};
                a = mma_rows<2>(KT + (16 * wave + l15) * 72 + 8 * g, WV + (16 * et + l15) * 72 + 8 * g, a);
                v2u o; o.x = pk2(a[0], a[1]); o.y = pk2(a[2], a[3]); *(v2u*)(Ug + (size_t)(16 * et + l15) * 128 + 16 * wave + 4 * g) = o; }
            if (tid < 128) { float s = 0.f; for (int t = 0; t < 64; ++t) s += bf2f(KT[tid * 72 + t]) * TAB[192 + t]; WSP(float, WS_NU)[(size_t)(bh * 128 + chunk) * 128 + tid] = s; }
        }
    }
#undef P2_FETCH_U
#undef P2_FETCH_V
    __syncthreads();
}

constexpr int L3_K = 0, L3_VT = 9216, L3_MIN = 18432;
__device__ __forceinline__ void p2_sb_attention(Frame& F) {
    const int tid = F.tid, lane = F.lane, wave = F.wave, g = lane >> 4, l15 = lane & 15;
    LAS bf16* Ks = (LAS bf16*)(F.lds + L3_K); LAS bf16* VT = (LAS bf16*)(F.lds + L3_VT); LAS float* MINR = (LAS float*)(F.lds + L3_MIN);
    bf16* PR = WSP(bf16, WS_PR); const float* PRM = WSP(float, WS_PRM);
    const int bhd = F.vcu >> 4, b = bhd >> 3, hd = bhd & 7;
    for (int ui = 0; ui < 4; ++ui) {
        const int qb = (F.vcu & 15) + 16 * ui;
        const int tq = 128 * qb + 16 * wave + l15;
        const size_t qrow = (size_t)(b * SEQ + tq) * NPROJ;
        const bf16x8 q0 = *(const bf16x8*)(PR + qrow + CQS + hd * 64 + 8 * g), q1 = *(const bf16x8*)(PR + qrow + CQS + hd * 64 + 32 + 8 * g);
        f32x4 o[4];
#pragma unroll
        for (int i = 0; i < 4; ++i) o[i] = (f32x4){0.f, 0.f, 0.f, 0.f};
        float R = 0.f;
        const int kr = tid >> 3, c8 = (tid & 7) * 8;
        v4u kn, vn;
#define SB_FETCH(jbx) do { if ((jbx) >= 0) { const size_t _ro = (size_t)(b * SEQ + 64 * (jbx) + kr) * NPROJ + hd * 64 + c8; kn = *(const v4u*)(PR + _ro + CKS); vn = *(const v4u*)(PR + _ro + CVS); } \
            else if (kr < NMETA) { const float* _sk = PRM + (size_t)kr * NIN + OKS + hd * 64 + c8; const float* _sv = PRM + (size_t)kr * NIN + OVS + hd * 64 + c8; \
                kn.x = pk2(_sk[0], _sk[1]); kn.y = pk2(_sk[2], _sk[3]); kn.z = pk2(_sk[4], _sk[5]); kn.w = pk2(_sk[6], _sk[7]); vn.x = pk2(_sv[0], _sv[1]); vn.y = pk2(_sv[2], _sv[3]); vn.z = pk2(_sv[4], _sv[5]); vn.w = pk2(_sv[6], _sv[7]); } \
            else { kn = (v4u){0u, 0u, 0u, 0u}; vn = kn; } } while (0)
        SB_FETCH(2 * qb + 1);
        for (int jb = 2 * qb + 1; jb >= -1; --jb) {
            __syncthreads();
            if (jb < 2 * qb + 1) { float mn = MINR[0];
#pragma unroll
                for (int w = 1; w < 8; ++w) mn = fminf(mn, MINR[w]);
                if (mn >= 90.f) break; }
            { const v4u kv = kn, vv = vn;
              *(LAS v4u*)(Ks + kr * 72 + c8) = kv;
              VT[(c8 + 0) * 72 + kr] = (bf16)(vv.x & 0xffffu); VT[(c8 + 1) * 72 + kr] = (bf16)(vv.x >> 16); VT[(c8 + 2) * 72 + kr] = (bf16)(vv.y & 0xffffu); VT[(c8 + 3) * 72 + kr] = (bf16)(vv.y >> 16);
              VT[(c8 + 4) * 72 + kr] = (bf16)(vv.z & 0xffffu); VT[(c8 + 5) * 72 + kr] = (bf16)(vv.z >> 16); VT[(c8 + 6) * 72 + kr] = (bf16)(vv.w & 0xffffu); VT[(c8 + 7) * 72 + kr] = (bf16)(vv.w >> 16); }
            if (jb > -1) SB_FETCH(jb - 1);
            __syncthreads();
            if (jb == 2 * qb + 1 && wave < 4) { if (lane == 0) MINR[wave] = 0.f; continue; }
            float z[16];
#pragma unroll
            for (int i = 0; i < 4; ++i) { const LAS bf16* kp = Ks + (16 * (l15 >> 2) + 4 * i + (l15 & 3)) * 72 + 8 * g;
                f32x4 a = {0.f, 0.f, 0.f, 0.f};
                a = __builtin_amdgcn_mfma_f32_16x16x32_bf16(*(const LAS bf16x8*)kp, q0, a, 0, 0, 0);
                a = __builtin_amdgcn_mfma_f32_16x16x32_bf16(*(const LAS bf16x8*)(kp + 32), q1, a, 0, 0, 0);
                z[4 * i + 0] = a[0] * 0.125f; z[4 * i + 1] = a[1] * 0.125f; z[4 * i + 2] = a[2] * 0.125f; z[4 * i + 3] = a[3] * 0.125f; }
            const int kbase = (jb >= 0) ? 64 * jb + 16 * g : 16 * g;
            float cum[16]; float run = 0.f;
#pragma unroll
            for (int n = 15; n >= 0; --n) { const bool ok = (jb >= 0) ? (kbase + n < tq) : (kbase + n < NMETA);
                const float zz = z[n]; const float sp = fmaxf(zz, 0.f) + __logf(1.f + __expf(-fabsf(zz)));
                run += ok ? sp : 0.f; cum[n] = run; }
            const float t1 = __shfl(run, (lane + 16) & 63), t2 = __shfl(run, (lane + 32) & 63), t3 = __shfl(run, (lane + 48) & 63);
            const float higher = (g < 3 ? t1 : 0.f) + (g < 2 ? t2 : 0.f) + (g < 1 ? t3 : 0.f);
            const float lower = (g >= 1 ? t3 : 0.f) + (g >= 2 ? t2 : 0.f) + (g >= 3 ? t1 : 0.f);
            const float base = R + higher;
            float av[16];
#pragma unroll
            for (int n = 0; n < 16; ++n) { const bool ok = (jb >= 0) ? (kbase + n < tq) : (kbase + n < NMETA); av[n] = ok ? __expf(z[n] - (base + cum[n])) : 0.f; }
            R += run + higher + lower;
#pragma unroll
            for (int ks = 0; ks < 2; ++ks) { v4u bw; bw.x = pk2(av[8 * ks + 0], av[8 * ks + 1]); bw.y = pk2(av[8 * ks + 2], av[8 * ks + 3]); bw.z = pk2(av[8 * ks + 4], av[8 * ks + 5]); bw.w = pk2(av[8 * ks + 6], av[8 * ks + 7]);
                const bf16x8 bfr = __builtin_bit_cast(bf16x8, bw);
#pragma unroll
                for (int et = 0; et < 4; ++et) { const bf16x8 afr = *(const LAS bf16x8*)(VT + (16 * et + l15) * 72 + 16 * g + 8 * ks); o[et] = __builtin_amdgcn_mfma_f32_16x16x32_bf16(afr, bfr, o[et], 0, 0, 0); } }
            const float wm = fminf(fminf(__shfl_xor(R, 1), R), 1e30f);
            float rm = R;
#pragma unroll
            for (int of = 1; of < 16; of <<= 1) rm = fminf(rm, __shfl_xor(rm, of));
            (void)wm;
            if (lane == 0) MINR[wave] = rm;
        }
        float ss = 0.f;
#pragma unroll
        for (int et = 0; et < 4; ++et) ss += (o[et][0] * o[et][0] + o[et][1] * o[et][1]) + (o[et][2] * o[et][2] + o[et][3] * o[et][3]);
        ss += __shfl_xor(ss, 16); ss += __shfl_xor(ss, 32);
        const float rstd = 1.0f / sqrtf(ss * (1.0f / 64.0f) + EPS);
#pragma unroll
        for (int et = 0; et < 4; ++et) { const int e = 16 * et + 4 * g; const f32x4 gg = *(const f32x4*)(F.sb_g + hd * 64 + e);
            v2u w; w.x = pk2(o[et][0] * rstd * gg[0], o[et][1] * rstd * gg[1]); w.y = pk2(o[et][2] * rstd * gg[2], o[et][3] * rstd * gg[3]);
            *(v2u*)(PR + qrow + CQS + hd * 64 + e) = w; }
    }
#undef SB_FETCH
    __syncthreads();
}

__device__ __forceinline__ void p3_scan(Frame& F) {
    const int bh = F.vcu >> 5, h = bh & 3, tid = F.tid, lane = F.lane;
    LAS float* DEC = (LAS float*)F.lds; LAS float* SCL = DEC + 128; LAS float* WM = DEC + 256;
    const float* PRM = WSP(float, WS_PRM);
    __syncthreads();
    if (F.wave == 0) {
        float li = -INFINITY, lf = 0.f;
        if (lane < NMETA) { li = PRM[(size_t)lane * NIN + OI_ + h] + F.b_i[h]; lf = logsigmoidf_(PRM[(size_t)lane * NIN + OF_ + h] + F.b_f[h]); }
        float bs = lf;
#pragma unroll
        for (int o = 1; o < 64; o <<= 1) { const float t = __shfl_up(bs, o); if (lane >= o) bs += t; }
        const float bL = __shfl(bs, 63); const float gg = bL - bs + li; float M = fmaxf(bL, wave_max(gg));
        if (lane < NMETA) WM[lane] = __expf(gg - M);
        const float* AC = WSP(float, WS_AC) + bh * 128; const float* BC = WSP(float, WS_BC) + bh * 128;
        for (int c = 0; c < 128; ++c) { const float a = AC[c], bc = BC[c]; const float Mn = fmaxf(M + a, bc);
            if (lane == 0) { DEC[c] = __expf(a + M - Mn); SCL[c] = __expf(bc - Mn); if ((F.vcu & 31) == 0) WSP(float, WS_MIN)[bh * 128 + c] = M; }
            M = Mn; }
    }
    __syncthreads();
    const int elem = (F.vcu & 31) * 512 + tid, e = elem >> 7, d = elem & 127;
    const float* KM = WSP(float, WS_KM) + (size_t)h * 16 * 128;
    float C = 0.f;
#pragma unroll
    for (int s = 0; s < NMETA; ++s) C += WM[s] * PRM[(size_t)s * NIN + OV_ + h * 128 + e] * KM[s * 128 + d];
    bf16* U = WSP(bf16, WS_U) + (size_t)bh * 128 * 16384 + elem;
    for (int c0 = 0; c0 < 128; c0 += 16) {
        unsigned short u[16];
#pragma unroll
        for (int j = 0; j < 16; ++j) u[j] = U[(size_t)(c0 + j) * 16384];
#pragma unroll
        for (int j = 0; j < 16; ++j) { U[(size_t)(c0 + j) * 16384] = (bf16)f2bf(C); C = DEC[c0 + j] * C + SCL[c0 + j] * bf2f(u[j]); }
    }
    if ((F.vcu & 31) == 0 && tid < 128) {
        float n = 0.f;
#pragma unroll
        for (int s = 0; s < NMETA; ++s) n += WM[s] * KM[s * 128 + tid];
        const float* NU = WSP(float, WS_NU) + (size_t)bh * 128 * 128 + tid; float* NS = WSP(float, WS_NS) + (size_t)bh * 128 * 128 + tid;
        for (int c = 0; c < 128; ++c) { NS[c * 128] = n; n = DEC[c] * n + SCL[c] * NU[c * 128]; }
    }
    __syncthreads();
}

constexpr int L4_Q = 0, L4_K = 17408, L4_VT = 34816, L4_CS = 53248, L4_S = 88064, L4_TAB = 97280;
__device__ __forceinline__ void p4_mlstm_out(Frame& F) {
    const int bh = F.vcu >> 5, b = bh >> 2, h = bh & 3, tid = F.tid, lane = F.lane, wave = F.wave, g = lane >> 4, l15 = lane & 15;
    LAS bf16* Qs = (LAS bf16*)(F.lds + L4_Q); LAS bf16* Ks = (LAS bf16*)(F.lds + L4_K); LAS bf16* VT = (LAS bf16*)(F.lds + L4_VT);
    LAS bf16* CS = (LAS bf16*)(F.lds + L4_CS); LAS bf16* Ss = (LAS bf16*)(F.lds + L4_S); LAS float* T = (LAS float*)(F.lds + L4_TAB);
    bf16* PR = WSP(bf16, WS_PR);
    const bf16* Qg = WSP(bf16, WS_QK); const bf16* Kg = Qg + (size_t)MROWS * 512;
    for (int ui = 0; ui < 4; ++ui) {
        const int chunk = (F.vcu & 31) + 32 * ui; const int m0 = b * SEQ + chunk * 64; const int uc = bh * 128 + chunk;
        __syncthreads();
        for (int i = tid; i < 1024; i += NTHR) { const int t = i >> 4, c8 = (i & 15) * 8; const size_t go = (size_t)(m0 + t) * 512 + h * 128 + c8;
            *(LAS v4u*)(Qs + t * 136 + c8) = *(const v4u*)(Qg + go); *(LAS v4u*)(Ks + t * 136 + c8) = *(const v4u*)(Kg + go); }
        for (int i = tid; i < 2048; i += NTHR) { const int e = i >> 4, c8 = (i & 15) * 8; *(LAS v4u*)(CS + e * 136 + c8) = *(const v4u*)(WSP(bf16, WS_U) + (size_t)uc * 16384 + e * 128 + c8); }
        for (int i = tid; i < 1024; i += NTHR) { const int s = i >> 4, e8 = (i & 15) * 8; const v4u pv = *(const v4u*)(PR + (size_t)(m0 + s) * NPROJ + CV_ + h * 128 + e8);
#pragma unroll
            for (int q = 0; q < 4; ++q) { VT[(e8 + 2 * q) * 72 + s] = (bf16)(pv[q] & 0xffffu); VT[(e8 + 2 * q + 1) * 72 + s] = (bf16)(pv[q] >> 16); } }
        if (tid < 64) { T[tid] = WSP(float, WS_BT)[(m0 + tid) * 4 + h]; T[64 + tid] = WSP(float, WS_GI)[(m0 + tid) * 4 + h]; }
        if (tid >= 128 && tid < 256) T[640 + tid - 128] = WSP(float, WS_NS)[(size_t)uc * 128 + tid - 128];
        const float Min = WSP(float, WS_MIN)[uc];
        __syncthreads();
        if (wave == 0) {
            const float bt = T[lane], li = T[64 + lane]; float pm = li - bt;
#pragma unroll
            for (int o = 1; o < 64; o <<= 1) { const float t = __shfl_up(pm, o); if (lane >= o) pm = fmaxf(pm, t); }
            const float Mt = bt + fmaxf(Min, pm);
            T[128 + lane] = Mt; T[192 + lane] = __expf(bt + Min - Mt);
        }
        { const int t = tid >> 3, part = tid & 7; float s = 0.f;
#pragma unroll
          for (int j = 0; j < 16; ++j) s += bf2f(Qs[t * 136 + part * 16 + j]) * T[640 + part * 16 + j];
          s += __shfl_xor(s, 1); s += __shfl_xor(s, 2); s += __shfl_xor(s, 4);
          if (part == 0) T[256 + t] = s; }
        __syncthreads();
#pragma unroll
        for (int j = 0; j < 2; ++j) { const int tt = wave >> 1, st = 2 * (wave & 1) + j; f32x4 a = {0.f, 0.f, 0.f, 0.f};
            a = mma_rows<4>(Qs + (16 * tt + l15) * 136 + 8 * g, Ks + (16 * st + l15) * 136 + 8 * g, a);
            const int s = 16 * st + l15; const float cs = T[64 + s] - T[s];
#pragma unroll
            for (int r = 0; r < 4; ++r) { const int t = 16 * tt + 4 * g + r; const float wgt = (s <= t) ? __expf(T[t] + cs - T[128 + t]) : 0.f; const float v = a[r] * wgt;
                Ss[t * 72 + s] = (bf16)f2bf(v); float rs = v; rs += __shfl_xor(rs, 1); rs += __shfl_xor(rs, 2); rs += __shfl_xor(rs, 4); rs += __shfl_xor(rs, 8);
                if (l15 == 0) T[384 + st * 64 + t] = rs; } }
        __syncthreads();
        if (tid < 64) { const float den = T[192 + tid] * T[256 + tid] + (T[384 + tid] + T[448 + tid]) + (T[512 + tid] + T[576 + tid]); T[320 + tid] = 1.0f / fmaxf(fabsf(den), __expf(-T[128 + tid])); }
        f32x4 acc[4];
        const int tt = wave >> 1, tl = 16 * tt + l15;
#pragma unroll
        for (int j = 0; j < 4; ++j) { const int et = 4 * (wave & 1) + j; f32x4 a = {0.f, 0.f, 0.f, 0.f};
            a = mma_rows<4>(CS + (16 * et + l15) * 136 + 8 * g, Qs + (16 * tt + l15) * 136 + 8 * g, a);
            a = a * T[192 + tl];
            a = mma_rows<2>(VT + (16 * et + l15) * 72 + 8 * g, Ss + (16 * tt + l15) * 72 + 8 * g, a);
            acc[j] = a; }
        __syncthreads();
        float ps = 0.f, pq = 0.f; const float invd = T[320 + tl];
        const size_t orow = (size_t)(m0 + tl) * NPROJ + CO_ + h * 128, crow = (size_t)(m0 + tl) * 512 + h * 128;
#pragma unroll
        for (int j = 0; j < 4; ++j) { const int e0 = 16 * (4 * (wave & 1) + j) + 4 * g; const v2u opk = *(const v2u*)(PR + orow + e0);
            const float op[4] = {bf2f(opk[0] & 0xffffu), __uint_as_float(opk[0] & 0xffff0000u), bf2f(opk[1] & 0xffffu), __uint_as_float(opk[1] & 0xffff0000u)};
#pragma unroll
            for (int r = 0; r < 4; ++r) { const float hv = acc[j][r] * invd / (1.f + __expf(-op[r])); acc[j][r] = hv; ps += hv; pq += hv * hv; } }
        ps += __shfl_xor(ps, 16); ps += __shfl_xor(ps, 32); pq += __shfl_xor(pq, 16); pq += __shfl_xor(pq, 32);
        if (g == 0) { T[768 + (wave & 1) * 64 + tl] = ps; T[896 + (wave & 1) * 64 + tl] = pq; }
        __syncthreads();
        { const float mu = (T[768 + tl] + T[832 + tl]) * (1.f / 128.f); const float var = (T[896 + tl] + T[960 + tl]) * (1.f / 128.f) - mu * mu; const float rsd = 1.0f / sqrtf(fmaxf(var, 0.f) + EPS);
#pragma unroll
          for (int j = 0; j < 4; ++j) { const int e0 = 16 * (4 * (wave & 1) + j) + 4 * g; const f32x4 gn = *(const f32x4*)(F.gn_g + h * 128 + e0), sk = *(const f32x4*)(F.skip + h * 128 + e0);
              const v2u cpk = *(const v2u*)(WSP(bf16, WS_CB) + crow + e0);
              const float cv[4] = {bf2f(cpk[0] & 0xffffu), __uint_as_float(cpk[0] & 0xffff0000u), bf2f(cpk[1] & 0xffffu), __uint_as_float(cpk[1] & 0xffff0000u)};
              float y[4];
#pragma unroll
              for (int r = 0; r < 4; ++r) y[r] = (acc[j][r] - mu) * rsd * gn[r] + sk[r] * cv[r];
              v2u o; o[0] = pk2(y[0], y[1]); o[1] = pk2(y[2], y[3]); *(v2u*)(PR + orow + e0) = o; } }
    }
    __syncthreads();
}

constexpr int L7_SK = 0, L7_LS = 69632;
__device__ __forceinline__ int pack_key(float v, int idx, unsigned mask) { int k = (int)((__builtin_bit_cast(unsigned, v) & ~mask) | (unsigned)idx); return k < 0 ? (k ^ 0x7fffffff) : k; }
__device__ __forceinline__ float key_val(int k, unsigned mask) { const int u = k < 0 ? (k ^ 0x7fffffff) : k; return __builtin_bit_cast(float, (unsigned)u & ~mask); }
__device__ __forceinline__ int key_idx(int k, unsigned mask) { const int u = k < 0 ? (k ^ 0x7fffffff) : k; return (int)((unsigned)u & mask); }
__device__ __forceinline__ void bitonic_sort16_desc(int (&t)[16]) {
#pragma unroll
    for (int k = 2; k <= 16; k <<= 1)
#pragma unroll
        for (int j = k >> 1; j > 0; j >>= 1)
#pragma unroll
            for (int i = 0; i < 16; ++i) { const int l = i ^ j; if (l > i) { const bool desc = ((i & k) == 0); const int hi = max(t[i], t[l]), lo = min(t[i], t[l]); t[i] = desc ? hi : lo; t[l] = desc ? lo : hi; } }
}
__device__ __forceinline__ void bitonic_merge16_desc(int (&t)[16]) {
#pragma unroll
    for (int j = 8; j > 0; j >>= 1)
#pragma unroll
        for (int i = 0; i < 16; ++i) { const int l = i ^ j; if (l > i) { const int hi = max(t[i], t[l]), lo = min(t[i], t[l]); t[i] = hi; t[l] = lo; } }
}
#define TOPK_INS(t, x) do { int _x = (x); _Pragma("unroll") for (int _i = 0; _i < 16; ++_i) { const int _hi = max(t[_i], _x); _x = min(t[_i], _x); t[_i] = _hi; } } while (0)
__device__ __forceinline__ void p7_topk(Frame& F) {
    const int tid = F.tid, lane = F.lane, wave = F.wave, g = lane >> 4, l15 = lane & 15;
    LAS bf16* SK = (LAS bf16*)(F.lds + L7_SK); LAS int* LS = (LAS int*)(F.lds + L7_LS); LAS int* HIST = (LAS int*)(F.lds + L7_LS + 65536);
    const bf16* QP = WSP(bf16, WS_QP);
    __syncthreads();
    for (int i = tid; i < 4096; i += NTHR) { const int row = i >> 4, c8 = (i & 15) * 8; *(LAS v4u*)(SK + row * 136 + c8) = *(const v4u*)(WSP(bf16, WS_SKB) + (size_t)row * 128 + c8); }
    __syncthreads();
    for (int unit = F.vcu; unit < MROWS / 64; unit += F.G) {
        const int tok0 = unit * 64, h = wave;
        for (int i = tid; i < 2048; i += NTHR) HIST[i] = 0;
        bf16x8 qf[4], qn[4];
        { const bf16* qrow = QP + (size_t)(tok0 + l15) * 2048 + h * 256 + 8 * g;
#pragma unroll
          for (int k = 0; k < 4; ++k) qf[k] = *(const bf16x8*)(qrow + 32 * k); }
#pragma unroll 1
        for (int it = 0; it < 8; ++it) {
            const int p = it >> 2, tt = it & 3;
            if (it + 1 < 8) { const int p2 = (it + 1) >> 2, tt2 = (it + 1) & 3; const bf16* qrow = QP + (size_t)(tok0 + 16 * tt2 + l15) * 2048 + h * 256 + p2 * 128 + 8 * g;
#pragma unroll
                for (int k = 0; k < 4; ++k) qn[k] = *(const bf16x8*)(qrow + 32 * k); }
            int ta[16], tb[16];
#pragma unroll
            for (int kt = 0; kt < 8; ++kt) { f32x4 a = {0.f, 0.f, 0.f, 0.f}; const LAS bf16* sk = SK + (p * 128 + 16 * kt + l15) * 136 + 8 * g;
#pragma unroll
                for (int k = 0; k < 4; ++k) a = __builtin_amdgcn_mfma_f32_16x16x32_bf16(*(const LAS bf16x8*)(sk + 32 * k), qf[k], a, 0, 0, 0);
#pragma unroll
                for (int r = 0; r < 4; ++r) { const int key = pack_key(a[r], 16 * kt + 4 * g + r, 127u); if (kt < 4) ta[4 * kt + r] = key; else tb[4 * (kt - 4) + r] = key; } }
            bitonic_sort16_desc(ta); bitonic_sort16_desc(tb);
#pragma unroll
            for (int i = 0; i < 16; ++i) ta[i] = max(ta[i], tb[15 - i]);
            bitonic_merge16_desc(ta);
#pragma unroll
            for (int dd = 16; dd <= 32; dd <<= 1) {
#pragma unroll
                for (int i = 0; i < 16; ++i) tb[i] = __shfl_xor(ta[i], dd);
#pragma unroll
                for (int i = 0; i < 16; ++i) ta[i] = max(ta[i], tb[15 - i]);
                bitonic_merge16_desc(ta); }
            if (g == 0) { LAS int* dst = LS + (((16 * tt + l15) * 8 + h) * 2 + p) * 16;
#pragma unroll
                for (int i = 0; i < 16; ++i) dst[i] = ta[i]; }
#pragma unroll
            for (int k = 0; k < 4; ++k) qf[k] = qn[k];
        }
        __syncthreads();
        { const int tok = tid >> 3, h2 = tid & 7; const LAS int* la = LS + ((tok * 8 + h2) * 2 + 0) * 16; const LAS int* lb = la + 16;
          float av[16], bv[16];
#pragma unroll
          for (int i = 0; i < 16; ++i) { av[i] = key_val(la[i], 127u); bv[i] = key_val(lb[i], 127u); }
          int top[16];
#pragma unroll
          for (int i = 0; i < 16; ++i) top[i] = (int)0x80000000;
#pragma unroll
          for (int i = 0; i < 16; ++i)
#pragma unroll
              for (int j = 0; j < 16; ++j) if ((i + 1) * (j + 1) <= 16) TOPK_INS(top, pack_key(av[i] + bv[j], i * 16 + j, 255u));
          const float vmax = key_val(top[0], 255u); float ev[16]; float z = 0.f;
#pragma unroll
          for (int k = 0; k < 16; ++k) { ev[k] = __expf(key_val(top[k], 255u) - vmax); z += ev[k]; }
          const float rz = 1.0f / z;
          int eidx[16]; float gate[16];
#pragma unroll
          for (int k = 0; k < 16; ++k) { const int ij = key_idx(top[k], 255u); const int ei = key_idx(la[ij >> 4], 127u), ej = key_idx(lb[ij & 15], 127u);
              eidx[k] = ei * 128 + ej; gate[k] = ev[k] * rz; __hip_atomic_fetch_add(HIST + tok * 32 + (eidx[k] >> 9), 1, __ATOMIC_RELAXED, __HIP_MEMORY_SCOPE_WORKGROUP); }
          __syncthreads();
          if (tid < 64) { int run = 0;
#pragma unroll
              for (int b = 0; b < 32; ++b) { const int c = HIST[tid * 32 + b]; HIST[tid * 32 + b] = run; run += c; } }
          __syncthreads();
          if (h2 == 0) { const f32x4* q = (const f32x4*)(WSP(float, WS_SSQ) + (size_t)(tok0 + tok) * 16); float ssq = 0.f;
#pragma unroll
              for (int j = 0; j < 4; ++j) { const f32x4 a = q[j]; ssq += (a[0] + a[1]) + (a[2] + a[3]); }
              WSP(float, WS_RS2)[tok0 + tok] = 1.0f / sqrtf(ssq * (1.0f / DM) + EPS); }
          v2u* tk = (v2u*)WSP(unsigned, WS_TK) + (size_t)(tok0 + tok) * 128;
#pragma unroll
          for (int k = 0; k < 16; ++k) { const int pos = __hip_atomic_fetch_add(HIST + tok * 32 + (eidx[k] >> 9), 1, __ATOMIC_RELAXED, __HIP_MEMORY_SCOPE_WORKGROUP);
              v2u o; o.x = (unsigned)eidx[k]; o.y = __builtin_bit_cast(unsigned, gate[k]); tk[pos] = o; } }
        asm volatile("s_waitcnt vmcnt(0)" ::: "memory");
        __syncthreads();
    }
}

__device__ __forceinline__ float gelu_erf(float v) { return 0.5f * v * (1.0f + erff(v * 0.70710678118654752f)); }
typedef float f32x2v __attribute__((ext_vector_type(2)));
#define P8_LOAD8(RB, G) P8_LOAD8X(RB, G, e0.x, e1.x)
#define P8_LOAD8X(RB, G, EX0, EX1) do { if ((G) < 32) { const unsigned char* _tab = ((G) < 16) ? EU : EV; _Pragma("unroll") for (int _j = 0; _j < 8; ++_j) { const int _k = 8 * ((G) & 15) + _j; const unsigned _s = (_k < 64) ? (EX0) : (EX1); \
        const unsigned _ei = (unsigned)__builtin_amdgcn_readlane((int)_s, _k & 63); RB[_j] = *(const v2u*)(_tab + (size_t)_ei * (DM / 2) + 8 * lane); } } } while (0)
__device__ __forceinline__ float gelu_as(float v) {
    const float av = fabsf(v), t = __builtin_amdgcn_rcpf(av * 0.2316418882f + 1.0f);
    float q = t * 0.5307027145f + (-0.7265760135f); q = q * t + 0.7107068705f; q = q * t + (-0.142248368f); q = q * t + 0.127414796f; q = q * t;
    const float m = v * (q * __builtin_amdgcn_exp2f((v * v) * (-0.72134752044f)));
    return v < 0.f ? m : v - m;
}
__device__ __forceinline__ float reduce8_butterfly(const float (&d)[8], int lane) {
    const bool b5 = (lane & 32) != 0, b4 = (lane & 16) != 0, b3 = (lane & 8) != 0;
    float k4[4];
#pragma unroll
    for (int i = 0; i < 4; ++i) { const float snd = b5 ? d[i] : d[i + 4], kp = b5 ? d[i + 4] : d[i]; k4[i] = kp + __shfl_xor(snd, 32); }
    float k2[2];
#pragma unroll
    for (int i = 0; i < 2; ++i) { const float snd = b4 ? k4[i] : k4[i + 2], kp = b4 ? k4[i + 2] : k4[i]; k2[i] = kp + __shfl_xor(snd, 16); }
    float k1; { const float snd = b3 ? k2[0] : k2[1], kp = b3 ? k2[1] : k2[0]; k1 = kp + __shfl_xor(snd, 8); }
    k1 += __shfl_xor(k1, 4); k1 += __shfl_xor(k1, 2); k1 += __shfl_xor(k1, 1);
    return k1;
}
#define P8_UDOT(UB, G) do { _Pragma("unroll") for (int _j = 0; _j < 8; ++_j) { \
            int _sh = __builtin_amdgcn_sdot8((int)UB[_j][0], (int)xh0, 0, false); _sh = __builtin_amdgcn_sdot8((int)UB[_j][1], (int)xh1, _sh, false); \
            int _sl = __builtin_amdgcn_sdot8((int)UB[_j][0], (int)xl0, 0, false); _sl = __builtin_amdgcn_sdot8((int)UB[_j][1], (int)xl1, _sl, false); const int _s = (_sh << 4) + _sl; \
            red[(8 * ((G) & 7) + _j) * 65 + lane] = (float)_s; } \
        if (((G) & 7) == 7) { float _t0 = 0.f, _t1 = 0.f, _t2 = 0.f, _t3 = 0.f; _Pragma("unroll") for (int _i = 0; _i < 64; _i += 4) { _t0 += red[lane * 65 + _i]; _t1 += red[lane * 65 + _i + 1]; _t2 += red[lane * 65 + _i + 2]; _t3 += red[lane * 65 + _i + 3]; } \
            const float _dl = (_t0 + _t1) + (_t2 + _t3); const bool _c1 = (G) >= 8; const float _gl = __uint_as_float(_c1 ? e1.y : e0.y), _su = __uint_as_float(_c1 ? s1x : s0x); \
            const float _cv = _gl * gelu_as((_dl + hsx) * _su * rsx) * 0.25f; if (_c1) c1 = _cv; else c0 = _cv; } } while (0)
#define P8_FP4ACC(w, sel, i0) { const f32x2v _f = __builtin_amdgcn_cvt_scalef32_pk_f32_fp4((w), 1.0f, sel); acc[i0] += _c * _f[0]; acc[(i0) + 1] += _c * _f[1]; }
#define P8_VACC(VB, G) do { const int _g = (G) - 16; const float _csrc = (_g < 8) ? c0 : c1; _Pragma("unroll") for (int _j = 0; _j < 8; ++_j) { \
            asm volatile("" : "+v"(VB[_j][0]), "+v"(VB[_j][1]) : "v"(acc[0]), "v"(acc[5]), "v"(acc[10]), "v"(acc[15])); \
            const float _c = __uint_as_float((unsigned)__builtin_amdgcn_readlane((int)__float_as_uint(_csrc), 8 * (_g & 7) + _j)); \
            P8_FP4ACC(VB[_j][0], 0, 0) P8_FP4ACC(VB[_j][0], 1, 2) P8_FP4ACC(VB[_j][0], 2, 4) P8_FP4ACC(VB[_j][0], 3, 6) P8_FP4ACC(VB[_j][1], 0, 8) P8_FP4ACC(VB[_j][1], 1, 10) P8_FP4ACC(VB[_j][1], 2, 12) P8_FP4ACC(VB[_j][1], 3, 14) } } while (0)
typedef int v8i __attribute__((ext_vector_type(8)));
#define P8_CLOAD_V(RB, PC, H) do { _Pragma("unroll") for (int _r = 0; _r < 8; ++_r) RB[_r] = *(const v4u*)(EV + (size_t)vofv[H][_r] + 128 * (PC)); } while (0)
#define P8_SLAB(RB, PC, H, FIRST) do { \
        _Pragma("unroll") for (int _r = 0; _r < 8; ++_r) { v4u _w = RB[_r]; if (_r >= 4) { const unsigned _t0 = _w[0], _t1 = _w[1]; _w[0] = _w[2]; _w[1] = _w[3]; _w[2] = _t0; _w[3] = _t1; } \
            *(LAS v4u*)(SLB + ((_r & 1) ? wa1 : wa0) + 1024 * _r) = _w; } \
        _Pragma("unroll") for (int _i = 0; _i < 16; ++_i) { const int _cb = 4 * (_i & 3) + (_i >> 2); const int _ta = (tb ^ (16 * (_cb >> 1))) ^ (8 * (_cb & 1)); \
            const v2i_t _t0 = __builtin_amdgcn_ds_read_tr4_b64_v2i32((LAS v2i_t*)(SLB + _ta)); const v2i_t _t1 = __builtin_amdgcn_ds_read_tr4_b64_v2i32((LAS v2i_t*)(SLB + _ta + 2048)); \
            v8i _b, _a; _b[0] = _t0[0]; _b[1] = _t0[1]; _b[2] = _t1[0]; _b[3] = _t1[1]; _b[4] = 0; _b[5] = 0; _b[6] = 0; _b[7] = 0; \
            const bool _keep = (ln >> 2) == (_cb & 3); _a[0] = _keep ? (int)ah[H][0] : 0; _a[1] = _keep ? (int)ah[H][1] : 0; _a[2] = _keep ? (int)ah[H][2] : 0; _a[3] = _keep ? (int)ah[H][3] : 0; _a[4] = 0; _a[5] = 0; _a[6] = 0; _a[7] = 0; \
            if ((FIRST) && (_cb & 3) == 0) { const f32x4 _z = {0.f, 0.f, 0.f, 0.f}; vacc[_cb >> 2] = _z; } \
            vacc[_cb >> 2] = __builtin_amdgcn_mfma_scale_f32_16x16x128_f8f6f4(_a, _b, vacc[_cb >> 2], 0, 4, 0, 0, 0, 0); } } while (0)
#define P8_VOUT(PC) do { _Pragma("unroll") for (int _a = 0; _a < 4; ++_a) OT[oto + 64 * (PC) + 16 * _a] = vacc[_a][0] + vacc[_a][1]; } while (0)
typedef int v2i_t __attribute__((ext_vector_type(2)));
__device__ __forceinline__ void p8_gather(Frame& F) {
    const int lane = F.lane; const int gw = F.vcu * NWAVES + F.wave, NGW = F.G * NWAVES;
    const unsigned char* EU = F.ws + WS_EU; const unsigned char* EV = F.ws + WS_EV; const bf16* H1B = WSP(bf16, WS_H1B);
    const unsigned long long* tkb = (const unsigned long long*)WSP(unsigned, WS_TK);
    unsigned long long nt0 = tkb[(size_t)(gw * 8) * 128 + lane], nt1 = tkb[(size_t)(gw * 8) * 128 + 64 + lane];
    v2u nx[4];
#pragma unroll
    for (int j = 0; j < 4; ++j) nx[j] = *(const v2u*)(H1B + (size_t)(gw * 8) * DM + 256 * j + 4 * lane);
    float nrs = WSP(float, WS_RS2)[gw * 8];
    const float* esc = WSP(float, WS_ESC);
    LAS float* red = (LAS float*)(F.lds + F.wave * 16640);
    LAS unsigned char* WL = F.lds + F.wave * 16640;
    LAS unsigned char* CTB = WL; LAS float* OT = (LAS float*)(WL + 1024); LAS unsigned char* SLB = WL + 8192;
    const int lq = lane >> 4, ln = lane & 15;
    const int cta = ((ln & 3) < 2 ? 128 * (ln & 3) : 256) + 16 * lq;
    const int wa0 = 128 * (lane >> 3) + 16 * ((lane & 7) ^ (lane >> 4)), wa1 = 128 * (lane >> 3) + 16 * ((lane & 7) ^ (4 + (lane >> 4)));
    const int tb = (32 * (lq & 1) + ln) * 128 + 16 * ((ln >> 1) & 7) + 8 * (lq & 1);
    const int oto = 256 * (ln >> 2) + 4 * lq + (ln & 3);
    f32x4 vacc[4];
    __syncthreads();
    float ns0x = esc[(unsigned)nt0], ns1x = esc[(unsigned)nt1];
    v2u b0[8], b1[8], b2[8];
    P8_LOAD8X(b0, 0, (unsigned)nt0, (unsigned)nt1); P8_LOAD8X(b1, 1, (unsigned)nt0, (unsigned)nt1);
    for (int tok = gw * 8; tok < gw * 8 + 8; ++tok) {
        float xf[16];
#pragma unroll
        for (int j = 0; j < 4; ++j) { const v2u xr = nx[j];
            xf[4 * j] = bf2f(xr[0] & 0xffffu); xf[4 * j + 1] = __uint_as_float(xr[0] & 0xffff0000u); xf[4 * j + 2] = bf2f(xr[1] & 0xffffu); xf[4 * j + 3] = __uint_as_float(xr[1] & 0xffff0000u); }
        v2u e0, e1; e0.x = (unsigned)nt0; e0.y = (unsigned)(nt0 >> 32); e1.x = (unsigned)nt1; e1.y = (unsigned)(nt1 >> 32);
        const unsigned s0x = __float_as_uint(ns0x), s1x = __float_as_uint(ns1x);
        float amax = 0.f;
#pragma unroll
        for (int i = 0; i < 16; ++i) amax = fmaxf(amax, fabsf(xf[i]));
        amax = wave_max(amax); const float sx = amax > 0.f ? 119.0f / amax : 1.0f;
        int sxl = 0; unsigned xh0 = 0u, xh1 = 0u, xl0 = 0u, xl1 = 0u;
#pragma unroll
        for (int i = 0; i < 16; ++i) { const int q = (int)rintf(xf[i] * sx); sxl += q; const int l = ((q + 8) & 15) - 8, h = (q - l) >> 4;
            if (i < 8) { xl0 |= ((unsigned)l & 15u) << (4 * i); xh0 |= ((unsigned)h & 15u) << (4 * i); } else { xl1 |= ((unsigned)l & 15u) << (4 * (i - 8)); xh1 |= ((unsigned)h & 15u) << (4 * (i - 8)); } }
        const float hsx = 0.5f * wave_sum((float)sxl);
        const float rsx = nrs / sx;
        float c0 = 0.f, c1 = 0.f;
        P8_LOAD8(b2, 2); P8_UDOT(b0, 0);
        P8_LOAD8(b0, 3); P8_UDOT(b1, 1);
        P8_LOAD8(b1, 4); P8_UDOT(b2, 2);
        P8_LOAD8(b2, 5); P8_UDOT(b0, 3);
        P8_LOAD8(b0, 6); P8_UDOT(b1, 4);
        P8_LOAD8(b1, 7); P8_UDOT(b2, 5);
        P8_LOAD8(b2, 8); P8_UDOT(b0, 6);
        P8_LOAD8(b0, 9); P8_UDOT(b1, 7);
        P8_LOAD8(b1, 10); P8_UDOT(b2, 8);
        P8_LOAD8(b2, 11); P8_UDOT(b0, 9);
        P8_LOAD8(b0, 12); P8_UDOT(b1, 10);
        P8_LOAD8(b1, 13); P8_UDOT(b2, 11);
        P8_LOAD8(b2, 14); P8_UDOT(b0, 12);
        P8_LOAD8(b0, 15); P8_UDOT(b1, 13);
        unsigned vofv[2][8];
#pragma unroll
        for (int h = 0; h < 2; ++h)
#pragma unroll
            for (int r = 0; r < 8; ++r) vofv[h][r] = (unsigned)__builtin_amdgcn_ds_bpermute(4 * (8 * r + (lane >> 3)), (int)(h ? e1.x : e0.x)) * 512u + 16u * (lane & 7);
        v4u sa[8], sb[8];
        P8_CLOAD_V(sa, 0, 0);
        P8_UDOT(b2, 14);
        P8_CLOAD_V(sb, 0, 1);
        P8_UDOT(b0, 15);
        asm volatile("" ::: "memory");
        const int tokn = tok + 1 < gw * 8 + 8 ? tok + 1 : tok;
        nt0 = tkb[(size_t)tokn * 128 + lane]; nt1 = tkb[(size_t)tokn * 128 + 64 + lane];
#pragma unroll
        for (int j = 0; j < 4; ++j) nx[j] = *(const v2u*)(H1B + (size_t)tokn * DM + 256 * j + 4 * lane);
        nrs = WSP(float, WS_RS2)[tokn];
        const float cmax = wave_max(fmaxf(fabsf(c0), fabsf(c1))); const float sc = cmax > 0.f ? 256.0f / cmax : 1.0f, rsc = 1.0f / sc;
        { const float a0 = c0 * sc, a1 = c1 * sc; const int h = __builtin_amdgcn_cvt_pk_fp8_f32(a0, a1, 0, false);
          const f32x2v rb = __builtin_amdgcn_cvt_pk_f32_fp8(h, false); const int l = __builtin_amdgcn_cvt_pk_fp8_f32(a0 - rb[0], a1 - rb[1], 0, false);
          CTB[lane] = (unsigned char)(h & 0xff); CTB[64 + lane] = (unsigned char)((h >> 8) & 0xff); CTB[128 + lane] = (unsigned char)(l & 0xff); CTB[192 + lane] = (unsigned char)((l >> 8) & 0xff);
          if (lane < 8) { v4u z; z[0] = 0u; z[1] = 0u; z[2] = 0u; z[3] = 0u; *(LAS v4u*)(CTB + 256 + 16 * lane) = z; } }
        v4u ah[2];
#pragma unroll
        for (int h = 0; h < 2; ++h) ah[h] = *(const LAS v4u*)(CTB + cta + 64 * h);
        P8_SLAB(sa, 0, 0, true);  P8_CLOAD_V(sa, 1, 0);
        P8_SLAB(sb, 0, 1, false); P8_CLOAD_V(sb, 1, 1);  P8_VOUT(0);
        P8_SLAB(sa, 1, 0, true);  P8_CLOAD_V(sa, 2, 0);
        P8_SLAB(sb, 1, 1, false); P8_CLOAD_V(sb, 2, 1);  P8_VOUT(1);
        P8_SLAB(sa, 2, 0, true);  P8_CLOAD_V(sa, 3, 0);
        P8_SLAB(sb, 2, 1, false); P8_CLOAD_V(sb, 3, 1);  P8_VOUT(2);
        ns0x = esc[(unsigned)nt0]; ns1x = esc[(unsigned)nt1];
        v2u hr[4];
#pragma unroll
        for (int j = 0; j < 4; ++j) hr[j] = *(const v2u*)(H1B + (size_t)tok * DM + 256 * j + 4 * lane);
        P8_LOAD8X(b2, 0, (unsigned)nt0, (unsigned)nt1);
        P8_SLAB(sa, 3, 0, true);
        P8_LOAD8X(b0, 1, (unsigned)nt0, (unsigned)nt1);
        P8_SLAB(sb, 3, 1, false); P8_VOUT(3);
        float acc[16];
#pragma unroll
        for (int j = 0; j < 4; ++j) { const f32x4 t = *(const LAS f32x4*)(OT + 256 * j + 4 * lane); acc[4 * j] = t[0] * rsc; acc[4 * j + 1] = t[1] * rsc; acc[4 * j + 2] = t[2] * rsc; acc[4 * j + 3] = t[3] * rsc; }
        f32x4* orow = (f32x4*)(F.out + (size_t)tok * DM) + lane; f32x4 hv[4]; float s2 = 0.f;
        f32x4 gv[4];
#pragma unroll
        for (int j = 0; j < 4; ++j) gv[j] = ((const f32x4*)F.g_fin)[lane + 64 * j];
#pragma unroll
        for (int j = 0; j < 4; ++j) {
            { const v2u xr = hr[j];
              hv[j][0] = bf2f(xr[0] & 0xffffu); hv[j][1] = __uint_as_float(xr[0] & 0xffff0000u); hv[j][2] = bf2f(xr[1] & 0xffffu); hv[j][3] = __uint_as_float(xr[1] & 0xffff0000u); }
#pragma unroll
            for (int i = 0; i < 4; ++i) { hv[j][i] += acc[4 * j + i]; s2 += hv[j][i] * hv[j][i]; } }
        s2 = wave_sum(s2); const float rstd3 = 1.0f / sqrtf(s2 * (1.0f / DM) + EPS);
#pragma unroll
        for (int j = 0; j < 4; ++j) orow[64 * j] = hv[j] * rstd3 * gv[j];
#pragma unroll
        for (int j = 0; j < 8; ++j) { const v2u t = b0[j]; b0[j] = b2[j]; b1[j] = t; }
        asm volatile("" ::: "memory");
    }
}

constexpr int CW_BAR = 4096;
static_assert((CW_BAR + XCD_BAR_WORDS) * 4 <= (int)CTL_ZERO_BYTES, "barrier words inside the zeroed region");

__global__ void __launch_bounds__(NTHR, 2) hybrid_fwd(Params prm) {
    extern __shared__ __attribute__((aligned(16))) unsigned char lds_raw[];
    Frame F;
    F.lds = (LAS unsigned char*)lds_raw;
    F.tid = threadIdx.x; F.lane = F.tid & 63; F.wave = __builtin_amdgcn_readfirstlane(F.tid >> 6);
    F.G = gridDim.x; { const int bx = blockIdx.x; F.vcu = (F.G % 8 == 0) ? (bx % 8) * (F.G / 8) + bx / 8 : bx; }
    F.x = prm.in[0]; F.meta = prm.in[1]; F.g_mix = prm.in[2]; F.w_in = prm.in[3]; F.conv_w = prm.in[4]; F.conv_b = prm.in[5]; F.w_qm = prm.in[6]; F.w_km = prm.in[7];
    F.b_i = prm.in[8]; F.b_f = prm.in[9]; F.skip = prm.in[10]; F.gn_g = prm.in[11]; F.sb_g = prm.in[12]; F.w_out = prm.in[13]; F.g_ffn = prm.in[14]; F.w_query = prm.in[15];
    F.sub_keys = prm.in[16]; F.eu = prm.in[17]; F.ev = prm.in[18]; F.g_fin = prm.in[19]; F.out = prm.out; F.ws = prm.ws;
    volatile LAS unsigned* MISC = (volatile LAS unsigned*)(F.lds + LDSCTL_OFF);
    if (F.tid < 64) MISC[F.tid] = 0u;
    __syncthreads();
    XcdBarrier bar = xcd_barrier_post((unsigned*)(F.ws + WS_CTL) + CW_BAR, MISC + 8);

    p0_prologue(F);
    xcd_barrier(bar);
    {
        pg8::Gemm g{WSP(bf16, WS_XB), WSP(bf16, WS_WINT), MROWS, NPROJ, DM, DM, DM}; pg8::StaticOrder S; S.init(MROWS, NPROJ, F.G, (int)blockIdx.x);
        pg8::EpiRowScaleBf16<0> E{WSP(bf16, WS_PR), NPROJ, WSP(float, WS_RSTD1), EPS};
        pg8::gemm_phase<pg8::EpiRowScaleBf16<0>, pg8::StaticOrder, PG8_ALIGN, PG8_SP2>(F.lds, g, S, E);
        p1_meta_tail(F);
    }
    xcd_barrier(bar);
    p2_mlstm_local(F);
    p2_sb_attention(F);
    xcd_barrier(bar);
    p3_scan(F);
    xcd_barrier(bar);
    p4_mlstm_out(F);
    xcd_barrier(bar);
    {
        pg8::Gemm g{WSP(bf16, WS_PR) + CO_, WSP(bf16, WS_WOUTT), MROWS, DM, DM, NPROJ, DM}; pg8::StaticOrder S; S.init(MROWS, DM, F.G, (int)blockIdx.x);
        pg8::EpiResidual E{F.x, F.out, WSP(bf16, WS_H1B), WSP(float, WS_SSQ), DM};
        pg8::gemm_phase<pg8::EpiResidual, pg8::StaticOrder, PG8_ALIGN, PG8_SP2>(F.lds, g, S, E);
    }
    xcd_barrier(bar);
    {
        pg8::Gemm g{WSP(bf16, WS_H1B), WSP(bf16, WS_WQT), MROWS, 2048, DM, DM, DM}; pg8::StaticOrder S; S.init(MROWS, 2048, F.G, (int)blockIdx.x);
        pg8::EpiRowScaleBf16<1> E{WSP(bf16, WS_QP), 2048, WSP(float, WS_SSQ), EPS};
        pg8::gemm_phase<pg8::EpiRowScaleBf16<1>, pg8::StaticOrder, PG8_ALIGN, PG8_SP2>(F.lds, g, S, E);
    }
    xcd_barrier(bar);
    p7_topk(F);
    p8_gather(F);
}

extern "C" void kernel_launch(void* const* d_in, const int* in_sizes, int n_in, void* d_out, int out_size, void* d_ws, size_t ws_size, hipStream_t stream) {
    static int grid = 0;
    if (grid == 0) {
        if (n_in != 20 || in_sizes[0] != MROWS * DM || out_size != MROWS * DM || ws_size < WS_END) {
            fprintf(stderr, "kernel_launch: unexpected shapes (n_in %d, in0 %d, out %d, ws %zu < %zu); nothing launched\n", n_in, n_in > 0 ? in_sizes[0] : -1, out_size, ws_size, (size_t)WS_END); grid = -1; return; }
        int dev = 0, cus = 0, per_cu = 0;
        if (hipGetDevice(&dev) != hipSuccess || hipDeviceGetAttribute(&cus, hipDeviceAttributeMultiprocessorCount, dev) != hipSuccess) { fprintf(stderr, "kernel_launch: device query failed\n"); grid = -1; return; }
        if (hipFuncSetAttribute((const void*)hybrid_fwd, hipFuncAttributeMaxDynamicSharedMemorySize, LDS_BYTES) != hipSuccess) { fprintf(stderr, "kernel_launch: hipFuncSetAttribute failed\n"); grid = -1; return; }
        if (hipOccupancyMaxActiveBlocksPerMultiprocessor(&per_cu, (const void*)hybrid_fwd, NTHR, LDS_BYTES) != hipSuccess || per_cu < 1) { fprintf(stderr, "kernel_launch: occupancy query says %d blocks/CU\n", per_cu); (void)hipGetLastError(); grid = -1; return; }
        grid = cus;
        if (grid != 256) { fprintf(stderr, "kernel_launch: this kernel is built for a 256-CU device (got %d)\n", grid); grid = -1; return; }
    }
    if (grid < 0) return;
    if (hipMemsetAsync((char*)d_ws + WS_CTL, 0, CTL_ZERO_BYTES, stream) != hipSuccess) { fprintf(stderr, "kernel_launch: memset failed\n"); return; }
    Params p{};
    for (int i = 0; i < 20; ++i) p.in[i] = (const float*)d_in[i];
    p.out = (float*)d_out; p.ws = (unsigned char*)d_ws;
    void* args[] = {&p};
    const hipError_t e = hipLaunchCooperativeKernel((const void*)hybrid_fwd, dim3(grid), dim3(NTHR), args, LDS_BYTES, stream);
    if (e != hipSuccess) fprintf(stderr, "kernel_launch: cooperative launch failed: %s\n", hipGetErrorString(e));
}
```

```cpp
#include <hip/hip_runtime.h>
#include <hip/hip_cooperative_groups.h>
#include <cstdio>
#include <cstdint>
namespace cg = cooperative_groups;

namespace pg8 {
#define PG8_LAS __attribute__((address_space(3)))
typedef unsigned short bf16_t;
typedef short bf16x8 __attribute__((ext_vector_type(8)));
typedef float f32x4 __attribute__((ext_vector_type(4)));
typedef unsigned u32x4 __attribute__((ext_vector_type(4)));
typedef unsigned u32x2 __attribute__((ext_vector_type(2)));
constexpr int BM = 256, BK = 64, HALF = 128, HTB = HALF * BK * 2  , STAGE_BYTES = 8 * HTB, NXCD = 8, WGM = 8;

__host__ __device__ __forceinline__ int lds_byte(int r, int c) { const int st = (r >> 4) * 2 + (c >> 5), rr = r & 15, cc = c & 31, ob = rr * 64 + cc * 2; return st * 1024 + (ob ^ (((ob >> 9) & 1) << 5)); }
__host__ __device__ __forceinline__ void stage_rc(int b, int& R, int& C) { const int st = b / 1024, sb = b % 1024, swz = sb ^ (((sb >> 9) & 1) << 5); R = (st >> 1) * 16 + swz / 64; C = (st & 1) * 32 + (swz % 64) / 2; }
__host__ __device__ __forceinline__ int perm32(int rho) { const int n = rho >> 4, i = rho & 15; return 8 * (i >> 2) + 4 * n + (i & 3); }

struct Unit { int pm, pn; };
struct Gemm { const bf16_t* A; const bf16_t* Bt; int M, N, K, lda, ldb; };

struct StaticOrder {
    int nM, nN, nwg, G, c;
    __host__ __device__ void init(int M, int N, int G_, int c_) { nM = M / BM; nN = N / BM; nwg = nM * nN; G = G_; c = c_; }
    __host__ __device__ bool next(int i, Unit& u) const {
        const long L = (long)i * G + c; if (L >= nwg) return false;
        int wgid = (int)L; { const int q = nwg / NXCD, r = nwg % NXCD, xcd = wgid % NXCD, off = wgid / NXCD; wgid = (xcd < r ? xcd * (q + 1) : r * (q + 1) + (xcd - r) * q) + off; }
        const int nig = WGM * nN, gid = wgid / nig, fm = gid * WGM, gsz = (nM - fm) < WGM ? (nM - fm) : WGM;
        u.pm = fm + ((wgid % nig) % gsz); u.pn = (wgid % nig) / gsz; return true;
    }
    __device__ __forceinline__ void a_ready(const Unit&) const {}
    __device__ __forceinline__ void done(const Unit&) const {}
};

__device__ __forceinline__ unsigned cvt_pk_bf16(float lo, float hi) { unsigned r; asm volatile("v_cvt_pk_bf16_f32 %0, %1, %2" : "=v"(r) : "v"(lo), "v"(hi)); return r; }

template <int MODE> struct EpiRowScaleBf16 {
    static constexpr bool PERM = true, AFTER_DRAIN = false;
    bf16_t* O; int ldc; const float* rs; float eps;
    __device__ __forceinline__ void operator()(const f32x4 (&acc)[2][2][4][2], const Unit& u, int wr, int wc, int fr, int fq) const {
        const int row0 = u.pm * BM + wr * 64 + fr; const int col0 = u.pn * BM + wc * 32 + 8 * fq;
#pragma unroll
        for (int ai = 0; ai < 2; ++ai)
#pragma unroll
            for (int m = 0; m < 4; ++m) { const int row = row0 + ai * HALF + m * 16; float sc;
                if (MODE == 0) sc = rs[row];
                else { const f32x4* q = (const f32x4*)(rs + (size_t)row * 16); const f32x4 a = q[0], b = q[1], c = q[2], d = q[3];
                       const float s = ((a[0] + a[1]) + (a[2] + a[3])) + ((b[0] + b[1]) + (b[2] + b[3])) + ((c[0] + c[1]) + (c[2] + c[3])) + ((d[0] + d[1]) + (d[2] + d[3]));
                       sc = 1.0f / sqrtf(s * (1.0f / 1024.0f) + eps); }
                bf16_t* rowp = O + (size_t)row * ldc + col0;
#pragma unroll
                for (int bj = 0; bj < 2; ++bj) { const f32x4 v0 = acc[ai][bj][m][0] * sc, v1 = acc[ai][bj][m][1] * sc;
                    u32x4 w; w.x = cvt_pk_bf16(v0[0], v0[1]); w.y = cvt_pk_bf16(v0[2], v0[3]); w.z = cvt_pk_bf16(v1[0], v1[1]); w.w = cvt_pk_bf16(v1[2], v1[3]);
                    *(u32x4*)(rowp + bj * HALF) = w; } }
    }
};
struct EpiResidual {
    static constexpr bool PERM = false, AFTER_DRAIN = false;
    const float* base; float* out; bf16_t* outb; float* ssq; int ldc;
    __device__ __forceinline__ void operator()(const f32x4 (&acc)[2][2][4][2], const Unit& u, int wr, int wc, int fr, int fq) const {
        const int col0 = u.pn * BM + wc * 32 + 4 * fq;
#pragma unroll
        for (int ai = 0; ai < 2; ++ai)
#pragma unroll
            for (int m = 0; m < 4; ++m) { const int row = u.pm * BM + ai * HALF + wr * 64 + m * 16 + fr; const size_t off = (size_t)row * ldc + col0; float s = 0.f;
#pragma unroll
                for (int bj = 0; bj < 2; ++bj)
#pragma unroll
                    for (int n = 0; n < 2; ++n) { const size_t o = off + bj * HALF + n * 16; const f32x4 h = *(const f32x4*)(base + o) + acc[ai][bj][m][n];
                        u32x2 w; w.x = cvt_pk_bf16(h[0], h[1]); w.y = cvt_pk_bf16(h[2], h[3]); *(u32x2*)(outb + o) = w;
                        s += (h[0] * h[0] + h[1] * h[1]) + (h[2] * h[2] + h[3] * h[3]); }
                s += __shfl_xor(s, 16); s += __shfl_xor(s, 32);
                if (fq == 0) ssq[(size_t)row * 16 + u.pn * 4 + wc] = s; }
    }
};
template <class Epi, class Sched, bool ALIGN_EPI = false, bool SP2 = false>
__device__ __forceinline__ void gemm_phase(PG8_LAS unsigned char* lds, const Gemm g, const Sched& S, const Epi& E) {
    const int tid = threadIdx.x, wid = __builtin_amdgcn_readfirstlane(tid >> 6), lane = tid & 63, wr = wid >> 2, wc = wid & 3, fr = lane & 15, fq = lane >> 4;
    const int K = g.K, nt = K / BK;
    unsigned voffA[2], voffB[2];
#pragma unroll
    for (int i = 0; i < 2; ++i) { int R, C; stage_rc(tid * 16 + i * 8192, R, C); const int Rb = Epi::PERM ? ((R & ~31) + perm32(R & 31)) : R;
        voffA[i] = (unsigned)(R * g.lda + C) * 2u; voffB[i] = (unsigned)(Rb * g.ldb + C) * 2u; }
    const size_t kstep = (size_t)(BK * 2);
    const size_t hstepA = (size_t)HALF * g.lda * 2, hstepB = (size_t)HALF * g.ldb * 2;
    const size_t tstepA = 2 * hstepA, tstepB = 2 * hstepB;
    const unsigned ldsw = (unsigned)wid * 1024u;
    const int aoff = lds_byte(wr * 64 + fr, fq * 8), boff = lds_byte(wc * 32 + fr, fq * 8);
#define PG8_SA(b, h) (((b) * 2 + (h)) * HTB)
#define PG8_SB(b, h) ((4 + (b) * 2 + (h)) * HTB)
#define PG8_STAGE(bufoff, gbase, voff) do { _Pragma("unroll") for (int _i = 0; _i < 2; ++_i) \
        __builtin_amdgcn_global_load_lds((const unsigned*)((const char*)(gbase) + (voff)[_i]), (PG8_LAS unsigned*)(lds + (bufoff) + ldsw + _i * 8192), 16, 0, 0); } while (0)
#define PG8_LDA(dst, b, h) do { _Pragma("unroll") for (int m = 0; m < 4; ++m) _Pragma("unroll") for (int k = 0; k < 2; ++k) dst[m][k] = *(const PG8_LAS bf16x8*)(lds + PG8_SA(b, h) + aoff + m * 2048 + k * 1024); } while (0)
#define PG8_LDB(dst, b, h) do { _Pragma("unroll") for (int n = 0; n < 2; ++n) _Pragma("unroll") for (int k = 0; k < 2; ++k) dst[n][k] = *(const PG8_LAS bf16x8*)(lds + PG8_SB(b, h) + boff + n * 2048 + k * 1024); } while (0)
#define PG8_MMA(ai, bj, At, Bt) do { __builtin_amdgcn_s_setprio(1); _Pragma("unroll") for (int m = 0; m < 4; ++m) _Pragma("unroll") for (int n = 0; n < 2; ++n) _Pragma("unroll") for (int k = 0; k < 2; ++k) \
        acc[ai][bj][m][n] = __builtin_amdgcn_mfma_f32_16x16x32_bf16(Bt[n][k], At[m][k], acc[ai][bj][m][n], 0, 0, 0); __builtin_amdgcn_s_setprio(0); } while (0)
#define PG8_WAIT_V(n) asm volatile("s_waitcnt vmcnt(" #n ")" ::: "memory")
#define PG8_WAIT_L(n) asm volatile("s_waitcnt lgkmcnt(" #n ")" ::: "memory")
#define PG8_BAR __builtin_amdgcn_s_barrier()
#define PG8_SCHED __builtin_amdgcn_sched_barrier(0)
    Unit cur, nxt; int ui = 0;
    if (!S.next(0, cur)) return;
    f32x4 acc[2][2][4][2];
#pragma unroll
    for (int a = 0; a < 2; ++a)
#pragma unroll
        for (int b = 0; b < 2; ++b)
#pragma unroll
            for (int m = 0; m < 4; ++m)
#pragma unroll
                for (int n = 0; n < 2; ++n) acc[a][b][m][n] = (f32x4){0.f, 0.f, 0.f, 0.f};
    bf16x8 At[4][2], B0[2][2], B1[2][2];
    const char* cA = (const char*)g.A + (size_t)cur.pm * tstepA; const char* cB = (const char*)g.Bt + (size_t)cur.pn * tstepB;
    S.a_ready(cur);
    if constexpr (SP2) {
        PG8_STAGE(PG8_SB(0, 0), cB, voffB); PG8_STAGE(PG8_SB(0, 1), cB + hstepB, voffB); PG8_STAGE(PG8_SA(0, 0), cA, voffA); PG8_STAGE(PG8_SA(0, 1), cA + hstepA, voffA);
        if (wr == 1) PG8_BAR;
        PG8_WAIT_V(2); PG8_BAR;
        PG8_STAGE(PG8_SB(1, 0), cB + kstep, voffB); PG8_STAGE(PG8_SA(1, 0), cA + kstep, voffA); PG8_STAGE(PG8_SB(1, 1), cB + hstepB + kstep, voffB);
        PG8_WAIT_V(6); PG8_BAR;
    } else {
        PG8_STAGE(PG8_SB(0, 0), cB, voffB); PG8_STAGE(PG8_SA(0, 0), cA, voffA); PG8_STAGE(PG8_SB(0, 1), cB + hstepB, voffB); PG8_STAGE(PG8_SA(0, 1), cA + hstepA, voffA);
        if (wr == 1) PG8_BAR;
        PG8_WAIT_V(4); PG8_BAR;
        PG8_STAGE(PG8_SB(1, 0), cB + kstep, voffB); PG8_STAGE(PG8_SA(1, 0), cA + kstep, voffA); PG8_STAGE(PG8_SB(1, 1), cB + hstepB + kstep, voffB);
        PG8_WAIT_V(6); PG8_BAR;
    }
    for (;;) {
        const bool has_next = S.next(ui + 1, nxt);
        const char* nA = has_next ? (const char*)g.A + (size_t)nxt.pm * tstepA : cA; const char* nB = has_next ? (const char*)g.Bt + (size_t)nxt.pn * tstepB : cB;
        for (int t = 0; t < nt; t += 2) {
            const bool last = (t == nt - 2);
            const char* a1 = cA + (size_t)(t + 1) * kstep;
            const char* a2 = last ? nA : cA + (size_t)(t + 2) * kstep; const char* b2 = last ? nB : cB + (size_t)(t + 2) * kstep;
            const char* a3 = a2 + kstep; const char* b3 = b2 + kstep;
            if (last && has_next) S.a_ready(nxt);
            if constexpr (SP2) {
            PG8_LDB(B0, 0, 0); PG8_LDB(B1, 0, 1); PG8_SCHED; PG8_LDA(At, 0, 0); PG8_STAGE(PG8_SA(1, 1), a1 + hstepA, voffA);
            PG8_WAIT_V(8); PG8_WAIT_L(0); PG8_BAR; PG8_MMA(0, 0, At, B0); PG8_MMA(0, 1, At, B1); PG8_BAR; PG8_SCHED;
            PG8_LDA(At, 0, 1); PG8_STAGE(PG8_SB(0, 0), b2, voffB); PG8_STAGE(PG8_SB(0, 1), b2 + hstepB, voffB); PG8_STAGE(PG8_SA(0, 0), a2, voffA);
            PG8_WAIT_V(8); PG8_WAIT_L(0); PG8_BAR; PG8_MMA(1, 0, At, B0); PG8_MMA(1, 1, At, B1); PG8_BAR; PG8_SCHED;
            PG8_LDB(B0, 1, 0); PG8_LDB(B1, 1, 1); PG8_SCHED; PG8_LDA(At, 1, 0); PG8_STAGE(PG8_SA(0, 1), a2 + hstepA, voffA);
            PG8_WAIT_V(8); PG8_WAIT_L(0); PG8_BAR; PG8_MMA(0, 0, At, B0); PG8_MMA(0, 1, At, B1); PG8_BAR; PG8_SCHED;
            PG8_LDA(At, 1, 1); PG8_STAGE(PG8_SB(1, 0), b3, voffB); PG8_STAGE(PG8_SB(1, 1), b3 + hstepB, voffB); PG8_STAGE(PG8_SA(1, 0), a3, voffA);
            PG8_WAIT_V(8); PG8_WAIT_L(0); PG8_BAR; PG8_MMA(1, 0, At, B0); PG8_MMA(1, 1, At, B1); PG8_BAR; PG8_SCHED;
            } else {
            PG8_LDB(B0, 0, 0); PG8_SCHED; PG8_LDA(At, 0, 0); PG8_STAGE(PG8_SA(1, 1), a1 + hstepA, voffA);
            PG8_WAIT_L(8); PG8_BAR; PG8_WAIT_L(0); PG8_MMA(0, 0, At, B0); PG8_BAR; PG8_SCHED;
            PG8_LDB(B1, 0, 1); PG8_STAGE(PG8_SB(0, 0), b2, voffB);
            PG8_BAR; PG8_WAIT_L(0); PG8_MMA(0, 1, At, B1); PG8_BAR;
            PG8_LDA(At, 0, 1); PG8_STAGE(PG8_SA(0, 0), a2, voffA);
            PG8_BAR; PG8_WAIT_L(0); PG8_MMA(1, 0, At, B0); PG8_BAR; PG8_SCHED;
            PG8_STAGE(PG8_SB(0, 1), b2 + hstepB, voffB);
            PG8_WAIT_V(6); PG8_BAR; PG8_MMA(1, 1, At, B1); PG8_BAR;
            PG8_LDB(B0, 1, 0); PG8_SCHED; PG8_LDA(At, 1, 0); PG8_STAGE(PG8_SA(0, 1), a2 + hstepA, voffA);
            PG8_WAIT_L(8); PG8_BAR; PG8_WAIT_L(0); PG8_MMA(0, 0, At, B0); PG8_BAR; PG8_SCHED;
            PG8_LDB(B1, 1, 1); PG8_STAGE(PG8_SB(1, 0), b3, voffB);
            PG8_BAR; PG8_WAIT_L(0); PG8_MMA(0, 1, At, B1); PG8_BAR;
            PG8_LDA(At, 1, 1); PG8_STAGE(PG8_SA(1, 0), a3, voffA);
            PG8_BAR; PG8_WAIT_L(0); PG8_MMA(1, 0, At, B0); PG8_BAR; PG8_SCHED;
            PG8_STAGE(PG8_SB(1, 1), b3 + hstepB, voffB);
            PG8_WAIT_V(6); PG8_BAR; PG8_MMA(1, 1, At, B1); PG8_BAR;
            }
        }
        if constexpr (ALIGN_EPI) { if (wr == 0) PG8_BAR; }
        if constexpr (!Epi::AFTER_DRAIN) { E(acc, cur, wr, wc, fr, fq); S.done(cur); }
        if (!has_next) break;
#pragma unroll
        for (int a = 0; a < 2; ++a)
#pragma unroll
            for (int b = 0; b < 2; ++b)
#pragma unroll
                for (int m = 0; m < 4; ++m)
#pragma unroll
                    for (int n = 0; n < 2; ++n) acc[a][b][m][n] = (f32x4){0.f, 0.f, 0.f, 0.f};
        cur = nxt; cA = nA; cB = nB; ++ui;
        if constexpr (ALIGN_EPI) { if (wr == 1) PG8_BAR; }
    }
    PG8_WAIT_V(0);
    if constexpr (!ALIGN_EPI) { if (wr == 0) PG8_BAR; }
    PG8_BAR;
    if constexpr (Epi::AFTER_DRAIN) { E.fused(acc, cur, wr, wc, fr, fq, lds, wid, lane); S.done(cur); }
#undef PG8_SA
#undef PG8_SB
#undef PG8_STAGE
#undef PG8_LDA
#undef PG8_LDB
#undef PG8_MMA
#undef PG8_WAIT_V
#undef PG8_WAIT_L
#undef PG8_BAR
#undef PG8_SCHED
}
}
#define PG8_SP2 true
#define PG8_ALIGN true

#define GAS __attribute__((address_space(1)))
#define LAS __attribute__((address_space(3)))
typedef unsigned short bf16;
typedef unsigned v4u __attribute__((ext_vector_type(4)));
typedef unsigned v2u __attribute__((ext_vector_type(2)));
typedef float f32x4 __attribute__((ext_vector_type(4)));
typedef float f32x2 __attribute__((ext_vector_type(2)));
typedef short bf16x8 __attribute__((ext_vector_type(8)));
#define RLX_AGENT __ATOMIC_RELAXED, __HIP_MEMORY_SCOPE_AGENT

constexpr int NWAVES = 8, NTHR = 512;
constexpr int SEQ = 8192, DM = 1024, MROWS = 16384, NMETA = 16;
constexpr int NIN = 3080, NPROJ = 3072;
constexpr int CU_ = 0, CV_ = 512, CO_ = 1024, CQS = 1536, CKS = 2048, CVS = 2560;
constexpr int OU_ = 0, OV_ = 512, OI_ = 1536, OF_ = 1540, OKS = 2056, OVS = 2568;
constexpr float EPS = 1e-6f;
constexpr int NEXP = 16384;

constexpr size_t KiB = 1024, MiB = 1024 * 1024;
constexpr size_t WS_CTL = 0, CTL_ZERO_BYTES = 64 * KiB;
constexpr size_t WS_RSTD1 = 64 * KiB;
constexpr size_t WS_SSQ   = WS_RSTD1 + 64 * KiB;
constexpr size_t WS_GI    = WS_SSQ + 1 * MiB;
constexpr size_t WS_GF    = WS_GI + 256 * KiB;
constexpr size_t WS_BT    = WS_GF + 256 * KiB;
constexpr size_t WS_NU    = WS_BT + 256 * KiB;
constexpr size_t WS_NS    = WS_NU + 512 * KiB;
constexpr size_t WS_AC    = WS_NS + 512 * KiB;
constexpr size_t WS_BC    = WS_AC + 4 * KiB;
constexpr size_t WS_MIN   = WS_BC + 4 * KiB;
constexpr size_t WS_PRM   = WS_MIN + 4 * KiB;
constexpr size_t WS_KM    = WS_PRM + 196 * KiB;
constexpr size_t WS_WQMT  = WS_KM + 32 * KiB;
constexpr size_t WS_WKMT  = WS_WQMT + 128 * KiB;
constexpr size_t WS_SKB   = WS_WKMT + 128 * KiB;
constexpr size_t WS_RSTDM = WS_SKB + 64 * KiB;
constexpr size_t WS_RS2 = WS_RSTDM + 4 * KiB;
constexpr size_t WS_ESC = WS_RS2 + 64 * KiB;
constexpr size_t WS_SMALL_END = WS_ESC + 128 * KiB;
static_assert(WS_SMALL_END <= 4 * MiB, "small region");
constexpr size_t WS_WINT = 4 * MiB, WS_WOUTT = 10 * MiB, WS_WQT = 12 * MiB;
constexpr size_t WS_EU = 16 * MiB, WS_EV = 32 * MiB;
constexpr size_t WS_PR = 80 * MiB;
constexpr size_t WS_QP = WS_PR;
constexpr size_t WS_QK = 176 * MiB;
constexpr size_t WS_XB = WS_QK, WS_H1B = WS_QK;
constexpr size_t WS_U = 208 * MiB;
constexpr size_t WS_PRMP = WS_U, WS_TK = WS_U;
constexpr size_t WS_CB = 240 * MiB;
constexpr size_t WS_END = 256 * MiB;

constexpr int LDS_BYTES = 147456, LDSCTL_OFF = LDS_BYTES - 256;

__device__ __forceinline__ unsigned f2bf(float f) { unsigned u = __builtin_bit_cast(unsigned, f); return (u + 0x7fffu + ((u >> 16) & 1u)) >> 16; }
__device__ __forceinline__ unsigned pk2(float lo, float hi) { return f2bf(lo) | (f2bf(hi) << 16); }
__device__ __forceinline__ unsigned pk_fp8x4(f32x4 v) {
    const float a = fminf(fmaxf(v[0], -448.f), 448.f), b = fminf(fmaxf(v[1], -448.f), 448.f), c = fminf(fmaxf(v[2], -448.f), 448.f), d = fminf(fmaxf(v[3], -448.f), 448.f);
    int r = __builtin_amdgcn_cvt_pk_fp8_f32(a, b, 0, false); r = __builtin_amdgcn_cvt_pk_fp8_f32(c, d, r, true); return (unsigned)r; }
__device__ __forceinline__ unsigned pk_fp4x8(f32x4 a, f32x4 b) {
    unsigned r = 0u; r = __builtin_amdgcn_cvt_scalef32_pk_fp4_f32(r, a[0], a[1], 1.0f, 0); r = __builtin_amdgcn_cvt_scalef32_pk_fp4_f32(r, a[2], a[3], 1.0f, 1);
    r = __builtin_amdgcn_cvt_scalef32_pk_fp4_f32(r, b[0], b[1], 1.0f, 2); r = __builtin_amdgcn_cvt_scalef32_pk_fp4_f32(r, b[2], b[3], 1.0f, 3); return r; }
__device__ __forceinline__ float bf2f(unsigned h) { return __builtin_bit_cast(float, h << 16); }
template <int CTRL> __device__ __forceinline__ float dpp_f(float v) { return __builtin_bit_cast(float, __builtin_amdgcn_update_dpp(0, __builtin_bit_cast(int, v), CTRL, 0xf, 0xf, true)); }
__device__ __forceinline__ float rdl_f(float v, int l) { return __builtin_bit_cast(float, __builtin_amdgcn_readlane(__builtin_bit_cast(int, v), l)); }
__device__ __forceinline__ float wave_sum(float v) {
    v += dpp_f<0xB1>(v); v += dpp_f<0x4E>(v); v += dpp_f<0x124>(v); v += dpp_f<0x128>(v);
    return (rdl_f(v, 0) + rdl_f(v, 16)) + (rdl_f(v, 32) + rdl_f(v, 48));
}
__device__ __forceinline__ float wave_max(float v) {
    v = fmaxf(v, dpp_f<0xB1>(v)); v = fmaxf(v, dpp_f<0x4E>(v)); v = fmaxf(v, dpp_f<0x124>(v)); v = fmaxf(v, dpp_f<0x128>(v));
    return fmaxf(fmaxf(rdl_f(v, 0), rdl_f(v, 16)), fmaxf(rdl_f(v, 32), rdl_f(v, 48)));
}
__device__ __forceinline__ float row16_sum(float v) { v += dpp_f<0xB1>(v); v += dpp_f<0x4E>(v); v += dpp_f<0x124>(v); v += dpp_f<0x128>(v); return v; }
__device__ __forceinline__ float row16_min(float v) { v = fminf(v, dpp_f<0xB1>(v)); v = fminf(v, dpp_f<0x4E>(v)); v = fminf(v, dpp_f<0x124>(v)); v = fminf(v, dpp_f<0x128>(v)); return v; }
template <int CTRL> __device__ __forceinline__ float dpp_shr(float v, float idv) { return __builtin_bit_cast(float, __builtin_amdgcn_update_dpp(__builtin_bit_cast(int, idv), __builtin_bit_cast(int, v), CTRL, 0xf, 0xf, false)); }
__device__ __forceinline__ float wave_scan_sum(float v, int lane) {
    v += dpp_shr<0x111>(v, 0.f); v += dpp_shr<0x112>(v, 0.f); v += dpp_shr<0x114>(v, 0.f); v += dpp_shr<0x118>(v, 0.f);
    const float r0 = rdl_f(v, 15), r1 = rdl_f(v, 31), r2 = rdl_f(v, 47);
    return v + (lane < 16 ? 0.f : lane < 32 ? r0 : lane < 48 ? r0 + r1 : (r0 + r1) + r2);
}
__device__ __forceinline__ float wave_scan_max(float v, int lane) {
    const float NI = -3.0e38f;
    v = fmaxf(v, dpp_shr<0x111>(v, NI)); v = fmaxf(v, dpp_shr<0x112>(v, NI)); v = fmaxf(v, dpp_shr<0x114>(v, NI)); v = fmaxf(v, dpp_shr<0x118>(v, NI));
    const float r0 = rdl_f(v, 15), r1 = rdl_f(v, 31), r2 = rdl_f(v, 47);
    return fmaxf(v, lane < 16 ? NI : lane < 32 ? r0 : lane < 48 ? fmaxf(r0, r1) : fmaxf(fmaxf(r0, r1), r2));
}
__device__ __forceinline__ float logsigmoidf_(float a) { return fminf(a, 0.f) - log1pf(__expf(-fabsf(a))); }
__device__ __forceinline__ float siluf_(float a) { return a / (1.f + __expf(-a)); }
template <int KS> __device__ __forceinline__ f32x4 mma_rows(const LAS bf16* a, const LAS bf16* b, f32x4 acc) {
#pragma unroll
    for (int k = 0; k < KS; ++k) { const bf16x8 av = *(const LAS bf16x8*)(a + 32 * k), bv = *(const LAS bf16x8*)(b + 32 * k); acc = __builtin_amdgcn_mfma_f32_16x16x32_bf16(av, bv, acc, 0, 0, 0); }
    return acc;
}
#define XB_TMO      128
#define XB_XCNT(j)  (256  + 64 * (j))
#define XB_XSUB(j)  (1280 + 64 * (j))
#define XB_XGEN(j)  (2304 + 64 * (j))
#define XB_TOP      3328
#define XB_TOPGEN   3392
#define XCD_BAR_WORDS 3456
#define XB_SPIN_CAP (1u << 18)

__device__ __forceinline__ unsigned xb_ld(unsigned* p)              { return __hip_atomic_load(p, __ATOMIC_RELAXED, __HIP_MEMORY_SCOPE_AGENT); }
__device__ __forceinline__ unsigned xb_add(unsigned* p, unsigned v) { return __hip_atomic_fetch_add(p, v, __ATOMIC_RELAXED, __HIP_MEMORY_SCOPE_AGENT); }
__device__ __forceinline__ unsigned xb_xcc_id() { return (unsigned)__builtin_amdgcn_s_getreg((3 << 11) | 20) & 0xFu; }
#define XB_SPIN(cond, bar) do { unsigned _sp = 0; while (cond) { __builtin_amdgcn_s_sleep(1); \
    if ((++_sp & 255u) == 0u) { if (xb_ld(&(bar)[XB_TMO])) break; if (_sp > XB_SPIN_CAP) { atomicAdd(&(bar)[XB_TMO], 1u); break; } } } } while (0)

struct XcdBarrier {
    unsigned* bar; unsigned x;
    volatile LAS unsigned* st;
};

__device__ __forceinline__ XcdBarrier xcd_barrier_post(unsigned* bar, volatile LAS unsigned* st) {
    XcdBarrier b; b.bar = bar; b.x = xb_xcc_id(); b.st = st;
    if (threadIdx.x == 0) (void)xb_add(&bar[XB_XCNT(b.x)], 1u);
    return b;
}
__device__ __forceinline__ void xcd_barrier_complete(unsigned* bar, unsigned x, unsigned& nloc, unsigned& nx) {
    const unsigned G = gridDim.x * gridDim.y * gridDim.z;
    unsigned sum, cnt, mine, sp = 0u;
    for (;;) {
        sum = 0u; cnt = 0u; mine = 0u;
#pragma unroll
        for (unsigned j = 0; j < 16; ++j) { const unsigned c = xb_ld(&bar[XB_XCNT(j)]); sum += c; cnt += (c > 0u) ? 1u : 0u; mine = (j == x) ? c : mine; }
        if (sum == G) break;
        __builtin_amdgcn_s_sleep(1);
        if ((++sp & 255u) == 0u) { if (xb_ld(&bar[XB_TMO])) break; if (sp > XB_SPIN_CAP) { atomicAdd(&bar[XB_TMO], 1u); break; } }
    }
    nloc = mine > 0u ? mine : 1u; nx = cnt > 0u ? cnt : 1u;
}

__device__ __forceinline__ void xcd_barrier(const XcdBarrier& b) {
    asm volatile("s_waitcnt vmcnt(0)" ::: "memory");
    __syncthreads();
    if (threadIdx.x == 0) {
        unsigned* bar = b.bar;
        __builtin_amdgcn_s_waitcnt(0);
        unsigned nloc = b.st[0], nx = b.st[1];
        if (nloc == 0u) { xcd_barrier_complete(bar, b.x, nloc, nx); b.st[0] = nloc; b.st[1] = nx; }
        const unsigned old = xb_add(&bar[XB_XSUB(b.x)], 1u);
        const unsigned gen = old / nloc;
        if (old + 1u == (gen + 1u) * nloc) {
            __builtin_amdgcn_fence(__ATOMIC_RELEASE, "agent");
            asm volatile("s_waitcnt vmcnt(0)" ::: "memory");
            const unsigned og = xb_add(&bar[XB_TOP], 1u);
            const unsigned tg = og / nx;
            if (og + 1u == (tg + 1u) * nx) xb_add(&bar[XB_TOPGEN], 1u);
            else XB_SPIN(xb_ld(&bar[XB_TOPGEN]) == tg, bar);
            __builtin_amdgcn_fence(__ATOMIC_ACQUIRE, "agent");
            xb_add(&bar[XB_XGEN(b.x)], 1u);
            asm volatile("s_waitcnt vmcnt(0)" ::: "memory");
        } else {
            XB_SPIN(xb_ld(&bar[XB_XGEN(b.x)]) == gen, bar);
            __builtin_amdgcn_fence(__ATOMIC_ACQUIRE, "agent");
            asm volatile("s_waitcnt vmcnt(0)" ::: "memory");
        }
    }
    __syncthreads();
}

struct Params { const float* in[20]; float* out; unsigned char* ws; };
struct Frame {
    LAS unsigned char* lds;
    int tid, lane, wave, vcu, G;
    const float *x, *meta, *g_mix, *w_in, *conv_w, *conv_b, *w_qm, *w_km, *b_i, *b_f, *skip, *gn_g, *sb_g, *w_out, *g_ffn, *w_query, *sub_keys, *eu, *ev, *g_fin;
    float* out; unsigned char* ws;
};
#define WSP(T, off) ((T*)(F.ws + (off)))

__device__ __forceinline__ void p0_transpose_item(const float* W, int ldw, int k0, int srccol0, bf16* WT, int K, int dstrow0, const float* gk, float cs, LAS float* scr, int lane, const float* META, float* PRMP) {
#pragma unroll 8
    for (int i = 0; i < 32; ++i) { const int kk = 2 * i + (lane >> 5); const float sc = gk ? gk[k0 + kk] * cs : cs; scr[kk * 33 + (lane & 31)] = W[(size_t)(k0 + kk) * ldw + srccol0 + (lane & 31)] * sc; }
    if (META) { LAS float* mb = scr + 64 * 33;
#pragma unroll
        for (int i = 0; i < 16; ++i) mb[i * 64 + lane] = META[(size_t)i * DM + k0 + lane]; }
    const int c = lane & 7;
#pragma unroll
    for (int j = 0; j < 4; ++j) { const int n = (lane >> 3) + 8 * j; const LAS float* s = scr + (8 * c) * 33 + n;
        v4u o; o.x = pk2(s[0 * 33], s[1 * 33]); o.y = pk2(s[2 * 33], s[3 * 33]); o.z = pk2(s[4 * 33], s[5 * 33]); o.w = pk2(s[6 * 33], s[7 * 33]);
        *(v4u*)(WT + (size_t)(dstrow0 + n) * K + k0 + 8 * c) = o; }
    if (META) { const LAS float* mb = scr + 64 * 33; const int n = lane & 31, r0 = (lane >> 5) * 8; float acc[8];
#pragma unroll
        for (int r = 0; r < 8; ++r) acc[r] = 0.f;
#pragma unroll 4
        for (int kk = 0; kk < 64; kk += 4) { const float w0 = scr[kk * 33 + n], w1 = scr[(kk + 1) * 33 + n], w2 = scr[(kk + 2) * 33 + n], w3 = scr[(kk + 3) * 33 + n];
#pragma unroll
            for (int r = 0; r < 8; ++r) { const f32x4 m = *(const LAS f32x4*)(mb + (r0 + r) * 64 + kk); acc[r] += (m[0] * w0 + m[1] * w1) + (m[2] * w2 + m[3] * w3); } }
#pragma unroll
        for (int r = 0; r < 8; ++r) PRMP[((size_t)(k0 >> 6) * 16 + r0 + r) * NIN + srccol0 + n] = acc[r]; }
}

__device__ __forceinline__ void p0_pack_row_i4(Frame& F, f32x4 (&a)[4], const f32x4 (&gf)[4], int r, int lane) {
    const bool isu = r < NEXP; float ss = 0.f;
#pragma unroll
    for (int j = 0; j < 4; ++j) { if (isu) a[j] = a[j] * gf[j]; ss += (a[j][0] * a[j][0] + a[j][1] * a[j][1]) + (a[j][2] * a[j][2] + a[j][3] * a[j][3]); }
    ss = wave_sum(ss);
    const float rms = sqrtf(ss * (1.0f / DM)); const float step = rms > 0.f ? 0.3125f * rms : 1.0f, inv = 1.0f / step;
    v2u o;
#pragma unroll
    for (int d = 0; d < 2; ++d) { unsigned w = 0u;
#pragma unroll
        for (int n = 0; n < 8; ++n) { const int i = 8 * d + n; const float q = floorf(a[i >> 2][i & 3] * inv); const int k = (int)fminf(fmaxf(q, -8.f), 7.f); w |= ((unsigned)k & 0xfu) << (4 * n); }
        o[d] = w; }
    *((v2u*)(F.ws + (isu ? WS_EU : WS_EV) + (size_t)(r & (NEXP - 1)) * (DM / 2)) + lane) = o;
    if (lane == 0) WSP(float, WS_ESC)[r] = step;
}

__device__ __forceinline__ void p0_prologue(Frame& F) {
    LAS float* scr = (LAS float*)(F.lds + 32768 + F.wave * 14336);
    LAS float* wg = (LAS float*)F.lds;
    const int gw = F.vcu * NWAVES + F.wave, NGW = F.G * NWAVES, lane = F.lane;
    for (int i = F.tid; i < 8192; i += NTHR) { const int jj = i >> 10, k = i & 1023; wg[i] = F.w_in[(size_t)k * NIN + OI_ + jj] * F.g_mix[k]; }
    {
        constexpr int I_IN = 16 * 96, I_OUT = 16 * 32, I_Q = 16 * 64, I_M = 2 * 4;
        constexpr int NITEMS = I_IN + I_OUT + I_Q + 8 * I_M;
        for (int it = gw; it < NITEMS; it += NGW) {
            int r = it;
            if (r < I_IN) { const int kb = r / 96, nb = r % 96; const int n0 = 32 * nb; p0_transpose_item(F.w_in, NIN, 64 * kb, n0 + (n0 >= 1536 ? 8 : 0), WSP(bf16, WS_WINT), DM, n0, F.g_mix, 1.f, scr, lane, F.meta, WSP(float, WS_PRMP)); continue; } r -= I_IN;
            if (r < I_OUT) { const int kb = r / 32, nb = r % 32; p0_transpose_item(F.w_out, DM, 64 * kb, 32 * nb, WSP(bf16, WS_WOUTT), DM, 32 * nb, nullptr, 1.f, scr, lane, nullptr, nullptr); continue; } r -= I_OUT;
            if (r < I_Q) { const int kb = r / 64, nb = r % 64; p0_transpose_item(F.w_query, 2048, 64 * kb, 32 * nb, WSP(bf16, WS_WQT), DM, 32 * nb, F.g_ffn, 1.f, scr, lane, nullptr, nullptr); continue; } r -= I_Q;
            { const int mat = r / I_M, q = r % I_M, kb = q / 4, nb = q % 4, h = mat & 3;
              const float* W = (mat < 4 ? F.w_qm : F.w_km) + (size_t)h * 16384; bf16* WT = WSP(bf16, mat < 4 ? WS_WQMT : WS_WKMT) + (size_t)h * 16384;
              p0_transpose_item(W, 128, 64 * kb, 32 * nb, WT, 128, 32 * nb, nullptr, mat < 4 ? 1.f : 0.08838834764831845f, scr, lane, nullptr, nullptr); }
        }
        for (int i = gw * 64 + lane; i < 32768 / 4; i += NGW * 64) { const f32x4 v = ((const f32x4*)F.sub_keys)[i]; v2u o; o.x = pk2(v[0], v[1]); o.y = pk2(v[2], v[3]); ((v2u*)WSP(bf16, WS_SKB))[i] = o; }
    }
    __syncthreads();
    {
        float bi[4], bfv[4];
#pragma unroll
        for (int j = 0; j < 4; ++j) { bi[j] = F.b_i[j]; bfv[j] = F.b_f[j]; }
        f32x4 v[4], vn[4];
        { const f32x4* xr = (const f32x4*)(F.x + (size_t)gw * DM) + lane;
#pragma unroll
          for (int j = 0; j < 4; ++j) v[j] = xr[64 * j]; }
        for (int m = gw; m < MROWS + NMETA; m += NGW) {
            const int mn = m + NGW;
            if (mn < MROWS + NMETA) { const f32x4* xr = (const f32x4*)(mn < MROWS ? F.x + (size_t)mn * DM : F.meta + (size_t)(mn - MROWS) * DM) + lane;
#pragma unroll
                for (int j = 0; j < 4; ++j) vn[j] = xr[64 * j]; }
            float ss = 0.f; float g8[8];
#pragma unroll
            for (int jj = 0; jj < 8; ++jj) g8[jj] = 0.f;
#pragma unroll
            for (int j = 0; j < 4; ++j) ss += (v[j][0] * v[j][0] + v[j][1] * v[j][1]) + (v[j][2] * v[j][2] + v[j][3] * v[j][3]);
#pragma unroll
            for (int j = 0; j < 4; ++j)
#pragma unroll
                for (int jj = 0; jj < 8; ++jj) { const f32x4 w = *(const LAS f32x4*)(wg + jj * 1024 + 256 * j + 4 * lane); g8[jj] += (v[j][0] * w[0] + v[j][1] * w[1]) + (v[j][2] * w[2] + v[j][3] * w[3]); }
            ss = wave_sum(ss);
#pragma unroll
            for (int jj = 0; jj < 8; ++jj) g8[jj] = wave_sum(g8[jj]);
            const float rstd = 1.0f / sqrtf(ss * (1.0f / DM) + EPS);
            if (m < MROWS) {
                v2u* o8 = (v2u*)(WSP(bf16, WS_XB) + (size_t)m * DM) + lane;
#pragma unroll
                for (int j = 0; j < 4; ++j) { v2u o; o.x = pk2(v[j][0], v[j][1]); o.y = pk2(v[j][2], v[j][3]); o8[64 * j] = o; }
                if (lane == 0) WSP(float, WS_RSTD1)[m] = rstd;
#pragma unroll
                for (int jj = 0; jj < 4; ++jj) if (lane == jj) { WSP(float, WS_GI)[m * 4 + jj] = g8[jj] * rstd + bi[jj]; WSP(float, WS_GF)[m * 4 + jj] = logsigmoidf_(g8[4 + jj] * rstd + bfv[jj]); }
            } else {
                const int r = m - MROWS;
                if (lane == 0) WSP(float, WS_RSTDM)[r] = rstd;
#pragma unroll
                for (int jj = 0; jj < 8; ++jj) if (lane == jj) WSP(float, WS_PRM)[(size_t)r * NIN + OI_ + jj] = g8[jj] * rstd;
            }
#pragma unroll
            for (int j = 0; j < 4; ++j) v[j] = vn[j];
        }
    }
    {
        f32x4 gf[4];
#pragma unroll
        for (int j = 0; j < 4; ++j) gf[j] = ((const f32x4*)F.g_ffn)[lane + 64 * j];
        for (int r = gw; r < 2 * NEXP; r += 2 * NGW) {
            const int r2 = r + NGW; const bool has2 = r2 < 2 * NEXP;
            const f32x4* s1 = (const f32x4*)((r >= NEXP ? F.ev : F.eu) + (size_t)(r & (NEXP - 1)) * DM) + lane;
            const f32x4* s2 = (const f32x4*)((r2 >= NEXP ? F.ev : F.eu) + (size_t)(r2 & (NEXP - 1)) * DM) + lane;
            f32x4 a[4], b[4];
#pragma unroll
            for (int j = 0; j < 4; ++j) { a[j] = s1[64 * j]; if (has2) b[j] = s2[64 * j]; }
            if (r < NEXP) p0_pack_row_i4(F, a, gf, r, lane);
            else { v2u o; o[0] = pk_fp4x8(a[0] * 4.0f, a[1] * 4.0f); o[1] = pk_fp4x8(a[2] * 4.0f, a[3] * 4.0f); *((v2u*)(F.ws + WS_EV + (size_t)(r - NEXP) * (DM / 2)) + lane) = o; }
            if (has2) { if (r2 < NEXP) p0_pack_row_i4(F, b, gf, r2, lane);
                else { v2u o; o[0] = pk_fp4x8(b[0] * 4.0f, b[1] * 4.0f); o[1] = pk_fp4x8(b[2] * 4.0f, b[3] * 4.0f); *((v2u*)(F.ws + WS_EV + (size_t)(r2 - NEXP) * (DM / 2)) + lane) = o; } }
        }
    }
}

__device__ __forceinline__ void p1_meta_tail(Frame& F) {
    const float* P = WSP(float, WS_PRMP);
    if (F.vcu >= 4 && F.vcu < 8) {
        const int part = F.vcu - 4, per = 16 * NIN / 4;
        for (int i = part * per + F.tid; i < (part + 1) * per; i += NTHR) { const int r = i / NIN, n = i - r * NIN; if (n >= OI_ && n < OI_ + 8) continue; float s = 0.f;
#pragma unroll
            for (int kp = 0; kp < 16; ++kp) s += P[(size_t)kp * 16 * NIN + i];
            WSP(float, WS_PRM)[i] = s * WSP(float, WS_RSTDM)[r]; }
    } else if (F.vcu < 4) {
        const int h = F.vcu; LAS float* um = (LAS float*)F.lds; LAS float* cm = um + 2048;
        for (int i = F.tid; i < 2048; i += NTHR) { const int t = i >> 7, ch = i & 127; float s = 0.f;
#pragma unroll
            for (int kp = 0; kp < 16; ++kp) s += P[(size_t)(kp * 16 + t) * NIN + OU_ + h * 128 + ch];
            um[i] = s * WSP(float, WS_RSTDM)[t]; }
        __syncthreads();
        for (int i = F.tid; i < 2048; i += NTHR) { const int t = i >> 7, ch = i & 127, c = h * 128 + ch; float s = F.conv_b[c];
#pragma unroll
            for (int j = 0; j < 4; ++j) { const int tt = t - 3 + j; if (tt >= 0) s += F.conv_w[j * 512 + c] * um[tt * 128 + ch]; }
            cm[i] = siluf_(s); }
        __syncthreads();
        { const int t = F.tid >> 5;
#pragma unroll
          for (int jj = 0; jj < 4; ++jj) { const int e = (F.tid & 31) + 32 * jj; float s = 0.f;
              for (int d = 0; d < 128; ++d) s += cm[t * 128 + d] * F.w_km[(size_t)h * 16384 + d * 128 + e];
              WSP(float, WS_KM)[(h * 16 + t) * 128 + e] = s * 0.08838834764831845f; } }
        __syncthreads();
    }
}

constexpr int L2_WQ = 0, L2_WK = 34816, L2_C = 69632, L2_KT = 87040, L2_WV = 105472, L2_U = 123904, L2_TAB = 141056;
__device__ __forceinline__ void p2_mlstm_local(Frame& F) {
    const int bh = F.vcu >> 5, b = bh >> 2, h = bh & 3, tid = F.tid, lane = F.lane, wave = F.wave, g = lane >> 4, l15 = lane & 15;
    LAS bf16* WQ = (LAS bf16*)(F.lds + L2_WQ); LAS bf16* WK = (LAS bf16*)(F.lds + L2_WK); LAS bf16* Cs = (LAS bf16*)(F.lds + L2_C);
    LAS bf16* KT = (LAS bf16*)(F.lds + L2_KT); LAS bf16* WV = (LAS bf16*)(F.lds + L2_WV); LAS bf16* Us = (LAS bf16*)(F.lds + L2_U);
    LAS float* TAB = (LAS float*)(F.lds + L2_TAB);
    const bf16* PR = WSP(bf16, WS_PR); const float* PRM = WSP(float, WS_PRM);
    for (int i = tid; i < 2048; i += NTHR) { const int e = i >> 4, c8 = (i & 15) * 8;
        *(LAS v4u*)(WQ + e * 136 + c8) = *(const v4u*)(WSP(bf16, WS_WQMT) + (size_t)h * 16384 + e * 128 + c8);
        *(LAS v4u*)(WK + e * 136 + c8) = *(const v4u*)(WSP(bf16, WS_WKMT) + (size_t)h * 16384 + e * 128 + c8); }
    v4u ur[3], vr[2]; float gli = 0.f, glf = 0.f;
#define P2_FETCH_U(chunkx) do { const int _m0 = b * SEQ + (chunkx) * 64; _Pragma("unroll") for (int _k = 0; _k < 3; ++_k) { const int _i = tid + NTHR * _k; if (_i < 67 * 16) { const int _rr = _i >> 4, _c8 = (_i & 15) * 8, _t = _rr - 3; \
            if ((chunkx) == 0 && _t < 0) { const float* _s = PRM + (size_t)(NMETA + _t) * NIN + OU_ + h * 128 + _c8; ur[_k].x = pk2(_s[0], _s[1]); ur[_k].y = pk2(_s[2], _s[3]); ur[_k].z = pk2(_s[4], _s[5]); ur[_k].w = pk2(_s[6], _s[7]); } \
            else ur[_k] = *(const v4u*)(PR + (size_t)(_m0 + _t) * NPROJ + CU_ + h * 128 + _c8); } } \
        if (tid < 64) { gli = WSP(float, WS_GI)[(_m0 + tid) * 4 + h]; glf = WSP(float, WS_GF)[(_m0 + tid) * 4 + h]; } } while (0)
#define P2_FETCH_V(chunkx) do { const int _m0 = b * SEQ + (chunkx) * 64; _Pragma("unroll") for (int _k = 0; _k < 2; ++_k) { const int _i = tid + NTHR * _k; vr[_k] = *(const v4u*)(PR + (size_t)(_m0 + (_i >> 4)) * NPROJ + CV_ + h * 128 + (_i & 15) * 8); } } while (0)
    P2_FETCH_U(F.vcu & 31); P2_FETCH_V(F.vcu & 31);
    for (int ui = 0; ui < 4; ++ui) {
        const int chunk = (F.vcu & 31) + 32 * ui; const int m0 = b * SEQ + chunk * 64;
        __syncthreads();
#pragma unroll
        for (int k = 0; k < 3; ++k) { const int i = tid + NTHR * k; if (i < 67 * 16) *(LAS v4u*)(Us + (i >> 4) * 128 + (i & 15) * 8) = ur[k]; }
        if (tid < 64) { TAB[tid] = gli; TAB[64 + tid] = glf; }
        if (ui + 1 < 4) P2_FETCH_U(chunk + 32);
        __syncthreads();
        { const int ch = tid & 127, c = h * 128 + ch; const float w0 = F.conv_w[c], w1 = F.conv_w[512 + c], w2 = F.conv_w[1024 + c], w3 = F.conv_w[1536 + c], cb = F.conv_b[c];
#pragma unroll 4
          for (int jj = 0; jj < 16; ++jj) { const int t = (tid >> 7) + 4 * jj;
              const float s = cb + w0 * bf2f(Us[t * 128 + ch]) + w1 * bf2f(Us[(t + 1) * 128 + ch]) + w2 * bf2f(Us[(t + 2) * 128 + ch]) + w3 * bf2f(Us[(t + 3) * 128 + ch]);
              const unsigned cv = f2bf(siluf_(s)); Cs[t * 136 + ch] = (bf16)cv; } }
        if (wave == 0) {
            const float li = TAB[lane], lf = TAB[64 + lane]; float bs = lf;
            bs = wave_scan_sum(bs, lane);
            const float bL = rdl_f(bs, 63); const float gg = bL - bs + li; const float Bc = wave_max(gg);
            TAB[128 + lane] = bs; TAB[192 + lane] = __expf(gg - Bc);
            WSP(float, WS_BT)[(m0 + lane) * 4 + h] = bs;
            if (lane == 0) { WSP(float, WS_AC)[bh * 128 + chunk] = bL; WSP(float, WS_BC)[bh * 128 + chunk] = Bc; }
        }
        __syncthreads();
        {
            bf16* Qg = WSP(bf16, WS_QK); bf16* Kg = Qg + (size_t)MROWS * 512;
#pragma unroll
            for (int tt = 0; tt < 4; ++tt) {
                f32x4 aq = {0.f, 0.f, 0.f, 0.f}, ak = {0.f, 0.f, 0.f, 0.f};
                aq = mma_rows<4>(WQ + (16 * wave + l15) * 136 + 8 * g, Cs + (16 * tt + l15) * 136 + 8 * g, aq);
                ak = mma_rows<4>(WK + (16 * wave + l15) * 136 + 8 * g, Cs + (16 * tt + l15) * 136 + 8 * g, ak);
                const int t = 16 * tt + l15, e0 = 16 * wave + 4 * g; const size_t go = (size_t)(m0 + t) * 512 + h * 128 + e0;
                v2u oq; oq.x = pk2(aq[0], aq[1]); oq.y = pk2(aq[2], aq[3]); *(v2u*)(Qg + go) = oq;
                v2u ok; ok.x = pk2(ak[0], ak[1]); ok.y = pk2(ak[2], ak[3]); *(v2u*)(Kg + go) = ok;
                KT[(e0 + 0) * 72 + t] = (bf16)(ok.x & 0xffffu); KT[(e0 + 1) * 72 + t] = (bf16)(ok.x >> 16); KT[(e0 + 2) * 72 + t] = (bf16)(ok.y & 0xffffu); KT[(e0 + 3) * 72 + t] = (bf16)(ok.y >> 16);
            }
            for (int i = tid; i < 1024; i += NTHR) { const int t = i >> 4, c8 = (i & 15) * 8; *(v4u*)(WSP(bf16, WS_CB) + (size_t)(m0 + t) * 512 + h * 128 + c8) = *(const LAS v4u*)(Cs + t * 136 + c8); }
#pragma unroll
            for (int k = 0; k < 2; ++k) { const int i = tid + NTHR * k; const int s = i >> 4, e8 = (i & 15) * 8; const v4u pv = vr[k]; const float w = TAB[192 + s];
#pragma unroll
                for (int q = 0; q < 4; ++q) { WV[(e8 + 2 * q) * 72 + s] = (bf16)f2bf(bf2f(pv[q] & 0xffffu) * w); WV[(e8 + 2 * q + 1) * 72 + s] = (bf16)f2bf(__uint_as_float(pv[q] & 0xffff0000u) * w); } }
            if (ui + 1 < 4) P2_FETCH_V(chunk + 32);
        }
        __syncthreads();
        {
            bf16* Ug = WSP(bf16, WS_U) + (size_t)(bh * 128 + chunk) * 16384;
#pragma unroll
            for (int et = 0; et < 8; ++et) { f32x4 a = {0.f, 0.f, 0.f, 0.f};
                a = mma_rows<2>(KT + (16 * wave + l15) * 72 + 8 * g, WV + (16 * et + l15) * 72 + 8 * g, a);
                v2u o; o.x = pk2(a[0], a[1]); o.y = pk2(a[2], a[3]); *(v2u*)(Ug + (size_t)(16 * et + l15) * 128 + 16 * wave + 4 * g) = o; }
            if (tid < 128) { float s = 0.f; for (int t = 0; t < 64; ++t) s += bf2f(KT[tid * 72 + t]) * TAB[192 + t]; WSP(float, WS_NU)[(size_t)(bh * 128 + chunk) * 128 + tid] = s; }
        }
    }
#undef P2_FETCH_U
#undef P2_FETCH_V
    __syncthreads();
}

constexpr int L3_K = 0, L3_VT = 9216, L3_MIN = 18432;
__device__ __forceinline__ void p2_sb_attention(Frame& F) {
    const int tid = F.tid, lane = F.lane, wave = F.wave, g = lane >> 4, l15 = lane & 15;
    LAS bf16* Ks = (LAS bf16*)(F.lds + L3_K); LAS bf16* VT = (LAS bf16*)(F.lds + L3_VT); LAS float* MINR = (LAS float*)(F.lds + L3_MIN);
    bf16* PR = WSP(bf16, WS_PR); const float* PRM = WSP(float, WS_PRM);
    const int bhd = F.vcu >> 4, b = bhd >> 3, hd = bhd & 7;
    for (int ui = 0; ui < 4; ++ui) {
        const int qb = (F.vcu & 15) + 16 * ui;
        const int tq = 128 * qb + 16 * wave + l15;
        const size_t qrow = (size_t)(b * SEQ + tq) * NPROJ;
        const bf16x8 q0 = *(const bf16x8*)(PR + qrow + CQS + hd * 64 + 8 * g), q1 = *(const bf16x8*)(PR + qrow + CQS + hd * 64 + 32 + 8 * g);
        f32x4 o[4];
#pragma unroll
        for (int i = 0; i < 4; ++i) o[i] = (f32x4){0.f, 0.f, 0.f, 0.f};
        float R = 0.f;
        const int kr = tid >> 3, c8 = (tid & 7) * 8;
        v4u kn, vn;
#define SB_FETCH(jbx) do { if ((jbx) >= 0) { const size_t _ro = (size_t)(b * SEQ + 64 * (jbx) + kr) * NPROJ + hd * 64 + c8; kn = *(const v4u*)(PR + _ro + CKS); vn = *(const v4u*)(PR + _ro + CVS); } \
            else if (kr < NMETA) { const float* _sk = PRM + (size_t)kr * NIN + OKS + hd * 64 + c8; const float* _sv = PRM + (size_t)kr * NIN + OVS + hd * 64 + c8; \
                kn.x = pk2(_sk[0], _sk[1]); kn.y = pk2(_sk[2], _sk[3]); kn.z = pk2(_sk[4], _sk[5]); kn.w = pk2(_sk[6], _sk[7]); vn.x = pk2(_sv[0], _sv[1]); vn.y = pk2(_sv[2], _sv[3]); vn.z = pk2(_sv[4], _sv[5]); vn.w = pk2(_sv[6], _sv[7]); } \
            else { kn = (v4u){0u, 0u, 0u, 0u}; vn = kn; } } while (0)
        SB_FETCH(2 * qb + 1);
        for (int jb = 2 * qb + 1; jb >= -1; --jb) {
            __syncthreads();
            if (jb < 2 * qb + 1) { float mn = MINR[0];
#pragma unroll
                for (int w = 1; w < 8; ++w) mn = fminf(mn, MINR[w]);
                if (mn >= 90.f) break; }
            { const v4u kv = kn, vv = vn;
              *(LAS v4u*)(Ks + kr * 72 + c8) = kv;
              VT[(c8 + 0) * 72 + kr] = (bf16)(vv.x & 0xffffu); VT[(c8 + 1) * 72 + kr] = (bf16)(vv.x >> 16); VT[(c8 + 2) * 72 + kr] = (bf16)(vv.y & 0xffffu); VT[(c8 + 3) * 72 + kr] = (bf16)(vv.y >> 16);
              VT[(c8 + 4) * 72 + kr] = (bf16)(vv.z & 0xffffu); VT[(c8 + 5) * 72 + kr] = (bf16)(vv.z >> 16); VT[(c8 + 6) * 72 + kr] = (bf16)(vv.w & 0xffffu); VT[(c8 + 7) * 72 + kr] = (bf16)(vv.w >> 16); }
            if (jb > -1) SB_FETCH(jb - 1);
            __syncthreads();
            if (jb == 2 * qb + 1 && wave < 4) { if (lane == 0) MINR[wave] = 0.f; continue; }
            float z[16];
#pragma unroll
            for (int i = 0; i < 4; ++i) { const LAS bf16* kp = Ks + (16 * (l15 >> 2) + 4 * i + (l15 & 3)) * 72 + 8 * g;
                f32x4 a = {0.f, 0.f, 0.f, 0.f};
                a = __builtin_amdgcn_mfma_f32_16x16x32_bf16(*(const LAS bf16x8*)kp, q0, a, 0, 0, 0);
                a = __builtin_amdgcn_mfma_f32_16x16x32_bf16(*(const LAS bf16x8*)(kp + 32), q1, a, 0, 0, 0);
                z[4 * i + 0] = a[0] * 0.125f; z[4 * i + 1] = a[1] * 0.125f; z[4 * i + 2] = a[2] * 0.125f; z[4 * i + 3] = a[3] * 0.125f; }
            const int kbase = (jb >= 0) ? 64 * jb + 16 * g : 16 * g;
            float cum[16]; float run = 0.f;
#pragma unroll
            for (int n = 15; n >= 0; --n) { const bool ok = (jb >= 0) ? (kbase + n < tq) : (kbase + n < NMETA);
                const float zz = z[n]; const float sp = fmaxf(zz, 0.f) + __logf(1.f + __expf(-fabsf(zz)));
                run += ok ? sp : 0.f; cum[n] = run; }
            const float t1 = __shfl(run, (lane + 16) & 63), t2 = __shfl(run, (lane + 32) & 63), t3 = __shfl(run, (lane + 48) & 63);
            const float higher = (g < 3 ? t1 : 0.f) + (g < 2 ? t2 : 0.f) + (g < 1 ? t3 : 0.f);
            const float lower = (g >= 1 ? t3 : 0.f) + (g >= 2 ? t2 : 0.f) + (g >= 3 ? t1 : 0.f);
            const float base = R + higher;
            float av[16];
#pragma unroll
            for (int n = 0; n < 16; ++n) { const bool ok = (jb >= 0) ? (kbase + n < tq) : (kbase + n < NMETA); av[n] = ok ? __expf(z[n] - (base + cum[n])) : 0.f; }
            R += run + higher + lower;
#pragma unroll
            for (int ks = 0; ks < 2; ++ks) { v4u bw; bw.x = pk2(av[8 * ks + 0], av[8 * ks + 1]); bw.y = pk2(av[8 * ks + 2], av[8 * ks + 3]); bw.z = pk2(av[8 * ks + 4], av[8 * ks + 5]); bw.w = pk2(av[8 * ks + 6], av[8 * ks + 7]);
                const bf16x8 bfr = __builtin_bit_cast(bf16x8, bw);
#pragma unroll
                for (int et = 0; et < 4; ++et) { const bf16x8 afr = *(const LAS bf16x8*)(VT + (16 * et + l15) * 72 + 16 * g + 8 * ks); o[et] = __builtin_amdgcn_mfma_f32_16x16x32_bf16(afr, bfr, o[et], 0, 0, 0); } }
            const float rm = row16_min(R);
            if (lane == 0) MINR[wave] = rm;
        }
        float ss = 0.f;
#pragma unroll
        for (int et = 0; et < 4; ++et) ss += (o[et][0] * o[et][0] + o[et][1] * o[et][1]) + (o[et][2] * o[et][2] + o[et][3] * o[et][3]);
        ss += __shfl_xor(ss, 16); ss += __shfl_xor(ss, 32);
        const float rstd = 1.0f / sqrtf(ss * (1.0f / 64.0f) + EPS);
#pragma unroll
        for (int et = 0; et < 4; ++et) { const int e = 16 * et + 4 * g; const f32x4 gg = *(const f32x4*)(F.sb_g + hd * 64 + e);
            v2u w; w.x = pk2(o[et][0] * rstd * gg[0], o[et][1] * rstd * gg[1]); w.y = pk2(o[et][2] * rstd * gg[2], o[et][3] * rstd * gg[3]);
            *(v2u*)(PR + qrow + CQS + hd * 64 + e) = w; }
    }
#undef SB_FETCH
    __syncthreads();
}

__device__ __forceinline__ void p3_scan(Frame& F) {
    const int bh = F.vcu >> 5, h = bh & 3, tid = F.tid, lane = F.lane;
    LAS float* DEC = (LAS float*)F.lds; LAS float* SCL = DEC + 128; LAS float* WM = DEC + 256;
    const float* PRM = WSP(float, WS_PRM);
    __syncthreads();
    if (F.wave == 0) {
        float li = -INFINITY, lf = 0.f;
        if (lane < NMETA) { li = PRM[(size_t)lane * NIN + OI_ + h] + F.b_i[h]; lf = logsigmoidf_(PRM[(size_t)lane * NIN + OF_ + h] + F.b_f[h]); }
        float bs = lf;
        bs = wave_scan_sum(bs, lane);
        const float bL = rdl_f(bs, 63); const float gg = bL - bs + li; float M = fmaxf(bL, wave_max(gg));
        if (lane < NMETA) WM[lane] = __expf(gg - M);
        const float* AC = WSP(float, WS_AC) + bh * 128; const float* BC = WSP(float, WS_BC) + bh * 128;
        for (int c = 0; c < 128; ++c) { const float a = AC[c], bc = BC[c]; const float Mn = fmaxf(M + a, bc);
            if (lane == 0) { DEC[c] = __expf(a + M - Mn); SCL[c] = __expf(bc - Mn); if ((F.vcu & 31) == 0) WSP(float, WS_MIN)[bh * 128 + c] = M; }
            M = Mn; }
    }
    __syncthreads();
    const int elem = (F.vcu & 31) * 512 + tid, e = elem >> 7, d = elem & 127;
    const float* KM = WSP(float, WS_KM) + (size_t)h * 16 * 128;
    float C = 0.f;
#pragma unroll
    for (int s = 0; s < NMETA; ++s) C += WM[s] * PRM[(size_t)s * NIN + OV_ + h * 128 + e] * KM[s * 128 + d];
    bf16* U = WSP(bf16, WS_U) + (size_t)bh * 128 * 16384 + elem;
    for (int c0 = 0; c0 < 128; c0 += 16) {
        unsigned short u[16];
#pragma unroll
        for (int j = 0; j < 16; ++j) u[j] = U[(size_t)(c0 + j) * 16384];
#pragma unroll
        for (int j = 0; j < 16; ++j) { U[(size_t)(c0 + j) * 16384] = (bf16)f2bf(C); C = DEC[c0 + j] * C + SCL[c0 + j] * bf2f(u[j]); }
    }
    if ((F.vcu & 31) == 0 && tid < 128) {
        float n = 0.f;
#pragma unroll
        for (int s = 0; s < NMETA; ++s) n += WM[s] * KM[s * 128 + tid];
        const float* NU = WSP(float, WS_NU) + (size_t)bh * 128 * 128 + tid; float* NS = WSP(float, WS_NS) + (size_t)bh * 128 * 128 + tid;
        for (int c = 0; c < 128; ++c) { NS[c * 128] = n; n = DEC[c] * n + SCL[c] * NU[c * 128]; }
    }
    __syncthreads();
}

constexpr int L4_Q = 0, L4_K = 17408, L4_VT = 34816, L4_CS = 53248, L4_S = 88064, L4_TAB = 97280;
__device__ __forceinline__ void p4_mlstm_out(Frame& F) {
    const int bh = F.vcu >> 5, b = bh >> 2, h = bh & 3, tid = F.tid, lane = F.lane, wave = F.wave, g = lane >> 4, l15 = lane & 15;
    LAS bf16* Qs = (LAS bf16*)(F.lds + L4_Q); LAS bf16* Ks = (LAS bf16*)(F.lds + L4_K); LAS bf16* VT = (LAS bf16*)(F.lds + L4_VT);
    LAS bf16* CS = (LAS bf16*)(F.lds + L4_CS); LAS bf16* Ss = (LAS bf16*)(F.lds + L4_S); LAS float* T = (LAS float*)(F.lds + L4_TAB);
    bf16* PR = WSP(bf16, WS_PR);
    const bf16* Qg = WSP(bf16, WS_QK); const bf16* Kg = Qg + (size_t)MROWS * 512;
    v4u rq[2], rk[2], rc[4], rv[2]; float rT0 = 0.f, rT1 = 0.f, rNS = 0.f, rMin;
#define P4_FETCH(UI) do { const int _chunk = (F.vcu & 31) + 32 * (UI); const int _m0 = b * SEQ + _chunk * 64; const int _uc = bh * 128 + _chunk; \
        _Pragma("unroll") for (int _k = 0; _k < 2; ++_k) { const int _i = tid + NTHR * _k; const int _t = _i >> 4, _c8 = (_i & 15) * 8; const size_t _go = (size_t)(_m0 + _t) * 512 + h * 128 + _c8; rq[_k] = *(const v4u*)(Qg + _go); rk[_k] = *(const v4u*)(Kg + _go); \
            rv[_k] = *(const v4u*)(PR + (size_t)(_m0 + _t) * NPROJ + CV_ + h * 128 + _c8); } \
        _Pragma("unroll") for (int _k = 0; _k < 4; ++_k) { const int _i = tid + NTHR * _k; const int _e = _i >> 4, _c8 = (_i & 15) * 8; rc[_k] = *(const v4u*)(WSP(bf16, WS_U) + (size_t)_uc * 16384 + _e * 128 + _c8); } \
        if (tid < 64) { rT0 = WSP(float, WS_BT)[(_m0 + tid) * 4 + h]; rT1 = WSP(float, WS_GI)[(_m0 + tid) * 4 + h]; } \
        if (tid >= 128 && tid < 256) rNS = WSP(float, WS_NS)[(size_t)_uc * 128 + tid - 128]; \
        rMin = WSP(float, WS_MIN)[_uc]; } while (0)
    P4_FETCH(0);
    for (int ui = 0; ui < 4; ++ui) {
        const int chunk = (F.vcu & 31) + 32 * ui; const int m0 = b * SEQ + chunk * 64;
        __syncthreads();
#pragma unroll
        for (int k = 0; k < 2; ++k) { const int i = tid + NTHR * k; const int t = i >> 4, c8 = (i & 15) * 8; *(LAS v4u*)(Qs + t * 136 + c8) = rq[k]; *(LAS v4u*)(Ks + t * 136 + c8) = rk[k];
            const v4u pv = rv[k];
#pragma unroll
            for (int q = 0; q < 4; ++q) { VT[(c8 + 2 * q) * 72 + t] = (bf16)(pv[q] & 0xffffu); VT[(c8 + 2 * q + 1) * 72 + t] = (bf16)(pv[q] >> 16); } }
#pragma unroll
        for (int k = 0; k < 4; ++k) { const int i = tid + NTHR * k; const int e = i >> 4, c8 = (i & 15) * 8; *(LAS v4u*)(CS + e * 136 + c8) = rc[k]; }
        if (tid < 64) { T[tid] = rT0; T[64 + tid] = rT1; }
        if (tid >= 128 && tid < 256) T[640 + tid - 128] = rNS;
        const float Min = rMin;
        P4_FETCH(ui + 1 < 4 ? ui + 1 : 3);
        __syncthreads();
        if (wave == 0) {
            const float bt = T[lane], li = T[64 + lane]; float pm = li - bt;
            pm = wave_scan_max(pm, lane);
            const float Mt = bt + fmaxf(Min, pm);
            T[128 + lane] = Mt; T[192 + lane] = __expf(bt + Min - Mt);
        }
        { const int t = tid >> 3, part = tid & 7; float s = 0.f;
#pragma unroll
          for (int j = 0; j < 16; ++j) s += bf2f(Qs[t * 136 + part * 16 + j]) * T[640 + part * 16 + j];
          s += dpp_f<0xB1>(s); s += dpp_f<0x4E>(s); s += dpp_f<0x124>(s);
          if (part == 0) T[256 + t] = s; }
        __syncthreads();
#pragma unroll
        for (int j = 0; j < 2; ++j) { const int tt = wave >> 1, st = 2 * (wave & 1) + j; f32x4 a = {0.f, 0.f, 0.f, 0.f};
            a = mma_rows<4>(Qs + (16 * tt + l15) * 136 + 8 * g, Ks + (16 * st + l15) * 136 + 8 * g, a);
            const int s = 16 * st + l15; const float cs = T[64 + s] - T[s];
#pragma unroll
            for (int r = 0; r < 4; ++r) { const int t = 16 * tt + 4 * g + r; const float wgt = (s <= t) ? __expf(T[t] + cs - T[128 + t]) : 0.f; const float v = a[r] * wgt;
                Ss[t * 72 + s] = (bf16)f2bf(v); const float rs = row16_sum(v);
                if (l15 == 0) T[384 + st * 64 + t] = rs; } }
        __syncthreads();
        if (tid < 64) { const float den = T[192 + tid] * T[256 + tid] + (T[384 + tid] + T[448 + tid]) + (T[512 + tid] + T[576 + tid]); T[320 + tid] = 1.0f / fmaxf(fabsf(den), __expf(-T[128 + tid])); }
        f32x4 acc[4];
        const int tt = wave >> 1, tl = 16 * tt + l15;
#pragma unroll
        for (int j = 0; j < 4; ++j) { const int et = 4 * (wave & 1) + j; f32x4 a = {0.f, 0.f, 0.f, 0.f};
            a = mma_rows<4>(CS + (16 * et + l15) * 136 + 8 * g, Qs + (16 * tt + l15) * 136 + 8 * g, a);
            a = a * T[192 + tl];
            a = mma_rows<2>(VT + (16 * et + l15) * 72 + 8 * g, Ss + (16 * tt + l15) * 72 + 8 * g, a);
            acc[j] = a; }
        __syncthreads();
        float ps = 0.f, pq = 0.f; const float invd = T[320 + tl];
        const size_t orow = (size_t)(m0 + tl) * NPROJ + CO_ + h * 128, crow = (size_t)(m0 + tl) * 512 + h * 128;
#pragma unroll
        for (int j = 0; j < 4; ++j) { const int e0 = 16 * (4 * (wave & 1) + j) + 4 * g; const v2u opk = *(const v2u*)(PR + orow + e0);
            const float op[4] = {bf2f(opk[0] & 0xffffu), __uint_as_float(opk[0] & 0xffff0000u), bf2f(opk[1] & 0xffffu), __uint_as_float(opk[1] & 0xffff0000u)};
#pragma unroll
            for (int r = 0; r < 4; ++r) { const float hv = acc[j][r] * invd / (1.f + __expf(-op[r])); acc[j][r] = hv; ps += hv; pq += hv * hv; } }
        ps += __shfl_xor(ps, 16); ps += __shfl_xor(ps, 32); pq += __shfl_xor(pq, 16); pq += __shfl_xor(pq, 32);
        if (g == 0) { T[768 + (wave & 1) * 64 + tl] = ps; T[896 + (wave & 1) * 64 + tl] = pq; }
        __syncthreads();
        { const float mu = (T[768 + tl] + T[832 + tl]) * (1.f / 128.f); const float var = (T[896 + tl] + T[960 + tl]) * (1.f / 128.f) - mu * mu; const float rsd = 1.0f / sqrtf(fmaxf(var, 0.f) + EPS);
#pragma unroll
          for (int j = 0; j < 4; ++j) { const int e0 = 16 * (4 * (wave & 1) + j) + 4 * g; const f32x4 gn = *(const f32x4*)(F.gn_g + h * 128 + e0), sk = *(const f32x4*)(F.skip + h * 128 + e0);
              const v2u cpk = *(const v2u*)(WSP(bf16, WS_CB) + crow + e0);
              const float cv[4] = {bf2f(cpk[0] & 0xffffu), __uint_as_float(cpk[0] & 0xffff0000u), bf2f(cpk[1] & 0xffffu), __uint_as_float(cpk[1] & 0xffff0000u)};
              float y[4];
#pragma unroll
              for (int r = 0; r < 4; ++r) y[r] = (acc[j][r] - mu) * rsd * gn[r] + sk[r] * cv[r];
              v2u o; o[0] = pk2(y[0], y[1]); o[1] = pk2(y[2], y[3]); *(v2u*)(PR + orow + e0) = o; } }
    }
    __syncthreads();
}

constexpr int L7_SK = 0, L7_LS = 69632;
__device__ __forceinline__ int pack_key(float v, int idx, unsigned mask) { int k = (int)((__builtin_bit_cast(unsigned, v) & ~mask) | (unsigned)idx); return k < 0 ? (k ^ 0x7fffffff) : k; }
__device__ __forceinline__ float key_val(int k, unsigned mask) { const int u = k < 0 ? (k ^ 0x7fffffff) : k; return __builtin_bit_cast(float, (unsigned)u & ~mask); }
__device__ __forceinline__ int key_idx(int k, unsigned mask) { const int u = k < 0 ? (k ^ 0x7fffffff) : k; return (int)((unsigned)u & mask); }
__device__ __forceinline__ void bitonic_sort16_desc(int (&t)[16]) {
#pragma unroll
    for (int k = 2; k <= 16; k <<= 1)
#pragma unroll
        for (int j = k >> 1; j > 0; j >>= 1)
#pragma unroll
            for (int i = 0; i < 16; ++i) { const int l = i ^ j; if (l > i) { const bool desc = ((i & k) == 0); const int hi = max(t[i], t[l]), lo = min(t[i], t[l]); t[i] = desc ? hi : lo; t[l] = desc ? lo : hi; } }
}
__device__ __forceinline__ void bitonic_merge16_desc(int (&t)[16]) {
#pragma unroll
    for (int j = 8; j > 0; j >>= 1)
#pragma unroll
        for (int i = 0; i < 16; ++i) { const int l = i ^ j; if (l > i) { const int hi = max(t[i], t[l]), lo = min(t[i], t[l]); t[i] = hi; t[l] = lo; } }
}
#define TOPK_INS(t, x) do { int _x = (x); _Pragma("unroll") for (int _i = 0; _i < 16; ++_i) { const int _hi = max(t[_i], _x); _x = min(t[_i], _x); t[_i] = _hi; } } while (0)
__device__ __forceinline__ void p7_topk(Frame& F) {
    const int tid = F.tid, lane = F.lane, wave = F.wave, g = lane >> 4, l15 = lane & 15;
    LAS bf16* SK = (LAS bf16*)(F.lds + L7_SK); LAS int* LS = (LAS int*)(F.lds + L7_LS); LAS int* HIST = (LAS int*)(F.lds + L7_LS + 65536);
    const bf16* QP = WSP(bf16, WS_QP);
    __syncthreads();
    for (int i = tid; i < 4096; i += NTHR) { const int row = i >> 4, c8 = (i & 15) * 8; *(LAS v4u*)(SK + row * 136 + c8) = *(const v4u*)(WSP(bf16, WS_SKB) + (size_t)row * 128 + c8); }
    __syncthreads();
    for (int unit = F.vcu; unit < MROWS / 64; unit += F.G) {
        const int tok0 = unit * 64, h = wave;
        for (int i = tid; i < 2048; i += NTHR) HIST[i] = 0;
        bf16x8 qf[4], qn[4];
        { const bf16* qrow = QP + (size_t)(tok0 + l15) * 2048 + h * 256 + 8 * g;
#pragma unroll
          for (int k = 0; k < 4; ++k) qf[k] = *(const bf16x8*)(qrow + 32 * k); }
#pragma unroll 1
        for (int it = 0; it < 8; ++it) {
            const int p = it >> 2, tt = it & 3;
            if (it + 1 < 8) { const int p2 = (it + 1) >> 2, tt2 = (it + 1) & 3; const bf16* qrow = QP + (size_t)(tok0 + 16 * tt2 + l15) * 2048 + h * 256 + p2 * 128 + 8 * g;
#pragma unroll
                for (int k = 0; k < 4; ++k) qn[k] = *(const bf16x8*)(qrow + 32 * k); }
            int ta[16], tb[16];
#pragma unroll
            for (int kt = 0; kt < 8; ++kt) { f32x4 a = {0.f, 0.f, 0.f, 0.f}; const LAS bf16* sk = SK + (p * 128 + 16 * kt + l15) * 136 + 8 * g;
#pragma unroll
                for (int k = 0; k < 4; ++k) a = __builtin_amdgcn_mfma_f32_16x16x32_bf16(*(const LAS bf16x8*)(sk + 32 * k), qf[k], a, 0, 0, 0);
#pragma unroll
                for (int r = 0; r < 4; ++r) { const int key = pack_key(a[r], 16 * kt + 4 * g + r, 127u); if (kt < 4) ta[4 * kt + r] = key; else tb[4 * (kt - 4) + r] = key; } }
            bitonic_sort16_desc(ta); bitonic_sort16_desc(tb);
#pragma unroll
            for (int i = 0; i < 16; ++i) ta[i] = max(ta[i], tb[15 - i]);
            bitonic_merge16_desc(ta);
#pragma unroll
            for (int dd = 16; dd <= 32; dd <<= 1) {
#pragma unroll
                for (int i = 0; i < 16; ++i) tb[i] = __shfl_xor(ta[i], dd);
#pragma unroll
                for (int i = 0; i < 16; ++i) ta[i] = max(ta[i], tb[15 - i]);
                bitonic_merge16_desc(ta); }
            if (g == 0) { LAS int* dst = LS + (((16 * tt + l15) * 8 + h) * 2 + p) * 16;
#pragma unroll
                for (int i = 0; i < 16; ++i) dst[i] = ta[i]; }
#pragma unroll
            for (int k = 0; k < 4; ++k) qf[k] = qn[k];
        }
        __syncthreads();
        { const int tok = tid >> 3, h2 = tid & 7; const LAS int* la = LS + ((tok * 8 + h2) * 2 + 0) * 16; const LAS int* lb = la + 16;
          float av[16], bv[16];
#pragma unroll
          for (int i = 0; i < 16; ++i) { av[i] = key_val(la[i], 127u); bv[i] = key_val(lb[i], 127u); }
          int top[16];
#pragma unroll
          for (int i = 0; i < 16; ++i) top[i] = (int)0x80000000;
#pragma unroll
          for (int i = 0; i < 16; ++i)
#pragma unroll
              for (int j = 0; j < 16; ++j) if ((i + 1) * (j + 1) <= 16) TOPK_INS(top, pack_key(av[i] + bv[j], i * 16 + j, 255u));
          const float vmax = key_val(top[0], 255u); float ev[16]; float z = 0.f;
#pragma unroll
          for (int k = 0; k < 16; ++k) { ev[k] = __expf(key_val(top[k], 255u) - vmax); z += ev[k]; }
          const float rz = 1.0f / z;
          int eidx[16]; float gate[16];
#pragma unroll
          for (int k = 0; k < 16; ++k) { const int ij = key_idx(top[k], 255u); const int ei = key_idx(la[ij >> 4], 127u), ej = key_idx(lb[ij & 15], 127u);
              eidx[k] = ei * 128 + ej; gate[k] = ev[k] * rz; __hip_atomic_fetch_add(HIST + tok * 32 + (eidx[k] >> 9), 1, __ATOMIC_RELAXED, __HIP_MEMORY_SCOPE_WORKGROUP); }
          __syncthreads();
          if (tid < 64) { int run = 0;
#pragma unroll
              for (int b = 0; b < 32; ++b) { const int c = HIST[tid * 32 + b]; HIST[tid * 32 + b] = run; run += c; } }
          __syncthreads();
          if (h2 == 0) { const f32x4* q = (const f32x4*)(WSP(float, WS_SSQ) + (size_t)(tok0 + tok) * 16); float ssq = 0.f;
#pragma unroll
              for (int j = 0; j < 4; ++j) { const f32x4 a = q[j]; ssq += (a[0] + a[1]) + (a[2] + a[3]); }
              WSP(float, WS_RS2)[tok0 + tok] = 1.0f / sqrtf(ssq * (1.0f / DM) + EPS); }
          v2u* tk = (v2u*)WSP(unsigned, WS_TK) + (size_t)(tok0 + tok) * 128;
#pragma unroll
          for (int k = 0; k < 16; ++k) { const int pos = __hip_atomic_fetch_add(HIST + tok * 32 + (eidx[k] >> 9), 1, __ATOMIC_RELAXED, __HIP_MEMORY_SCOPE_WORKGROUP);
              v2u o; o.x = (unsigned)eidx[k]; o.y = __builtin_bit_cast(unsigned, gate[k]); tk[pos] = o; } }
        asm volatile("s_waitcnt vmcnt(0)" ::: "memory");
        __syncthreads();
    }
}

__device__ __forceinline__ float gelu_erf(float v) { return 0.5f * v * (1.0f + erff(v * 0.70710678118654752f)); }
typedef float f32x2v __attribute__((ext_vector_type(2)));
#define P8_LOAD8(RB, G) P8_LOAD8X(RB, G, e0.x, e1.x)
#define P8_LOAD8X(RB, G, EX0, EX1) do { if ((G) < 32) { const unsigned char* _tab = ((G) < 16) ? EU : EV; _Pragma("unroll") for (int _j = 0; _j < 8; ++_j) { const int _k = 8 * ((G) & 15) + _j; const unsigned _s = (_k < 64) ? (EX0) : (EX1); \
        const unsigned _ei = (unsigned)__builtin_amdgcn_readlane((int)_s, _k & 63); RB[_j] = *(const v2u*)(_tab + (size_t)_ei * (DM / 2) + 8 * lane); } } } while (0)
__device__ __forceinline__ float gelu_as(float v) {
    const float av = fabsf(v), t = __builtin_amdgcn_rcpf(av * 0.2316418882f + 1.0f);
    float q = t * 0.5307027145f + (-0.7265760135f); q = q * t + 0.7107068705f; q = q * t + (-0.142248368f); q = q * t + 0.127414796f; q = q * t;
    const float m = v * (q * __builtin_amdgcn_exp2f((v * v) * (-0.72134752044f)));
    return v < 0.f ? m : v - m;
}
__device__ __forceinline__ float reduce8_butterfly(const float (&d)[8], int lane) {
    const bool b5 = (lane & 32) != 0, b4 = (lane & 16) != 0, b3 = (lane & 8) != 0;
    float k4[4];
#pragma unroll
    for (int i = 0; i < 4; ++i) { const float snd = b5 ? d[i] : d[i + 4], kp = b5 ? d[i + 4] : d[i]; k4[i] = kp + __shfl_xor(snd, 32); }
    float k2[2];
#pragma unroll
    for (int i = 0; i < 2; ++i) { const float snd = b4 ? k4[i] : k4[i + 2], kp = b4 ? k4[i + 2] : k4[i]; k2[i] = kp + __shfl_xor(snd, 16); }
    float k1; { const float snd = b3 ? k2[0] : k2[1], kp = b3 ? k2[1] : k2[0]; k1 = kp + __shfl_xor(snd, 8); }
    k1 += __shfl_xor(k1, 4); k1 += __shfl_xor(k1, 2); k1 += __shfl_xor(k1, 1);
    return k1;
}
#define P8_UDOT(UB, G) do { _Pragma("unroll") for (int _j = 0; _j < 8; ++_j) { \
            int _sh = __builtin_amdgcn_sdot8((int)UB[_j][0], (int)xh0, 0, false); _sh = __builtin_amdgcn_sdot8((int)UB[_j][1], (int)xh1, _sh, false); \
            int _sl = __builtin_amdgcn_sdot8((int)UB[_j][0], (int)xl0, 0, false); _sl = __builtin_amdgcn_sdot8((int)UB[_j][1], (int)xl1, _sl, false); const int _s = (_sh << 4) + _sl; \
            red[(8 * ((G) & 7) + _j) * 65 + lane] = (float)_s; } \
        if (((G) & 7) == 7) { float _t0 = 0.f, _t1 = 0.f, _t2 = 0.f, _t3 = 0.f; _Pragma("unroll") for (int _i = 0; _i < 64; _i += 4) { _t0 += red[lane * 65 + _i]; _t1 += red[lane * 65 + _i + 1]; _t2 += red[lane * 65 + _i + 2]; _t3 += red[lane * 65 + _i + 3]; } \
            const float _dl = (_t0 + _t1) + (_t2 + _t3); const bool _c1 = (G) >= 8; const float _gl = __uint_as_float(_c1 ? e1.y : e0.y), _su = __uint_as_float(_c1 ? s1x : s0x); \
            const float _cv = _gl * gelu_as((_dl + hsx) * _su * rsx) * 0.25f; if (_c1) c1 = _cv; else c0 = _cv; } } while (0)
#define P8_FP4ACC(w, sel, i0) { const f32x2v _f = __builtin_amdgcn_cvt_scalef32_pk_f32_fp4((w), 1.0f, sel); acc[i0] += _c * _f[0]; acc[(i0) + 1] += _c * _f[1]; }
#define P8_VACC(VB, G) do { const int _g = (G) - 16; const float _csrc = (_g < 8) ? c0 : c1; _Pragma("unroll") for (int _j = 0; _j < 8; ++_j) { \
            asm volatile("" : "+v"(VB[_j][0]), "+v"(VB[_j][1]) : "v"(acc[0]), "v"(acc[5]), "v"(acc[10]), "v"(acc[15])); \
            const float _c = __uint_as_float((unsigned)__builtin_amdgcn_readlane((int)__float_as_uint(_csrc), 8 * (_g & 7) + _j)); \
            P8_FP4ACC(VB[_j][0], 0, 0) P8_FP4ACC(VB[_j][0], 1, 2) P8_FP4ACC(VB[_j][0], 2, 4) P8_FP4ACC(VB[_j][0], 3, 6) P8_FP4ACC(VB[_j][1], 0, 8) P8_FP4ACC(VB[_j][1], 1, 10) P8_FP4ACC(VB[_j][1], 2, 12) P8_FP4ACC(VB[_j][1], 3, 14) } } while (0)
typedef int v8i __attribute__((ext_vector_type(8)));
#define P8_CLOAD_V(RB, PC, H) do { _Pragma("unroll") for (int _r = 0; _r < 8; ++_r) RB[_r] = *(const v4u*)(EV + (size_t)vofv[H][_r] + 128 * (PC)); } while (0)
#define P8_SLAB(RB, PC, H, FIRST) do { \
        _Pragma("unroll") for (int _r = 0; _r < 8; ++_r) { v4u _w = RB[_r]; if (_r >= 4) { const unsigned _t0 = _w[0], _t1 = _w[1]; _w[0] = _w[2]; _w[1] = _w[3]; _w[2] = _t0; _w[3] = _t1; } \
            *(LAS v4u*)(SLB + ((_r & 1) ? wa1 : wa0) + 1024 * _r) = _w; } \
        _Pragma("unroll") for (int _i = 0; _i < 16; ++_i) { const int _cb = 4 * (_i & 3) + (_i >> 2); const int _ta = (tb ^ (16 * (_cb >> 1))) ^ (8 * (_cb & 1)); \
            const v2i_t _t0 = __builtin_amdgcn_ds_read_tr4_b64_v2i32((LAS v2i_t*)(SLB + _ta)); const v2i_t _t1 = __builtin_amdgcn_ds_read_tr4_b64_v2i32((LAS v2i_t*)(SLB + _ta + 2048)); \
            v8i _b, _a; _b[0] = _t0[0]; _b[1] = _t0[1]; _b[2] = _t1[0]; _b[3] = _t1[1]; _b[4] = 0; _b[5] = 0; _b[6] = 0; _b[7] = 0; \
            const bool _keep = (ln >> 2) == (_cb & 3); _a[0] = _keep ? (int)ah[H][0] : 0; _a[1] = _keep ? (int)ah[H][1] : 0; _a[2] = _keep ? (int)ah[H][2] : 0; _a[3] = _keep ? (int)ah[H][3] : 0; _a[4] = 0; _a[5] = 0; _a[6] = 0; _a[7] = 0; \
            if ((FIRST) && (_cb & 3) == 0) { const f32x4 _z = {0.f, 0.f, 0.f, 0.f}; vacc[_cb >> 2] = _z; } \
            vacc[_cb >> 2] = __builtin_amdgcn_mfma_scale_f32_16x16x128_f8f6f4(_a, _b, vacc[_cb >> 2], 0, 4, 0, 0, 0, 0); } } while (0)
#define P8_VOUT(PC) do { _Pragma("unroll") for (int _a = 0; _a < 4; ++_a) OT[oto + 64 * (PC) + 16 * _a] = vacc[_a][0] + vacc[_a][1]; } while (0)
typedef int v2i_t __attribute__((ext_vector_type(2)));
__device__ __forceinline__ void p8_gather(Frame& F) {
    const int lane = F.lane; const int gw = F.vcu * NWAVES + F.wave, NGW = F.G * NWAVES;
    const unsigned char* EU = F.ws + WS_EU; const unsigned char* EV = F.ws + WS_EV; const bf16* H1B = WSP(bf16, WS_H1B);
    const unsigned long long* tkb = (const unsigned long long*)WSP(unsigned, WS_TK);
    unsigned long long nt0 = tkb[(size_t)(gw * 8) * 128 + lane], nt1 = tkb[(size_t)(gw * 8) * 128 + 64 + lane];
    v2u nx[4];
#pragma unroll
    for (int j = 0; j < 4; ++j) nx[j] = *(const v2u*)(H1B + (size_t)(gw * 8) * DM + 256 * j + 4 * lane);
    float nrs = WSP(float, WS_RS2)[gw * 8];
    const float* esc = WSP(float, WS_ESC);
    LAS float* red = (LAS float*)(F.lds + F.wave * 16640);
    LAS unsigned char* WL = F.lds + F.wave * 16640;
    LAS unsigned char* CTB = WL; LAS float* OT = (LAS float*)(WL + 1024); LAS unsigned char* SLB = WL + 8192;
    const int lq = lane >> 4, ln = lane & 15;
    const int cta = ((ln & 3) < 2 ? 128 * (ln & 3) : 256) + 16 * lq;
    const int wa0 = 128 * (lane >> 3) + 16 * ((lane & 7) ^ (lane >> 4)), wa1 = 128 * (lane >> 3) + 16 * ((lane & 7) ^ (4 + (lane >> 4)));
    const int tb = (32 * (lq & 1) + ln) * 128 + 16 * ((ln >> 1) & 7) + 8 * (lq & 1);
    const int oto = 256 * (ln >> 2) + 4 * lq + (ln & 3);
    f32x4 vacc[4];
    __syncthreads();
    float ns0x = esc[(unsigned)nt0], ns1x = esc[(unsigned)nt1];
    v2u b0[8], b1[8], b2[8];
    P8_LOAD8X(b0, 0, (unsigned)nt0, (unsigned)nt1); P8_LOAD8X(b1, 1, (unsigned)nt0, (unsigned)nt1);
    for (int tok = gw * 8; tok < gw * 8 + 8; ++tok) {
        float xf[16];
#pragma unroll
        for (int j = 0; j < 4; ++j) { const v2u xr = nx[j];
            xf[4 * j] = bf2f(xr[0] & 0xffffu); xf[4 * j + 1] = __uint_as_float(xr[0] & 0xffff0000u); xf[4 * j + 2] = bf2f(xr[1] & 0xffffu); xf[4 * j + 3] = __uint_as_float(xr[1] & 0xffff0000u); }
        v2u e0, e1; e0.x = (unsigned)nt0; e0.y = (unsigned)(nt0 >> 32); e1.x = (unsigned)nt1; e1.y = (unsigned)(nt1 >> 32);
        const unsigned s0x = __float_as_uint(ns0x), s1x = __float_as_uint(ns1x);
        float amax = 0.f;
#pragma unroll
        for (int i = 0; i < 16; ++i) amax = fmaxf(amax, fabsf(xf[i]));
        amax = wave_max(amax); const float sx = amax > 0.f ? 119.0f / amax : 1.0f;
        int sxl = 0; unsigned xh0 = 0u, xh1 = 0u, xl0 = 0u, xl1 = 0u;
#pragma unroll
        for (int i = 0; i < 16; ++i) { const int q = (int)rintf(xf[i] * sx); sxl += q; const int l = ((q + 8) & 15) - 8, h = (q - l) >> 4;
            if (i < 8) { xl0 |= ((unsigned)l & 15u) << (4 * i); xh0 |= ((unsigned)h & 15u) << (4 * i); } else { xl1 |= ((unsigned)l & 15u) << (4 * (i - 8)); xh1 |= ((unsigned)h & 15u) << (4 * (i - 8)); } }
        const float hsx = 0.5f * wave_sum((float)sxl);
        const float rsx = nrs / sx;
        float c0 = 0.f, c1 = 0.f;
        P8_LOAD8(b2, 2); P8_UDOT(b0, 0);
        P8_LOAD8(b0, 3); P8_UDOT(b1, 1);
        P8_LOAD8(b1, 4); P8_UDOT(b2, 2);
        P8_LOAD8(b2, 5); P8_UDOT(b0, 3);
        P8_LOAD8(b0, 6); P8_UDOT(b1, 4);
        P8_LOAD8(b1, 7); P8_UDOT(b2, 5);
        P8_LOAD8(b2, 8); P8_UDOT(b0, 6);
        P8_LOAD8(b0, 9); P8_UDOT(b1, 7);
        P8_LOAD8(b1, 10); P8_UDOT(b2, 8);
        P8_LOAD8(b2, 11); P8_UDOT(b0, 9);
        P8_LOAD8(b0, 12); P8_UDOT(b1, 10);
        P8_LOAD8(b1, 13); P8_UDOT(b2, 11);
        P8_LOAD8(b2, 14); P8_UDOT(b0, 12);
        P8_LOAD8(b0, 15); P8_UDOT(b1, 13);
        unsigned vofv[2][8];
#pragma unroll
        for (int h = 0; h < 2; ++h)
#pragma unroll
            for (int r = 0; r < 8; ++r) vofv[h][r] = (unsigned)__builtin_amdgcn_ds_bpermute(4 * (8 * r + (lane >> 3)), (int)(h ? e1.x : e0.x)) * 512u + 16u * (lane & 7);
        v4u sa[8], sb[8];
        P8_CLOAD_V(sa, 0, 0);
        P8_UDOT(b2, 14);
        P8_CLOAD_V(sb, 0, 1);
        P8_UDOT(b0, 15);
        asm volatile("" ::: "memory");
        const int tokn = tok + 1 < gw * 8 + 8 ? tok + 1 : tok;
        nt0 = tkb[(size_t)tokn * 128 + lane]; nt1 = tkb[(size_t)tokn * 128 + 64 + lane];
#pragma unroll
        for (int j = 0; j < 4; ++j) nx[j] = *(const v2u*)(H1B + (size_t)tokn * DM + 256 * j + 4 * lane);
        nrs = WSP(float, WS_RS2)[tokn];
        const float cmax = wave_max(fmaxf(fabsf(c0), fabsf(c1))); const float sc = cmax > 0.f ? 256.0f / cmax : 1.0f, rsc = 1.0f / sc;
        { const float a0 = c0 * sc, a1 = c1 * sc; const int h = __builtin_amdgcn_cvt_pk_fp8_f32(a0, a1, 0, false);
          const f32x2v rb = __builtin_amdgcn_cvt_pk_f32_fp8(h, false); const int l = __builtin_amdgcn_cvt_pk_fp8_f32(a0 - rb[0], a1 - rb[1], 0, false);
          CTB[lane] = (unsigned char)(h & 0xff); CTB[64 + lane] = (unsigned char)((h >> 8) & 0xff); CTB[128 + lane] = (unsigned char)(l & 0xff); CTB[192 + lane] = (unsigned char)((l >> 8) & 0xff);
          if (lane < 8) { v4u z; z[0] = 0u; z[1] = 0u; z[2] = 0u; z[3] = 0u; *(LAS v4u*)(CTB + 256 + 16 * lane) = z; } }
        v4u ah[2];
#pragma unroll
        for (int h = 0; h < 2; ++h) ah[h] = *(const LAS v4u*)(CTB + cta + 64 * h);
        P8_SLAB(sa, 0, 0, true);  P8_CLOAD_V(sa, 1, 0);
        P8_SLAB(sb, 0, 1, false); P8_CLOAD_V(sb, 1, 1);  P8_VOUT(0);
        P8_SLAB(sa, 1, 0, true);  P8_CLOAD_V(sa, 2, 0);
        P8_SLAB(sb, 1, 1, false); P8_CLOAD_V(sb, 2, 1);  P8_VOUT(1);
        P8_SLAB(sa, 2, 0, true);  P8_CLOAD_V(sa, 3, 0);
        P8_SLAB(sb, 2, 1, false); P8_CLOAD_V(sb, 3, 1);  P8_VOUT(2);
        ns0x = esc[(unsigned)nt0]; ns1x = esc[(unsigned)nt1];
        v2u hr[4];
#pragma unroll
        for (int j = 0; j < 4; ++j) hr[j] = *(const v2u*)(H1B + (size_t)tok * DM + 256 * j + 4 * lane);
        P8_LOAD8X(b2, 0, (unsigned)nt0, (unsigned)nt1);
        P8_SLAB(sa, 3, 0, true);
        P8_LOAD8X(b0, 1, (unsigned)nt0, (unsigned)nt1);
        P8_SLAB(sb, 3, 1, false); P8_VOUT(3);
        float acc[16];
#pragma unroll
        for (int j = 0; j < 4; ++j) { const f32x4 t = *(const LAS f32x4*)(OT + 256 * j + 4 * lane); acc[4 * j] = t[0] * rsc; acc[4 * j + 1] = t[1] * rsc; acc[4 * j + 2] = t[2] * rsc; acc[4 * j + 3] = t[3] * rsc; }
        f32x4* orow = (f32x4*)(F.out + (size_t)tok * DM) + lane; f32x4 hv[4]; float s2 = 0.f;
        f32x4 gv[4];
#pragma unroll
        for (int j = 0; j < 4; ++j) gv[j] = ((const f32x4*)F.g_fin)[lane + 64 * j];
#pragma unroll
        for (int j = 0; j < 4; ++j) {
            { const v2u xr = hr[j];
              hv[j][0] = bf2f(xr[0] & 0xffffu); hv[j][1] = __uint_as_float(xr[0] & 0xffff0000u); hv[j][2] = bf2f(xr[1] & 0xffffu); hv[j][3] = __uint_as_float(xr[1] & 0xffff0000u); }
#pragma unroll
            for (int i = 0; i < 4; ++i) { hv[j][i] += acc[4 * j + i]; s2 += hv[j][i] * hv[j][i]; } }
        s2 = wave_sum(s2); const float rstd3 = 1.0f / sqrtf(s2 * (1.0f / DM) + EPS);
#pragma unroll
        for (int j = 0; j < 4; ++j) orow[64 * j] = hv[j] * rstd3 * gv[j];
#pragma unroll
        for (int j = 0; j < 8; ++j) { const v2u t = b0[j]; b0[j] = b2[j]; b1[j] = t; }
        asm volatile("" ::: "memory");
    }
}

constexpr int CW_BAR = 4096;
static_assert((CW_BAR + XCD_BAR_WORDS) * 4 <= (int)CTL_ZERO_BYTES, "barrier words inside the zeroed region");

__global__ void __launch_bounds__(NTHR, 2) hybrid_fwd(Params prm) {
    extern __shared__ __attribute__((aligned(16))) unsigned char lds_raw[];
    Frame F;
    F.lds = (LAS unsigned char*)lds_raw;
    F.tid = threadIdx.x; F.lane = F.tid & 63; F.wave = __builtin_amdgcn_readfirstlane(F.tid >> 6);
    F.G = gridDim.x; { const int bx = blockIdx.x; F.vcu = (F.G % 8 == 0) ? (bx % 8) * (F.G / 8) + bx / 8 : bx; }
    F.x = prm.in[0]; F.meta = prm.in[1]; F.g_mix = prm.in[2]; F.w_in = prm.in[3]; F.conv_w = prm.in[4]; F.conv_b = prm.in[5]; F.w_qm = prm.in[6]; F.w_km = prm.in[7];
    F.b_i = prm.in[8]; F.b_f = prm.in[9]; F.skip = prm.in[10]; F.gn_g = prm.in[11]; F.sb_g = prm.in[12]; F.w_out = prm.in[13]; F.g_ffn = prm.in[14]; F.w_query = prm.in[15];
    F.sub_keys = prm.in[16]; F.eu = prm.in[17]; F.ev = prm.in[18]; F.g_fin = prm.in[19]; F.out = prm.out; F.ws = prm.ws;
    volatile LAS unsigned* MISC = (volatile LAS unsigned*)(F.lds + LDSCTL_OFF);
    if (F.tid < 64) MISC[F.tid] = 0u;
    __syncthreads();
    XcdBarrier bar = xcd_barrier_post((unsigned*)(F.ws + WS_CTL) + CW_BAR, MISC + 8);

    p0_prologue(F);
    xcd_barrier(bar);
    {
        pg8::Gemm g{WSP(bf16, WS_XB), WSP(bf16, WS_WINT), MROWS, NPROJ, DM, DM, DM}; pg8::StaticOrder S; S.init(MROWS, NPROJ, F.G, (int)blockIdx.x);
        pg8::EpiRowScaleBf16<0> E{WSP(bf16, WS_PR), NPROJ, WSP(float, WS_RSTD1), EPS};
        pg8::gemm_phase<pg8::EpiRowScaleBf16<0>, pg8::StaticOrder, PG8_ALIGN, PG8_SP2>(F.lds, g, S, E);
        p1_meta_tail(F);
    }
    xcd_barrier(bar);
    p2_mlstm_local(F);
    p2_sb_attention(F);
    xcd_barrier(bar);
    p3_scan(F);
    xcd_barrier(bar);
    p4_mlstm_out(F);
    xcd_barrier(bar);
    {
        pg8::Gemm g{WSP(bf16, WS_PR) + CO_, WSP(bf16, WS_WOUTT), MROWS, DM, DM, NPROJ, DM}; pg8::StaticOrder S; S.init(MROWS, DM, F.G, (int)blockIdx.x);
        pg8::EpiResidual E{F.x, F.out, WSP(bf16, WS_H1B), WSP(float, WS_SSQ), DM};
        pg8::gemm_phase<pg8::EpiResidual, pg8::StaticOrder, PG8_ALIGN, PG8_SP2>(F.lds, g, S, E);
    }
    xcd_barrier(bar);
    {
        pg8::Gemm g{WSP(bf16, WS_H1B), WSP(bf16, WS_WQT), MROWS, 2048, DM, DM, DM}; pg8::StaticOrder S; S.init(MROWS, 2048, F.G, (int)blockIdx.x);
        pg8::EpiRowScaleBf16<1> E{WSP(bf16, WS_QP), 2048, WSP(float, WS_SSQ), EPS};
        pg8::gemm_phase<pg8::EpiRowScaleBf16<1>, pg8::StaticOrder, PG8_ALIGN, PG8_SP2>(F.lds, g, S, E);
    }
    xcd_barrier(bar);
    p7_topk(F);
    p8_gather(F);
}

extern "C" void kernel_launch(void* const* d_in, const int* in_sizes, int n_in, void* d_out, int out_size, void* d_ws, size_t ws_size, hipStream_t stream) {
    static int grid = 0;
    if (grid == 0) {
        if (n_in != 20 || in_sizes[0] != MROWS * DM || out_size != MROWS * DM || ws_size < WS_END) {
            fprintf(stderr, "kernel_launch: unexpected shapes (n_in %d, in0 %d, out %d, ws %zu < %zu); nothing launched\n", n_in, n_in > 0 ? in_sizes[0] : -1, out_size, ws_size, (size_t)WS_END); grid = -1; return; }
        int dev = 0, cus = 0, per_cu = 0;
        if (hipGetDevice(&dev) != hipSuccess || hipDeviceGetAttribute(&cus, hipDeviceAttributeMultiprocessorCount, dev) != hipSuccess) { fprintf(stderr, "kernel_launch: device query failed\n"); grid = -1; return; }
        if (hipFuncSetAttribute((const void*)hybrid_fwd, hipFuncAttributeMaxDynamicSharedMemorySize, LDS_BYTES) != hipSuccess) { fprintf(stderr, "kernel_launch: hipFuncSetAttribute failed\n"); grid = -1; return; }
        if (hipOccupancyMaxActiveBlocksPerMultiprocessor(&per_cu, (const void*)hybrid_fwd, NTHR, LDS_BYTES) != hipSuccess || per_cu < 1) { fprintf(stderr, "kernel_launch: occupancy query says %d blocks/CU\n", per_cu); (void)hipGetLastError(); grid = -1; return; }
        grid = cus;
        if (grid != 256) { fprintf(stderr, "kernel_launch: this kernel is built for a 256-CU device (got %d)\n", grid); grid = -1; return; }
    }
    if (grid < 0) return;
    if (hipMemsetAsync((char*)d_ws + WS_CTL, 0, CTL_ZERO_BYTES, stream) != hipSuccess) { fprintf(stderr, "kernel_launch: memset failed\n"); return; }
    Params p{};
    for (int i = 0; i < 20; ++i) p.in[i] = (const float*)d_in[i];
    p.out = (float*)d_out; p.ws = (unsigned char*)d_ws;
    void* args[] = {&p};
    const hipError_t e = hipLaunchCooperativeKernel((const void*)hybrid_fwd, dim3(grid), dim3(NTHR), args, LDS_BYTES, stream);
    if (e != hipSuccess) fprintf(stderr, "kernel_launch: cooperative launch failed: %s\n", hipGetErrorString(e));
}
```

```cpp
#include <hip/hip_runtime.h>
#include <hip/hip_cooperative_groups.h>
#include <cstdio>
#include <cstdint>
namespace cg = cooperative_groups;

namespace pg8 {
#define PG8_LAS __attribute__((address_space(3)))
typedef unsigned short bf16_t;
typedef short bf16x8 __attribute__((ext_vector_type(8)));
typedef float f32x4 __attribute__((ext_vector_type(4)));
typedef unsigned u32x4 __attribute__((ext_vector_type(4)));
typedef unsigned u32x2 __attribute__((ext_vector_type(2)));
constexpr int BM = 256, BK = 64, HALF = 128, HTB = HALF * BK * 2  , STAGE_BYTES = 8 * HTB, NXCD = 8, WGM = 8;

__host__ __device__ __forceinline__ int lds_byte(int r, int c) { const int st = (r >> 4) * 2 + (c >> 5), rr = r & 15, cc = c & 31, ob = rr * 64 + cc * 2; return st * 1024 + (ob ^ (((ob >> 9) & 1) << 5)); }
__host__ __device__ __forceinline__ void stage_rc(int b, int& R, int& C) { const int st = b / 1024, sb = b % 1024, swz = sb ^ (((sb >> 9) & 1) << 5); R = (st >> 1) * 16 + swz / 64; C = (st & 1) * 32 + (swz % 64) / 2; }
__host__ __device__ __forceinline__ int perm32(int rho) { const int n = rho >> 4, i = rho & 15; return 8 * (i >> 2) + 4 * n + (i & 3); }

struct Unit { int pm, pn; };
struct Gemm { const bf16_t* A; const bf16_t* Bt; int M, N, K, lda, ldb; };

struct StaticOrder {
    int nM, nN, nwg, G, c;
    __host__ __device__ void init(int M, int N, int G_, int c_) { nM = M / BM; nN = N / BM; nwg = nM * nN; G = G_; c = c_; }
    __host__ __device__ bool next(int i, Unit& u) const {
        const long L = (long)i * G + c; if (L >= nwg) return false;
        int wgid = (int)L; { const int q = nwg / NXCD, r = nwg % NXCD, xcd = wgid % NXCD, off = wgid / NXCD; wgid = (xcd < r ? xcd * (q + 1) : r * (q + 1) + (xcd - r) * q) + off; }
        const int nig = WGM * nN, gid = wgid / nig, fm = gid * WGM, gsz = (nM - fm) < WGM ? (nM - fm) : WGM;
        u.pm = fm + ((wgid % nig) % gsz); u.pn = (wgid % nig) / gsz; return true;
    }
    __device__ __forceinline__ void a_ready(const Unit&) const {}
    __device__ __forceinline__ void done(const Unit&) const {}
};

__device__ __forceinline__ unsigned cvt_pk_bf16(float lo, float hi) { unsigned r; asm volatile("v_cvt_pk_bf16_f32 %0, %1, %2" : "=v"(r) : "v"(lo), "v"(hi)); return r; }

template <int MODE> struct EpiRowScaleBf16 {
    static constexpr bool PERM = true, AFTER_DRAIN = false;
    bf16_t* O; int ldc; const float* rs; float eps;
    __device__ __forceinline__ void operator()(const f32x4 (&acc)[2][2][4][2], const Unit& u, int wr, int wc, int fr, int fq) const {
        const int row0 = u.pm * BM + wr * 64 + fr; const int col0 = u.pn * BM + wc * 32 + 8 * fq;
#pragma unroll
        for (int ai = 0; ai < 2; ++ai)
#pragma unroll
            for (int m = 0; m < 4; ++m) { const int row = row0 + ai * HALF + m * 16; float sc;
                if (MODE == 0) sc = rs[row];
                else { const f32x4* q = (const f32x4*)(rs + (size_t)row * 16); const f32x4 a = q[0], b = q[1], c = q[2], d = q[3];
                       const float s = ((a[0] + a[1]) + (a[2] + a[3])) + ((b[0] + b[1]) + (b[2] + b[3])) + ((c[0] + c[1]) + (c[2] + c[3])) + ((d[0] + d[1]) + (d[2] + d[3]));
                       sc = 1.0f / sqrtf(s * (1.0f / 1024.0f) + eps); }
                bf16_t* rowp = O + (size_t)row * ldc + col0;
#pragma unroll
                for (int bj = 0; bj < 2; ++bj) { const f32x4 v0 = acc[ai][bj][m][0] * sc, v1 = acc[ai][bj][m][1] * sc;
                    u32x4 w; w.x = cvt_pk_bf16(v0[0], v0[1]); w.y = cvt_pk_bf16(v0[2], v0[3]); w.z = cvt_pk_bf16(v1[0], v1[1]); w.w = cvt_pk_bf16(v1[2], v1[3]);
                    *(u32x4*)(rowp + bj * HALF) = w; } }
    }
};
struct EpiResidual {
    static constexpr bool PERM = false, AFTER_DRAIN = false;
    const float* base; float* out; bf16_t* outb; float* ssq; int ldc;
    __device__ __forceinline__ void operator()(const f32x4 (&acc)[2][2][4][2], const Unit& u, int wr, int wc, int fr, int fq) const {
        const int col0 = u.pn * BM + wc * 32 + 4 * fq;
#pragma unroll
        for (int ai = 0; ai < 2; ++ai)
#pragma unroll
            for (int m = 0; m < 4; ++m) { const int row = u.pm * BM + ai * HALF + wr * 64 + m * 16 + fr; const size_t off = (size_t)row * ldc + col0; float s = 0.f;
#pragma unroll
                for (int bj = 0; bj < 2; ++bj)
#pragma unroll
                    for (int n = 0; n < 2; ++n) { const size_t o = off + bj * HALF + n * 16; const f32x4 h = *(const f32x4*)(base + o) + acc[ai][bj][m][n];
                        u32x2 w; w.x = cvt_pk_bf16(h[0], h[1]); w.y = cvt_pk_bf16(h[2], h[3]); *(u32x2*)(outb + o) = w;
                        s += (h[0] * h[0] + h[1] * h[1]) + (h[2] * h[2] + h[3] * h[3]); }
                s += __shfl_xor(s, 16); s += __shfl_xor(s, 32);
                if (fq == 0) ssq[(size_t)row * 16 + u.pn * 4 + wc] = s; }
    }
};
template <class Epi, class Sched, bool ALIGN_EPI = false, bool SP2 = false>
__device__ __forceinline__ void gemm_phase(PG8_LAS unsigned char* lds, const Gemm g, const Sched& S, const Epi& E) {
    int tid_ = threadIdx.x; asm volatile("" : "+v"(tid_));
    const int tid = tid_, wid = __builtin_amdgcn_readfirstlane(tid >> 6), lane = tid & 63, wr = wid >> 2, wc = wid & 3, fr = lane & 15, fq = lane >> 4;
    const int K = g.K, nt = K / BK;
    unsigned voffA[2], voffB[2];
#pragma unroll
    for (int i = 0; i < 2; ++i) { int R, C; stage_rc(tid * 16 + i * 8192, R, C); const int Rb = Epi::PERM ? ((R & ~31) + perm32(R & 31)) : R;
        voffA[i] = (unsigned)(R * g.lda + C) * 2u; voffB[i] = (unsigned)(Rb * g.ldb + C) * 2u; }
    const size_t kstep = (size_t)(BK * 2);
    const size_t hstepA = (size_t)HALF * g.lda * 2, hstepB = (size_t)HALF * g.ldb * 2;
    const size_t tstepA = 2 * hstepA, tstepB = 2 * hstepB;
    const unsigned ldsw = (unsigned)wid * 1024u;
    const int aoff = lds_byte(wr * 64 + fr, fq * 8), boff = lds_byte(wc * 32 + fr, fq * 8);
#define PG8_SA(b, h) (((b) * 2 + (h)) * HTB)
#define PG8_SB(b, h) ((4 + (b) * 2 + (h)) * HTB)
#define PG8_STAGE(bufoff, gbase, voff) do { _Pragma("unroll") for (int _i = 0; _i < 2; ++_i) \
        __builtin_amdgcn_global_load_lds((const unsigned*)((const char*)(gbase) + (voff)[_i]), (PG8_LAS unsigned*)(lds + (bufoff) + ldsw + _i * 8192), 16, 0, 0); } while (0)
#define PG8_LDA(dst, b, h) do { _Pragma("unroll") for (int m = 0; m < 4; ++m) _Pragma("unroll") for (int k = 0; k < 2; ++k) dst[m][k] = *(const PG8_LAS bf16x8*)(lds + PG8_SA(b, h) + aoff + m * 2048 + k * 1024); } while (0)
#define PG8_LDB(dst, b, h) do { _Pragma("unroll") for (int n = 0; n < 2; ++n) _Pragma("unroll") for (int k = 0; k < 2; ++k) dst[n][k] = *(const PG8_LAS bf16x8*)(lds + PG8_SB(b, h) + boff + n * 2048 + k * 1024); } while (0)
#define PG8_MMA(ai, bj, At, Bt) do { __builtin_amdgcn_s_setprio(1); _Pragma("unroll") for (int m = 0; m < 4; ++m) _Pragma("unroll") for (int n = 0; n < 2; ++n) _Pragma("unroll") for (int k = 0; k < 2; ++k) \
        acc[ai][bj][m][n] = __builtin_amdgcn_mfma_f32_16x16x32_bf16(Bt[n][k], At[m][k], acc[ai][bj][m][n], 0, 0, 0); __builtin_amdgcn_s_setprio(0); } while (0)
#define PG8_WAIT_V(n) asm volatile("s_waitcnt vmcnt(" #n ")" ::: "memory")
#define PG8_WAIT_L(n) asm volatile("s_waitcnt lgkmcnt(" #n ")" ::: "memory")
#define PG8_BAR __builtin_amdgcn_s_barrier()
#define PG8_SCHED __builtin_amdgcn_sched_barrier(0)
    Unit cur, nxt; int ui = 0;
    if (!S.next(0, cur)) return;
    f32x4 acc[2][2][4][2];
#pragma unroll
    for (int a = 0; a < 2; ++a)
#pragma unroll
        for (int b = 0; b < 2; ++b)
#pragma unroll
            for (int m = 0; m < 4; ++m)
#pragma unroll
                for (int n = 0; n < 2; ++n) acc[a][b][m][n] = (f32x4){0.f, 0.f, 0.f, 0.f};
    bf16x8 At[4][2], B0[2][2], B1[2][2];
    const char* cA = (const char*)g.A + (size_t)cur.pm * tstepA; const char* cB = (const char*)g.Bt + (size_t)cur.pn * tstepB;
    S.a_ready(cur);
    if constexpr (SP2) {
        PG8_STAGE(PG8_SB(0, 0), cB, voffB); PG8_STAGE(PG8_SB(0, 1), cB + hstepB, voffB); PG8_STAGE(PG8_SA(0, 0), cA, voffA); PG8_STAGE(PG8_SA(0, 1), cA + hstepA, voffA);
        if (wr == 1) PG8_BAR;
        PG8_WAIT_V(2); PG8_BAR;
        PG8_STAGE(PG8_SB(1, 0), cB + kstep, voffB); PG8_STAGE(PG8_SA(1, 0), cA + kstep, voffA); PG8_STAGE(PG8_SB(1, 1), cB + hstepB + kstep, voffB);
        PG8_WAIT_V(6); PG8_BAR;
    } else {
        PG8_STAGE(PG8_SB(0, 0), cB, voffB); PG8_STAGE(PG8_SA(0, 0), cA, voffA); PG8_STAGE(PG8_SB(0, 1), cB + hstepB, voffB); PG8_STAGE(PG8_SA(0, 1), cA + hstepA, voffA);
        if (wr == 1) PG8_BAR;
        PG8_WAIT_V(4); PG8_BAR;
        PG8_STAGE(PG8_SB(1, 0), cB + kstep, voffB); PG8_STAGE(PG8_SA(1, 0), cA + kstep, voffA); PG8_STAGE(PG8_SB(1, 1), cB + hstepB + kstep, voffB);
        PG8_WAIT_V(6); PG8_BAR;
    }
    for (;;) {
        const bool has_next = S.next(ui + 1, nxt);
        const char* nA = has_next ? (const char*)g.A + (size_t)nxt.pm * tstepA : cA; const char* nB = has_next ? (const char*)g.Bt + (size_t)nxt.pn * tstepB : cB;
        for (int t = 0; t < nt; t += 2) {
            const bool last = (t == nt - 2);
            const char* a1 = cA + (size_t)(t + 1) * kstep;
            const char* a2 = last ? nA : cA + (size_t)(t + 2) * kstep; const char* b2 = last ? nB : cB + (size_t)(t + 2) * kstep;
            const char* a3 = a2 + kstep; const char* b3 = b2 + kstep;
            if (last && has_next) S.a_ready(nxt);
            if constexpr (SP2) {
            PG8_LDB(B0, 0, 0); PG8_LDB(B1, 0, 1); PG8_SCHED; PG8_LDA(At, 0, 0); PG8_STAGE(PG8_SA(1, 1), a1 + hstepA, voffA);
            PG8_WAIT_V(8); PG8_WAIT_L(0); PG8_BAR; PG8_MMA(0, 0, At, B0); PG8_MMA(0, 1, At, B1); PG8_BAR; PG8_SCHED;
            PG8_LDA(At, 0, 1); PG8_STAGE(PG8_SB(0, 0), b2, voffB); PG8_STAGE(PG8_SB(0, 1), b2 + hstepB, voffB); PG8_STAGE(PG8_SA(0, 0), a2, voffA);
            PG8_WAIT_V(8); PG8_WAIT_L(0); PG8_BAR; PG8_MMA(1, 0, At, B0); PG8_MMA(1, 1, At, B1); PG8_BAR; PG8_SCHED;
            PG8_LDB(B0, 1, 0); PG8_LDB(B1, 1, 1); PG8_SCHED; PG8_LDA(At, 1, 0); PG8_STAGE(PG8_SA(0, 1), a2 + hstepA, voffA);
            PG8_WAIT_V(8); PG8_WAIT_L(0); PG8_BAR; PG8_MMA(0, 0, At, B0); PG8_MMA(0, 1, At, B1); PG8_BAR; PG8_SCHED;
            PG8_LDA(At, 1, 1); PG8_STAGE(PG8_SB(1, 0), b3, voffB); PG8_STAGE(PG8_SB(1, 1), b3 + hstepB, voffB); PG8_STAGE(PG8_SA(1, 0), a3, voffA);
            PG8_WAIT_V(8); PG8_WAIT_L(0); PG8_BAR; PG8_MMA(1, 0, At, B0); PG8_MMA(1, 1, At, B1); PG8_BAR; PG8_SCHED;
            } else {
            PG8_LDB(B0, 0, 0); PG8_SCHED; PG8_LDA(At, 0, 0); PG8_STAGE(PG8_SA(1, 1), a1 + hstepA, voffA);
            PG8_WAIT_L(8); PG8_BAR; PG8_WAIT_L(0); PG8_MMA(0, 0, At, B0); PG8_BAR; PG8_SCHED;
            PG8_LDB(B1, 0, 1); PG8_STAGE(PG8_SB(0, 0), b2, voffB);
            PG8_BAR; PG8_WAIT_L(0); PG8_MMA(0, 1, At, B1); PG8_BAR;
            PG8_LDA(At, 0, 1); PG8_STAGE(PG8_SA(0, 0), a2, voffA);
            PG8_BAR; PG8_WAIT_L(0); PG8_MMA(1, 0, At, B0); PG8_BAR; PG8_SCHED;
            PG8_STAGE(PG8_SB(0, 1), b2 + hstepB, voffB);
            PG8_WAIT_V(6); PG8_BAR; PG8_MMA(1, 1, At, B1); PG8_BAR;
            PG8_LDB(B0, 1, 0); PG8_SCHED; PG8_LDA(At, 1, 0); PG8_STAGE(PG8_SA(0, 1), a2 + hstepA, voffA);
            PG8_WAIT_L(8); PG8_BAR; PG8_WAIT_L(0); PG8_MMA(0, 0, At, B0); PG8_BAR; PG8_SCHED;
            PG8_LDB(B1, 1, 1); PG8_STAGE(PG8_SB(1, 0), b3, voffB);
            PG8_BAR; PG8_WAIT_L(0); PG8_MMA(0, 1, At, B1); PG8_BAR;
            PG8_LDA(At, 1, 1); PG8_STAGE(PG8_SA(1, 0), a3, voffA);
            PG8_BAR; PG8_WAIT_L(0); PG8_MMA(1, 0, At, B0); PG8_BAR; PG8_SCHED;
            PG8_STAGE(PG8_SB(1, 1), b3 + hstepB, voffB);
            PG8_WAIT_V(6); PG8_BAR; PG8_MMA(1, 1, At, B1); PG8_BAR;
            }
        }
        if constexpr (ALIGN_EPI) { if (wr == 0) PG8_BAR; }
        if constexpr (!Epi::AFTER_DRAIN) { E(acc, cur, wr, wc, fr, fq); S.done(cur); }
        if (!has_next) break;
#pragma unroll
        for (int a = 0; a < 2; ++a)
#pragma unroll
            for (int b = 0; b < 2; ++b)
#pragma unroll
                for (int m = 0; m < 4; ++m)
#pragma unroll
                    for (int n = 0; n < 2; ++n) acc[a][b][m][n] = (f32x4){0.f, 0.f, 0.f, 0.f};
        cur = nxt; cA = nA; cB = nB; ++ui;
        if constexpr (ALIGN_EPI) { if (wr == 1) PG8_BAR; }
    }
    PG8_WAIT_V(0);
    if constexpr (!ALIGN_EPI) { if (wr == 0) PG8_BAR; }
    PG8_BAR;
    if constexpr (Epi::AFTER_DRAIN) { E.fused(acc, cur, wr, wc, fr, fq, lds, wid, lane); S.done(cur); }
#undef PG8_SA
#undef PG8_SB
#undef PG8_STAGE
#undef PG8_LDA
#undef PG8_LDB
#undef PG8_MMA
#undef PG8_WAIT_V
#undef PG8_WAIT_L
#undef PG8_BAR
#undef PG8_SCHED
}
}
#define PG8_SP2 true
#define PG8_ALIGN true

#define GAS __attribute__((address_space(1)))
#define LAS __attribute__((address_space(3)))
typedef unsigned short bf16;
typedef unsigned v4u __attribute__((ext_vector_type(4)));
typedef unsigned v2u __attribute__((ext_vector_type(2)));
typedef float f32x4 __attribute__((ext_vector_type(4)));
typedef float f32x2 __attribute__((ext_vector_type(2)));
typedef short bf16x8 __attribute__((ext_vector_type(8)));
#define RLX_AGENT __ATOMIC_RELAXED, __HIP_MEMORY_SCOPE_AGENT

constexpr int NWAVES = 8, NTHR = 512;
constexpr int SEQ = 8192, DM = 1024, MROWS = 16384, NMETA = 16;
constexpr int NIN = 3080, NPROJ = 3072;
constexpr int CU_ = 0, CV_ = 512, CO_ = 1024, CQS = 1536, CKS = 2048, CVS = 2560;
constexpr int OU_ = 0, OV_ = 512, OI_ = 1536, OF_ = 1540, OKS = 2056, OVS = 2568;
constexpr float EPS = 1e-6f;
constexpr int NEXP = 16384;

constexpr size_t KiB = 1024, MiB = 1024 * 1024;
constexpr size_t WS_CTL = 0, CTL_ZERO_BYTES = 64 * KiB;
constexpr size_t WS_RSTD1 = 64 * KiB;
constexpr size_t WS_SSQ   = WS_RSTD1 + 64 * KiB;
constexpr size_t WS_GI    = WS_SSQ + 1 * MiB;
constexpr size_t WS_GF    = WS_GI + 256 * KiB;
constexpr size_t WS_BT    = WS_GF + 256 * KiB;
constexpr size_t WS_NU    = WS_BT + 256 * KiB;
constexpr size_t WS_NS    = WS_NU + 512 * KiB;
constexpr size_t WS_AC    = WS_NS + 512 * KiB;
constexpr size_t WS_BC    = WS_AC + 4 * KiB;
constexpr size_t WS_MIN   = WS_BC + 4 * KiB;
constexpr size_t WS_PRM   = WS_MIN + 4 * KiB;
constexpr size_t WS_KM    = WS_PRM + 196 * KiB;
constexpr size_t WS_WQMT  = WS_KM + 32 * KiB;
constexpr size_t WS_WKMT  = WS_WQMT + 128 * KiB;
constexpr size_t WS_SKB   = WS_WKMT + 128 * KiB;
constexpr size_t WS_RSTDM = WS_SKB + 64 * KiB;
constexpr size_t WS_RS2 = WS_RSTDM + 4 * KiB;
constexpr size_t WS_ESC = WS_RS2 + 64 * KiB;
constexpr size_t WS_SMALL_END = WS_ESC + 128 * KiB;
static_assert(WS_SMALL_END <= 4 * MiB, "small region");
constexpr size_t WS_WINT = 4 * MiB, WS_WOUTT = 10 * MiB, WS_WQT = 12 * MiB;
constexpr size_t WS_EU = 16 * MiB, WS_EV = 32 * MiB;
constexpr size_t WS_PR = 80 * MiB;
constexpr size_t WS_QP = WS_PR;
constexpr size_t WS_QK = 176 * MiB;
constexpr size_t WS_XB = WS_QK, WS_H1B = WS_QK;
constexpr size_t WS_U = 208 * MiB;
constexpr size_t WS_PRMP = WS_U, WS_TK = WS_U;
constexpr size_t WS_CB = 240 * MiB;
constexpr size_t WS_END = 256 * MiB;

constexpr int LDS_BYTES = 147456, LDSCTL_OFF = LDS_BYTES - 256;

__device__ __forceinline__ unsigned f2bf(float f) { unsigned u = __builtin_bit_cast(unsigned, f); return (u + 0x7fffu + ((u >> 16) & 1u)) >> 16; }
__device__ __forceinline__ unsigned pk2(float lo, float hi) { return f2bf(lo) | (f2bf(hi) << 16); }
__device__ __forceinline__ unsigned pk_fp8x4(f32x4 v) {
    const float a = fminf(fmaxf(v[0], -448.f), 448.f), b = fminf(fmaxf(v[1], -448.f), 448.f), c = fminf(fmaxf(v[2], -448.f), 448.f), d = fminf(fmaxf(v[3], -448.f), 448.f);
    int r = __builtin_amdgcn_cvt_pk_fp8_f32(a, b, 0, false); r = __builtin_amdgcn_cvt_pk_fp8_f32(c, d, r, true); return (unsigned)r; }
__device__ __forceinline__ unsigned pk_fp4x8(f32x4 a, f32x4 b) {
    unsigned r = 0u; r = __builtin_amdgcn_cvt_scalef32_pk_fp4_f32(r, a[0], a[1], 1.0f, 0); r = __builtin_amdgcn_cvt_scalef32_pk_fp4_f32(r, a[2], a[3], 1.0f, 1);
    r = __builtin_amdgcn_cvt_scalef32_pk_fp4_f32(r, b[0], b[1], 1.0f, 2); r = __builtin_amdgcn_cvt_scalef32_pk_fp4_f32(r, b[2], b[3], 1.0f, 3); return r; }
__device__ __forceinline__ float bf2f(unsigned h) { return __builtin_bit_cast(float, h << 16); }
template <int CTRL> __device__ __forceinline__ float dpp_f(float v) { return __builtin_bit_cast(float, __builtin_amdgcn_update_dpp(0, __builtin_bit_cast(int, v), CTRL, 0xf, 0xf, true)); }
__device__ __forceinline__ float rdl_f(float v, int l) { return __builtin_bit_cast(float, __builtin_amdgcn_readlane(__builtin_bit_cast(int, v), l)); }
__device__ __forceinline__ float wave_sum(float v) {
    v += dpp_f<0xB1>(v); v += dpp_f<0x4E>(v); v += dpp_f<0x124>(v); v += dpp_f<0x128>(v);
    return (rdl_f(v, 0) + rdl_f(v, 16)) + (rdl_f(v, 32) + rdl_f(v, 48));
}
__device__ __forceinline__ float wave_max(float v) {
    v = fmaxf(v, dpp_f<0xB1>(v)); v = fmaxf(v, dpp_f<0x4E>(v)); v = fmaxf(v, dpp_f<0x124>(v)); v = fmaxf(v, dpp_f<0x128>(v));
    return fmaxf(fmaxf(rdl_f(v, 0), rdl_f(v, 16)), fmaxf(rdl_f(v, 32), rdl_f(v, 48)));
}
__device__ __forceinline__ float row16_sum(float v) { v += dpp_f<0xB1>(v); v += dpp_f<0x4E>(v); v += dpp_f<0x124>(v); v += dpp_f<0x128>(v); return v; }
__device__ __forceinline__ float row16_min(float v) { v = fminf(v, dpp_f<0xB1>(v)); v = fminf(v, dpp_f<0x4E>(v)); v = fminf(v, dpp_f<0x124>(v)); v = fminf(v, dpp_f<0x128>(v)); return v; }
template <int CTRL> __device__ __forceinline__ float dpp_shr(float v, float idv) { return __builtin_bit_cast(float, __builtin_amdgcn_update_dpp(__builtin_bit_cast(int, idv), __builtin_bit_cast(int, v), CTRL, 0xf, 0xf, false)); }
__device__ __forceinline__ float wave_scan_sum(float v, int lane) {
    v += dpp_shr<0x111>(v, 0.f); v += dpp_shr<0x112>(v, 0.f); v += dpp_shr<0x114>(v, 0.f); v += dpp_shr<0x118>(v, 0.f);
    const float r0 = rdl_f(v, 15), r1 = rdl_f(v, 31), r2 = rdl_f(v, 47);
    return v + (lane < 16 ? 0.f : lane < 32 ? r0 : lane < 48 ? r0 + r1 : (r0 + r1) + r2);
}
__device__ __forceinline__ float wave_scan_max(float v, int lane) {
    const float NI = -3.0e38f;
    v = fmaxf(v, dpp_shr<0x111>(v, NI)); v = fmaxf(v, dpp_shr<0x112>(v, NI)); v = fmaxf(v, dpp_shr<0x114>(v, NI)); v = fmaxf(v, dpp_shr<0x118>(v, NI));
    const float r0 = rdl_f(v, 15), r1 = rdl_f(v, 31), r2 = rdl_f(v, 47);
    return fmaxf(v, lane < 16 ? NI : lane < 32 ? r0 : lane < 48 ? fmaxf(r0, r1) : fmaxf(fmaxf(r0, r1), r2));
}
__device__ __forceinline__ float logsigmoidf_(float a) { return fminf(a, 0.f) - log1pf(__expf(-fabsf(a))); }
__device__ __forceinline__ float siluf_(float a) { return a / (1.f + __expf(-a)); }
template <int KS> __device__ __forceinline__ f32x4 mma_rows(const LAS bf16* a, const LAS bf16* b, f32x4 acc) {
#pragma unroll
    for (int k = 0; k < KS; ++k) { const bf16x8 av = *(const LAS bf16x8*)(a + 32 * k), bv = *(const LAS bf16x8*)(b + 32 * k); acc = __builtin_amdgcn_mfma_f32_16x16x32_bf16(av, bv, acc, 0, 0, 0); }
    return acc;
}
#define XB_TMO      128
#define XB_XCNT(j)  (256  + 64 * (j))
#define XB_XSUB(j)  (1280 + 64 * (j))
#define XB_XGEN(j)  (2304 + 64 * (j))
#define XB_TOP      3328
#define XB_TOPGEN   3392
#define XCD_BAR_WORDS 3456
#define XB_SPIN_CAP (1u << 18)

__device__ __forceinline__ unsigned xb_ld(unsigned* p)              { return __hip_atomic_load(p, __ATOMIC_RELAXED, __HIP_MEMORY_SCOPE_AGENT); }
__device__ __forceinline__ unsigned xb_add(unsigned* p, unsigned v) { return __hip_atomic_fetch_add(p, v, __ATOMIC_RELAXED, __HIP_MEMORY_SCOPE_AGENT); }
__device__ __forceinline__ unsigned xb_xcc_id() { return (unsigned)__builtin_amdgcn_s_getreg((3 << 11) | 20) & 0xFu; }
#define XB_SPIN(cond, bar) do { unsigned _sp = 0; while (cond) { __builtin_amdgcn_s_sleep(1); \
    if ((++_sp & 255u) == 0u) { if (xb_ld(&(bar)[XB_TMO])) break; if (_sp > XB_SPIN_CAP) { atomicAdd(&(bar)[XB_TMO], 1u); break; } } } } while (0)

struct XcdBarrier {
    unsigned* bar; unsigned x;
    volatile LAS unsigned* st;
};

__device__ __forceinline__ XcdBarrier xcd_barrier_post(unsigned* bar, volatile LAS unsigned* st) {
    XcdBarrier b; b.bar = bar; b.x = xb_xcc_id(); b.st = st;
    if (threadIdx.x == 0) (void)xb_add(&bar[XB_XCNT(b.x)], 1u);
    return b;
}
__device__ __forceinline__ void xcd_barrier_complete(unsigned* bar, unsigned x, unsigned& nloc, unsigned& nx) {
    const unsigned G = gridDim.x * gridDim.y * gridDim.z;
    unsigned sum, cnt, mine, sp = 0u;
    for (;;) {
        sum = 0u; cnt = 0u; mine = 0u;
#pragma unroll
        for (unsigned j = 0; j < 16; ++j) { const unsigned c = xb_ld(&bar[XB_XCNT(j)]); sum += c; cnt += (c > 0u) ? 1u : 0u; mine = (j == x) ? c : mine; }
        if (sum == G) break;
        __builtin_amdgcn_s_sleep(1);
        if ((++sp & 255u) == 0u) { if (xb_ld(&bar[XB_TMO])) break; if (sp > XB_SPIN_CAP) { atomicAdd(&bar[XB_TMO], 1u); break; } }
    }
    nloc = mine > 0u ? mine : 1u; nx = cnt > 0u ? cnt : 1u;
}

__device__ __forceinline__ void xcd_barrier(const XcdBarrier& b) {
    asm volatile("s_waitcnt vmcnt(0)" ::: "memory");
    __syncthreads();
    if (threadIdx.x == 0) {
        unsigned* bar = b.bar;
        __builtin_amdgcn_s_waitcnt(0);
        unsigned nloc = b.st[0], nx = b.st[1];
        if (nloc == 0u) { xcd_barrier_complete(bar, b.x, nloc, nx); b.st[0] = nloc; b.st[1] = nx; }
        const unsigned old = xb_add(&bar[XB_XSUB(b.x)], 1u);
        const unsigned gen = old / nloc;
        if (old + 1u == (gen + 1u) * nloc) {
            __builtin_amdgcn_fence(__ATOMIC_RELEASE, "agent");
            asm volatile("s_waitcnt vmcnt(0)" ::: "memory");
            const unsigned og = xb_add(&bar[XB_TOP], 1u);
            const unsigned tg = og / nx;
            if (og + 1u == (tg + 1u) * nx) xb_add(&bar[XB_TOPGEN], 1u);
            else XB_SPIN(xb_ld(&bar[XB_TOPGEN]) == tg, bar);
            __builtin_amdgcn_fence(__ATOMIC_ACQUIRE, "agent");
            xb_add(&bar[XB_XGEN(b.x)], 1u);
            asm volatile("s_waitcnt vmcnt(0)" ::: "memory");
        } else {
            XB_SPIN(xb_ld(&bar[XB_XGEN(b.x)]) == gen, bar);
            __builtin_amdgcn_fence(__ATOMIC_ACQUIRE, "agent");
            asm volatile("s_waitcnt vmcnt(0)" ::: "memory");
        }
    }
    __syncthreads();
}

struct Params { const float* in[20]; float* out; unsigned char* ws; };
struct Frame {
    LAS unsigned char* lds;
    int tid, lane, wave, vcu, G;
    const float *x, *meta, *g_mix, *w_in, *conv_w, *conv_b, *w_qm, *w_km, *b_i, *b_f, *skip, *gn_g, *sb_g, *w_out, *g_ffn, *w_query, *sub_keys, *eu, *ev, *g_fin;
    float* out; unsigned char* ws;
};
#define WSP(T, off) ((T*)(F.ws + (off)))

__device__ __forceinline__ void p0_transpose_item(const float* W, int ldw, int k0, int srccol0, bf16* WT, int K, int dstrow0, const float* gk, float cs, LAS float* scr, int lane, const float* META, float* PRMP) {
#pragma unroll 8
    for (int i = 0; i < 32; ++i) { const int kk = 2 * i + (lane >> 5); const float sc = gk ? gk[k0 + kk] * cs : cs; scr[kk * 33 + (lane & 31)] = W[(size_t)(k0 + kk) * ldw + srccol0 + (lane & 31)] * sc; }
    if (META) { LAS float* mb = scr + 64 * 33;
#pragma unroll
        for (int i = 0; i < 16; ++i) mb[i * 64 + lane] = META[(size_t)i * DM + k0 + lane]; }
    const int c = lane & 7;
#pragma unroll
    for (int j = 0; j < 4; ++j) { const int n = (lane >> 3) + 8 * j; const LAS float* s = scr + (8 * c) * 33 + n;
        v4u o; o.x = pk2(s[0 * 33], s[1 * 33]); o.y = pk2(s[2 * 33], s[3 * 33]); o.z = pk2(s[4 * 33], s[5 * 33]); o.w = pk2(s[6 * 33], s[7 * 33]);
        *(v4u*)(WT + (size_t)(dstrow0 + n) * K + k0 + 8 * c) = o; }
    if (META) { const LAS float* mb = scr + 64 * 33; const int n = lane & 31, r0 = (lane >> 5) * 8; float acc[8];
#pragma unroll
        for (int r = 0; r < 8; ++r) acc[r] = 0.f;
#pragma unroll 4
        for (int kk = 0; kk < 64; kk += 4) { const float w0 = scr[kk * 33 + n], w1 = scr[(kk + 1) * 33 + n], w2 = scr[(kk + 2) * 33 + n], w3 = scr[(kk + 3) * 33 + n];
#pragma unroll
            for (int r = 0; r < 8; ++r) { const f32x4 m = *(const LAS f32x4*)(mb + (r0 + r) * 64 + kk); acc[r] += (m[0] * w0 + m[1] * w1) + (m[2] * w2 + m[3] * w3); } }
#pragma unroll
        for (int r = 0; r < 8; ++r) PRMP[((size_t)(k0 >> 6) * 16 + r0 + r) * NIN + srccol0 + n] = acc[r]; }
}

__device__ __forceinline__ void p0_pack_row_i4(Frame& F, f32x4 (&a)[4], const f32x4 (&gf)[4], int r, int lane) {
    const bool isu = r < NEXP; float ss = 0.f;
#pragma unroll
    for (int j = 0; j < 4; ++j) { if (isu) a[j] = a[j] * gf[j]; ss += (a[j][0] * a[j][0] + a[j][1] * a[j][1]) + (a[j][2] * a[j][2] + a[j][3] * a[j][3]); }
    ss = wave_sum(ss);
    const float rms = sqrtf(ss * (1.0f / DM)); const float step = rms > 0.f ? 0.3125f * rms : 1.0f, inv = 1.0f / step;
    v2u o;
#pragma unroll
    for (int d = 0; d < 2; ++d) { unsigned w = 0u;
#pragma unroll
        for (int n = 0; n < 8; ++n) { const int i = 8 * d + n; const float q = floorf(a[i >> 2][i & 3] * inv); const int k = (int)fminf(fmaxf(q, -8.f), 7.f); w |= ((unsigned)k & 0xfu) << (4 * n); }
        o[d] = w; }
    *((v2u*)(F.ws + (isu ? WS_EU : WS_EV) + (size_t)(r & (NEXP - 1)) * (DM / 2)) + lane) = o;
    if (lane == 0) WSP(float, WS_ESC)[r] = step;
}

__device__ __forceinline__ void p0_prologue(Frame& F) {
    LAS float* scr = (LAS float*)(F.lds + 32768 + F.wave * 14336);
    LAS float* wg = (LAS float*)F.lds;
    const int gw = F.vcu * NWAVES + F.wave, NGW = F.G * NWAVES, lane = F.lane;
    for (int i = F.tid; i < 8192; i += NTHR) { const int jj = i >> 10, k = i & 1023; wg[i] = F.w_in[(size_t)k * NIN + OI_ + jj] * F.g_mix[k]; }
    {
        constexpr int I_IN = 16 * 96, I_OUT = 16 * 32, I_Q = 16 * 64, I_M = 2 * 4;
        constexpr int NITEMS = I_IN + I_OUT + I_Q + 8 * I_M;
        for (int it = gw; it < NITEMS; it += NGW) {
            int r = it;
            if (r < I_IN) { const int kb = r / 96, nb = r % 96; const int n0 = 32 * nb; p0_transpose_item(F.w_in, NIN, 64 * kb, n0 + (n0 >= 1536 ? 8 : 0), WSP(bf16, WS_WINT), DM, n0, F.g_mix, 1.f, scr, lane, F.meta, WSP(float, WS_PRMP)); continue; } r -= I_IN;
            if (r < I_OUT) { const int kb = r / 32, nb = r % 32; p0_transpose_item(F.w_out, DM, 64 * kb, 32 * nb, WSP(bf16, WS_WOUTT), DM, 32 * nb, nullptr, 1.f, scr, lane, nullptr, nullptr); continue; } r -= I_OUT;
            if (r < I_Q) { const int kb = r / 64, nb = r % 64; p0_transpose_item(F.w_query, 2048, 64 * kb, 32 * nb, WSP(bf16, WS_WQT), DM, 32 * nb, F.g_ffn, 1.f, scr, lane, nullptr, nullptr); continue; } r -= I_Q;
            { const int mat = r / I_M, q = r % I_M, kb = q / 4, nb = q % 4, h = mat & 3;
              const float* W = (mat < 4 ? F.w_qm : F.w_km) + (size_t)h * 16384; bf16* WT = WSP(bf16, mat < 4 ? WS_WQMT : WS_WKMT) + (size_t)h * 16384;
              p0_transpose_item(W, 128, 64 * kb, 32 * nb, WT, 128, 32 * nb, nullptr, mat < 4 ? 1.f : 0.08838834764831845f, scr, lane, nullptr, nullptr); }
        }
        for (int i = gw * 64 + lane; i < 32768 / 4; i += NGW * 64) { const f32x4 v = ((const f32x4*)F.sub_keys)[i]; v2u o; o.x = pk2(v[0], v[1]); o.y = pk2(v[2], v[3]); ((v2u*)WSP(bf16, WS_SKB))[i] = o; }
    }
    __syncthreads();
    {
        float bi[4], bfv[4];
#pragma unroll
        for (int j = 0; j < 4; ++j) { bi[j] = F.b_i[j]; bfv[j] = F.b_f[j]; }
        f32x4 v[4], vn[4];
        { const f32x4* xr = (const f32x4*)(F.x + (size_t)gw * DM) + lane;
#pragma unroll
          for (int j = 0; j < 4; ++j) v[j] = xr[64 * j]; }
        for (int m = gw; m < MROWS + NMETA; m += NGW) {
            const int mn = m + NGW;
            if (mn < MROWS + NMETA) { const f32x4* xr = (const f32x4*)(mn < MROWS ? F.x + (size_t)mn * DM : F.meta + (size_t)(mn - MROWS) * DM) + lane;
#pragma unroll
                for (int j = 0; j < 4; ++j) vn[j] = xr[64 * j]; }
            float ss = 0.f; float g8[8];
#pragma unroll
            for (int jj = 0; jj < 8; ++jj) g8[jj] = 0.f;
#pragma unroll
            for (int j = 0; j < 4; ++j) ss += (v[j][0] * v[j][0] + v[j][1] * v[j][1]) + (v[j][2] * v[j][2] + v[j][3] * v[j][3]);
#pragma unroll
            for (int j = 0; j < 4; ++j)
#pragma unroll
                for (int jj = 0; jj < 8; ++jj) { const f32x4 w = *(const LAS f32x4*)(wg + jj * 1024 + 256 * j + 4 * lane); g8[jj] += (v[j][0] * w[0] + v[j][1] * w[1]) + (v[j][2] * w[2] + v[j][3] * w[3]); }
            ss = wave_sum(ss);
#pragma unroll
            for (int jj = 0; jj < 8; ++jj) g8[jj] = wave_sum(g8[jj]);
            const float rstd = 1.0f / sqrtf(ss * (1.0f / DM) + EPS);
            if (m < MROWS) {
                v2u* o8 = (v2u*)(WSP(bf16, WS_XB) + (size_t)m * DM) + lane;
#pragma unroll
                for (int j = 0; j < 4; ++j) { v2u o; o.x = pk2(v[j][0], v[j][1]); o.y = pk2(v[j][2], v[j][3]); o8[64 * j] = o; }
                if (lane == 0) WSP(float, WS_RSTD1)[m] = rstd;
#pragma unroll
                for (int jj = 0; jj < 4; ++jj) if (lane == jj) { WSP(float, WS_GI)[m * 4 + jj] = g8[jj] * rstd + bi[jj]; WSP(float, WS_GF)[m * 4 + jj] = logsigmoidf_(g8[4 + jj] * rstd + bfv[jj]); }
            } else {
                const int r = m - MROWS;
                if (lane == 0) WSP(float, WS_RSTDM)[r] = rstd;
#pragma unroll
                for (int jj = 0; jj < 8; ++jj) if (lane == jj) WSP(float, WS_PRM)[(size_t)r * NIN + OI_ + jj] = g8[jj] * rstd;
            }
#pragma unroll
            for (int j = 0; j < 4; ++j) v[j] = vn[j];
        }
    }
    {
        f32x4 gf[4];
#pragma unroll
        for (int j = 0; j < 4; ++j) gf[j] = ((const f32x4*)F.g_ffn)[lane + 64 * j];
        for (int r = gw; r < 2 * NEXP; r += 2 * NGW) {
            const int r2 = r + NGW; const bool has2 = r2 < 2 * NEXP;
            const f32x4* s1 = (const f32x4*)((r >= NEXP ? F.ev : F.eu) + (size_t)(r & (NEXP - 1)) * DM) + lane;
            const f32x4* s2 = (const f32x4*)((r2 >= NEXP ? F.ev : F.eu) + (size_t)(r2 & (NEXP - 1)) * DM) + lane;
            f32x4 a[4], b[4];
#pragma unroll
            for (int j = 0; j < 4; ++j) { a[j] = s1[64 * j]; if (has2) b[j] = s2[64 * j]; }
            if (r < NEXP) p0_pack_row_i4(F, a, gf, r, lane);
            else { v2u o; o[0] = pk_fp4x8(a[0] * 4.0f, a[1] * 4.0f); o[1] = pk_fp4x8(a[2] * 4.0f, a[3] * 4.0f); *((v2u*)(F.ws + WS_EV + (size_t)(r - NEXP) * (DM / 2)) + lane) = o; }
            if (has2) { if (r2 < NEXP) p0_pack_row_i4(F, b, gf, r2, lane);
                else { v2u o; o[0] = pk_fp4x8(b[0] * 4.0f, b[1] * 4.0f); o[1] = pk_fp4x8(b[2] * 4.0f, b[3] * 4.0f); *((v2u*)(F.ws + WS_EV + (size_t)(r2 - NEXP) * (DM / 2)) + lane) = o; } }
        }
    }
}

__device__ __forceinline__ void p1_meta_tail(Frame& F) {
    const float* P = WSP(float, WS_PRMP); int tid_ = F.tid; asm volatile("" : "+v"(tid_)); const int tid = tid_;
    const int nrounds = (96 + F.G - 1) / F.G;
    for (int rnd = 0; rnd < nrounds; ++rnd) { const int item = F.vcu + rnd * F.G; if (item >= 96) break;
        if (item < 64) {
            const int h = item >> 4, t = item & 15;
            LAS float* um = (LAS float*)F.lds; LAS float* cm = um + 512; LAS float* part = cm + 128;
            __syncthreads();
            { const int j = tid >> 7, ch = tid & 127, tt = t - 3 + j; float s = 0.f;
              if (tt >= 0) {
#pragma unroll 4
                  for (int kp = 0; kp < 16; ++kp) s += P[(size_t)(kp * 16 + tt) * NIN + OU_ + h * 128 + ch];
                  s *= WSP(float, WS_RSTDM)[tt]; }
              um[j * 128 + ch] = s; }
            __syncthreads();
            if (tid < 128) { const int c = h * 128 + tid; float s = F.conv_b[c];
#pragma unroll
                for (int j = 0; j < 4; ++j) { if (t - 3 + j >= 0) s += F.conv_w[j * 512 + c] * um[j * 128 + tid]; }
                cm[tid] = siluf_(s); }
            __syncthreads();
            { const int e = tid & 127, dp = tid >> 7; float s = 0.f;
#pragma unroll 4
              for (int d = 32 * dp; d < 32 * dp + 32; ++d) s += cm[d] * F.w_km[(size_t)h * 16384 + d * 128 + e];
              part[dp * 128 + e] = s; }
            __syncthreads();
            if (tid < 128) WSP(float, WS_KM)[(h * 16 + t) * 128 + tid] = ((part[tid] + part[128 + tid]) + (part[256 + tid] + part[384 + tid])) * 0.08838834764831845f;
        } else {
            const int part = item - 64, per = 16 * NIN / 32;
            for (int i = part * per + tid; i < (part + 1) * per; i += NTHR) { const int r = i / NIN, n = i - r * NIN; if (n >= OI_ && n < OI_ + 8) continue; float s = 0.f;
#pragma unroll 4
                for (int kp = 0; kp < 16; ++kp) s += P[(size_t)kp * 16 * NIN + i];
                WSP(float, WS_PRM)[i] = s * WSP(float, WS_RSTDM)[r]; }
        }
    }
    __syncthreads();
}

constexpr int L2_WQ = 0, L2_WK = 34816, L2_C = 69632, L2_KT = 87040, L2_WV = 105472, L2_U = 123904, L2_TAB = 141056;
__device__ __forceinline__ void p2_mlstm_local(Frame& F) {
    const int bh = F.vcu >> 5, b = bh >> 2, h = bh & 3, tid = F.tid, lane = F.lane, wave = F.wave, g = lane >> 4, l15 = lane & 15;
    LAS bf16* WQ = (LAS bf16*)(F.lds + L2_WQ); LAS bf16* WK = (LAS bf16*)(F.lds + L2_WK); LAS bf16* Cs = (LAS bf16*)(F.lds + L2_C);
    LAS bf16* KT = (LAS bf16*)(F.lds + L2_KT); LAS bf16* WV = (LAS bf16*)(F.lds + L2_WV); LAS bf16* Us = (LAS bf16*)(F.lds + L2_U);
    LAS float* TAB = (LAS float*)(F.lds + L2_TAB);
    const bf16* PR = WSP(bf16, WS_PR); const float* PRM = WSP(float, WS_PRM);
    for (int i = tid; i < 2048; i += NTHR) { const int e = i >> 4, c8 = (i & 15) * 8;
        *(LAS v4u*)(WQ + e * 136 + c8) = *(const v4u*)(WSP(bf16, WS_WQMT) + (size_t)h * 16384 + e * 128 + c8);
        *(LAS v4u*)(WK + e * 136 + c8) = *(const v4u*)(WSP(bf16, WS_WKMT) + (size_t)h * 16384 + e * 128 + c8); }
    v4u ur[3], vr[2]; float gli = 0.f, glf = 0.f;
#define P2_FETCH_U(chunkx) do { const int _m0 = b * SEQ + (chunkx) * 64; _Pragma("unroll") for (int _k = 0; _k < 3; ++_k) { const int _i = tid + NTHR * _k; if (_i < 67 * 16) { const int _rr = _i >> 4, _c8 = (_i & 15) * 8, _t = _rr - 3; \
            if ((chunkx) == 0 && _t < 0) { const float* _s = PRM + (size_t)(NMETA + _t) * NIN + OU_ + h * 128 + _c8; ur[_k].x = pk2(_s[0], _s[1]); ur[_k].y = pk2(_s[2], _s[3]); ur[_k].z = pk2(_s[4], _s[5]); ur[_k].w = pk2(_s[6], _s[7]); } \
            else ur[_k] = *(const v4u*)(PR + (size_t)(_m0 + _t) * NPROJ + CU_ + h * 128 + _c8); } } \
        if (tid < 64) { gli = WSP(float, WS_GI)[(_m0 + tid) * 4 + h]; glf = WSP(float, WS_GF)[(_m0 + tid) * 4 + h]; } } while (0)
#define P2_FETCH_V(chunkx) do { const int _m0 = b * SEQ + (chunkx) * 64; _Pragma("unroll") for (int _k = 0; _k < 2; ++_k) { const int _i = tid + NTHR * _k; vr[_k] = *(const v4u*)(PR + (size_t)(_m0 + (_i >> 4)) * NPROJ + CV_ + h * 128 + (_i & 15) * 8); } } while (0)
    P2_FETCH_U(F.vcu & 31); P2_FETCH_V(F.vcu & 31);
    for (int ui = 0; ui < 4; ++ui) {
        const int chunk = (F.vcu & 31) + 32 * ui; const int m0 = b * SEQ + chunk * 64;
        __syncthreads();
#pragma unroll
        for (int k = 0; k < 3; ++k) { const int i = tid + NTHR * k; if (i < 67 * 16) *(LAS v4u*)(Us + (i >> 4) * 128 + (i & 15) * 8) = ur[k]; }
        if (tid < 64) { TAB[tid] = gli; TAB[64 + tid] = glf; }
        if (ui + 1 < 4) P2_FETCH_U(chunk + 32);
        __syncthreads();
        { const int ch = tid & 127, c = h * 128 + ch; const float w0 = F.conv_w[c], w1 = F.conv_w[512 + c], w2 = F.conv_w[1024 + c], w3 = F.conv_w[1536 + c], cb = F.conv_b[c];
#pragma unroll 4
          for (int jj = 0; jj < 16; ++jj) { const int t = (tid >> 7) + 4 * jj;
              const float s = cb + w0 * bf2f(Us[t * 128 + ch]) + w1 * bf2f(Us[(t + 1) * 128 + ch]) + w2 * bf2f(Us[(t + 2) * 128 + ch]) + w3 * bf2f(Us[(t + 3) * 128 + ch]);
              const unsigned cv = f2bf(siluf_(s)); Cs[t * 136 + ch] = (bf16)cv; } }
        if (wave == 0) {
            const float li = TAB[lane], lf = TAB[64 + lane]; float bs = lf;
            bs = wave_scan_sum(bs, lane);
            const float bL = rdl_f(bs, 63); const float gg = bL - bs + li; const float Bc = wave_max(gg);
            TAB[128 + lane] = bs; TAB[192 + lane] = __expf(gg - Bc);
            WSP(float, WS_BT)[(m0 + lane) * 4 + h] = bs;
            if (lane == 0) { WSP(float, WS_AC)[bh * 128 + chunk] = bL; WSP(float, WS_BC)[bh * 128 + chunk] = Bc; }
        }
        __syncthreads();
        {
            bf16* Qg = WSP(bf16, WS_QK); bf16* Kg = Qg + (size_t)MROWS * 512;
#pragma unroll
            for (int tt = 0; tt < 4; ++tt) {
                f32x4 aq = {0.f, 0.f, 0.f, 0.f}, ak = {0.f, 0.f, 0.f, 0.f};
                aq = mma_rows<4>(WQ + (16 * wave + l15) * 136 + 8 * g, Cs + (16 * tt + l15) * 136 + 8 * g, aq);
                ak = mma_rows<4>(WK + (16 * wave + l15) * 136 + 8 * g, Cs + (16 * tt + l15) * 136 + 8 * g, ak);
                const int t = 16 * tt + l15, e0 = 16 * wave + 4 * g; const size_t go = (size_t)(m0 + t) * 512 + h * 128 + e0;
                v2u oq; oq.x = pk2(aq[0], aq[1]); oq.y = pk2(aq[2], aq[3]); *(v2u*)(Qg + go) = oq;
                v2u ok; ok.x = pk2(ak[0], ak[1]); ok.y = pk2(ak[2], ak[3]); *(v2u*)(Kg + go) = ok;
                KT[(e0 + 0) * 72 + t] = (bf16)(ok.x & 0xffffu); KT[(e0 + 1) * 72 + t] = (bf16)(ok.x >> 16); KT[(e0 + 2) * 72 + t] = (bf16)(ok.y & 0xffffu); KT[(e0 + 3) * 72 + t] = (bf16)(ok.y >> 16);
            }
            for (int i = tid; i < 1024; i += NTHR) { const int t = i >> 4, c8 = (i & 15) * 8; *(v4u*)(WSP(bf16, WS_CB) + (size_t)(m0 + t) * 512 + h * 128 + c8) = *(const LAS v4u*)(Cs + t * 136 + c8); }
#pragma unroll
            for (int k = 0; k < 2; ++k) { const int i = tid + NTHR * k; const int s = i >> 4, e8 = (i & 15) * 8; const v4u pv = vr[k]; const float w = TAB[192 + s];
#pragma unroll
                for (int q = 0; q < 4; ++q) { WV[(e8 + 2 * q) * 72 + s] = (bf16)f2bf(bf2f(pv[q] & 0xffffu) * w); WV[(e8 + 2 * q + 1) * 72 + s] = (bf16)f2bf(__uint_as_float(pv[q] & 0xffff0000u) * w); } }
            if (ui + 1 < 4) P2_FETCH_V(chunk + 32);
        }
        __syncthreads();
        {
            bf16* Ug = WSP(bf16, WS_U) + (size_t)(bh * 128 + chunk) * 16384;
#pragma unroll
            for (int et = 0; et < 8; ++et) { f32x4 a = {0.f, 0.f, 0.f, 0.f};
                a = mma_rows<2>(KT + (16 * wave + l15) * 72 + 8 * g, WV + (16 * et + l15) * 72 + 8 * g, a);
                v2u o; o.x = pk2(a[0], a[1]); o.y = pk2(a[2], a[3]); *(v2u*)(Ug + (size_t)(16 * et + l15) * 128 + 16 * wave + 4 * g) = o; }
            if (tid < 128) { float s = 0.f; for (int t = 0; t < 64; ++t) s += bf2f(KT[tid * 72 + t]) * TAB[192 + t]; WSP(float, WS_NU)[(size_t)(bh * 128 + chunk) * 128 + tid] = s; }
        }
    }
#undef P2_FETCH_U
#undef P2_FETCH_V
    __syncthreads();
}

constexpr int L3_K = 0, L3_VT = 9216, L3_MIN = 18432;
__device__ __forceinline__ void p2_sb_attention(Frame& F) {
    const int tid = F.tid, lane = F.lane, wave = F.wave, g = lane >> 4, l15 = lane & 15;
    LAS bf16* Ks = (LAS bf16*)(F.lds + L3_K); LAS bf16* VT = (LAS bf16*)(F.lds + L3_VT); LAS float* MINR = (LAS float*)(F.lds + L3_MIN);
    bf16* PR = WSP(bf16, WS_PR); const float* PRM = WSP(float, WS_PRM);
    const int bhd = F.vcu >> 4, b = bhd >> 3, hd = bhd & 7;
    for (int ui = 0; ui < 4; ++ui) {
        const int qb = (F.vcu & 15) + 16 * ui;
        const int tq = 128 * qb + 16 * wave + l15;
        const size_t qrow = (size_t)(b * SEQ + tq) * NPROJ;
        const bf16x8 q0 = *(const bf16x8*)(PR + qrow + CQS + hd * 64 + 8 * g), q1 = *(const bf16x8*)(PR + qrow + CQS + hd * 64 + 32 + 8 * g);
        f32x4 o[4];
#pragma unroll
        for (int i = 0; i < 4; ++i) o[i] = (f32x4){0.f, 0.f, 0.f, 0.f};
        float R = 0.f;
        const int kr = tid >> 3, c8 = (tid & 7) * 8;
        v4u kn, vn;
#define SB_FETCH(jbx) do { if ((jbx) >= 0) { const size_t _ro = (size_t)(b * SEQ + 64 * (jbx) + kr) * NPROJ + hd * 64 + c8; kn = *(const v4u*)(PR + _ro + CKS); vn = *(const v4u*)(PR + _ro + CVS); } \
            else if (kr < NMETA) { const float* _sk = PRM + (size_t)kr * NIN + OKS + hd * 64 + c8; const float* _sv = PRM + (size_t)kr * NIN + OVS + hd * 64 + c8; \
                kn.x = pk2(_sk[0], _sk[1]); kn.y = pk2(_sk[2], _sk[3]); kn.z = pk2(_sk[4], _sk[5]); kn.w = pk2(_sk[6], _sk[7]); vn.x = pk2(_sv[0], _sv[1]); vn.y = pk2(_sv[2], _sv[3]); vn.z = pk2(_sv[4], _sv[5]); vn.w = pk2(_sv[6], _sv[7]); } \
            else { kn = (v4u){0u, 0u, 0u, 0u}; vn = kn; } } while (0)
        SB_FETCH(2 * qb + 1);
        for (int jb = 2 * qb + 1; jb >= -1; --jb) {
            __syncthreads();
            if (jb < 2 * qb + 1) { float mn = MINR[0];
#pragma unroll
                for (int w = 1; w < 8; ++w) mn = fminf(mn, MINR[w]);
                if (mn >= 90.f) break; }
            { const v4u kv = kn, vv = vn;
              *(LAS v4u*)(Ks + kr * 72 + c8) = kv;
              VT[(c8 + 0) * 72 + kr] = (bf16)(vv.x & 0xffffu); VT[(c8 + 1) * 72 + kr] = (bf16)(vv.x >> 16); VT[(c8 + 2) * 72 + kr] = (bf16)(vv.y & 0xffffu); VT[(c8 + 3) * 72 + kr] = (bf16)(vv.y >> 16);
              VT[(c8 + 4) * 72 + kr] = (bf16)(vv.z & 0xffffu); VT[(c8 + 5) * 72 + kr] = (bf16)(vv.z >> 16); VT[(c8 + 6) * 72 + kr] = (bf16)(vv.w & 0xffffu); VT[(c8 + 7) * 72 + kr] = (bf16)(vv.w >> 16); }
            if (jb > -1) SB_FETCH(jb - 1);
            __syncthreads();
            if (jb == 2 * qb + 1 && wave < 4) { if (lane == 0) MINR[wave] = 0.f; continue; }
            float z[16];
#pragma unroll
            for (int i = 0; i < 4; ++i) { const LAS bf16* kp = Ks + (16 * (l15 >> 2) + 4 * i + (l15 & 3)) * 72 + 8 * g;
                f32x4 a = {0.f, 0.f, 0.f, 0.f};
                a = __builtin_amdgcn_mfma_f32_16x16x32_bf16(*(const LAS bf16x8*)kp, q0, a, 0, 0, 0);
                a = __builtin_amdgcn_mfma_f32_16x16x32_bf16(*(const LAS bf16x8*)(kp + 32), q1, a, 0, 0, 0);
                z[4 * i + 0] = a[0] * 0.125f; z[4 * i + 1] = a[1] * 0.125f; z[4 * i + 2] = a[2] * 0.125f; z[4 * i + 3] = a[3] * 0.125f; }
            const int kbase = (jb >= 0) ? 64 * jb + 16 * g : 16 * g;
            float cum[16]; float run = 0.f;
#pragma unroll
            for (int n = 15; n >= 0; --n) { const bool ok = (jb >= 0) ? (kbase + n < tq) : (kbase + n < NMETA);
                const float zz = z[n]; const float sp = fmaxf(zz, 0.f) + __logf(1.f + __expf(-fabsf(zz)));
                run += ok ? sp : 0.f; cum[n] = run; }
            const float t1 = __shfl(run, (lane + 16) & 63), t2 = __shfl(run, (lane + 32) & 63), t3 = __shfl(run, (lane + 48) & 63);
            const float higher = (g < 3 ? t1 : 0.f) + (g < 2 ? t2 : 0.f) + (g < 1 ? t3 : 0.f);
            const float lower = (g >= 1 ? t3 : 0.f) + (g >= 2 ? t2 : 0.f) + (g >= 3 ? t1 : 0.f);
            const float base = R + higher;
            float av[16];
#pragma unroll
            for (int n = 0; n < 16; ++n) { const bool ok = (jb >= 0) ? (kbase + n < tq) : (kbase + n < NMETA); av[n] = ok ? __expf(z[n] - (base + cum[n])) : 0.f; }
            R += run + higher + lower;
#pragma unroll
            for (int ks = 0; ks < 2; ++ks) { v4u bw; bw.x = pk2(av[8 * ks + 0], av[8 * ks + 1]); bw.y = pk2(av[8 * ks + 2], av[8 * ks + 3]); bw.z = pk2(av[8 * ks + 4], av[8 * ks + 5]); bw.w = pk2(av[8 * ks + 6], av[8 * ks + 7]);
                const bf16x8 bfr = __builtin_bit_cast(bf16x8, bw);
#pragma unroll
                for (int et = 0; et < 4; ++et) { const bf16x8 afr = *(const LAS bf16x8*)(VT + (16 * et + l15) * 72 + 16 * g + 8 * ks); o[et] = __builtin_amdgcn_mfma_f32_16x16x32_bf16(afr, bfr, o[et], 0, 0, 0); } }
            const float rm = row16_min(R);
            if (lane == 0) MINR[wave] = rm;
        }
        float ss = 0.f;
#pragma unroll
        for (int et = 0; et < 4; ++et) ss += (o[et][0] * o[et][0] + o[et][1] * o[et][1]) + (o[et][2] * o[et][2] + o[et][3] * o[et][3]);
        ss += __shfl_xor(ss, 16); ss += __shfl_xor(ss, 32);
        const float rstd = 1.0f / sqrtf(ss * (1.0f / 64.0f) + EPS);
#pragma unroll
        for (int et = 0; et < 4; ++et) { const int e = 16 * et + 4 * g; const f32x4 gg = *(const f32x4*)(F.sb_g + hd * 64 + e);
            v2u w; w.x = pk2(o[et][0] * rstd * gg[0], o[et][1] * rstd * gg[1]); w.y = pk2(o[et][2] * rstd * gg[2], o[et][3] * rstd * gg[3]);
            *(v2u*)(PR + qrow + CQS + hd * 64 + e) = w; }
    }
#undef SB_FETCH
    __syncthreads();
}

__device__ __forceinline__ void p3_scan(Frame& F) {
    const int bh = F.vcu >> 5, h = bh & 3, tid = F.tid, lane = F.lane;
    LAS float* DEC = (LAS float*)F.lds; LAS float* SCL = DEC + 128; LAS float* WM = DEC + 256;
    const float* PRM = WSP(float, WS_PRM);
    __syncthreads();
    if (F.wave == 0) {
        float li = -INFINITY, lf = 0.f;
        if (lane < NMETA) { li = PRM[(size_t)lane * NIN + OI_ + h] + F.b_i[h]; lf = logsigmoidf_(PRM[(size_t)lane * NIN + OF_ + h] + F.b_f[h]); }
        float bs = lf;
        bs = wave_scan_sum(bs, lane);
        const float bL = rdl_f(bs, 63); const float gg = bL - bs + li; float M = fmaxf(bL, wave_max(gg));
        if (lane < NMETA) WM[lane] = __expf(gg - M);
        const float* AC = WSP(float, WS_AC) + bh * 128; const float* BC = WSP(float, WS_BC) + bh * 128;
        for (int c = 0; c < 128; ++c) { const float a = AC[c], bc = BC[c]; const float Mn = fmaxf(M + a, bc);
            if (lane == 0) { DEC[c] = __expf(a + M - Mn); SCL[c] = __expf(bc - Mn); if ((F.vcu & 31) == 0) WSP(float, WS_MIN)[bh * 128 + c] = M; }
            M = Mn; }
    }
    __syncthreads();
    const int elem = (F.vcu & 31) * 512 + tid, e = elem >> 7, d = elem & 127;
    const float* KM = WSP(float, WS_KM) + (size_t)h * 16 * 128;
    float C = 0.f;
#pragma unroll
    for (int s = 0; s < NMETA; ++s) C += WM[s] * PRM[(size_t)s * NIN + OV_ + h * 128 + e] * KM[s * 128 + d];
    bf16* U = WSP(bf16, WS_U) + (size_t)bh * 128 * 16384 + elem;
    for (int c0 = 0; c0 < 128; c0 += 16) {
        unsigned short u[16];
#pragma unroll
        for (int j = 0; j < 16; ++j) u[j] = U[(size_t)(c0 + j) * 16384];
#pragma unroll
        for (int j = 0; j < 16; ++j) { U[(size_t)(c0 + j) * 16384] = (bf16)f2bf(C); C = DEC[c0 + j] * C + SCL[c0 + j] * bf2f(u[j]); }
    }
    if ((F.vcu & 31) == 0 && tid < 128) {
        float n = 0.f;
#pragma unroll
        for (int s = 0; s < NMETA; ++s) n += WM[s] * KM[s * 128 + tid];
        const float* NU = WSP(float, WS_NU) + (size_t)bh * 128 * 128 + tid; float* NS = WSP(float, WS_NS) + (size_t)bh * 128 * 128 + tid;
        for (int c = 0; c < 128; ++c) { NS[c * 128] = n; n = DEC[c] * n + SCL[c] * NU[c * 128]; }
    }
    __syncthreads();
}

constexpr int L4_Q = 0, L4_K = 17408, L4_VT = 34816, L4_CS = 53248, L4_S = 88064, L4_TAB = 97280;
__device__ __forceinline__ void p4_mlstm_out(Frame& F) {
    const int bh = F.vcu >> 5, b = bh >> 2, h = bh & 3, tid = F.tid, lane = F.lane, wave = F.wave, g = lane >> 4, l15 = lane & 15;
    LAS bf16* Qs = (LAS bf16*)(F.lds + L4_Q); LAS bf16* Ks = (LAS bf16*)(F.lds + L4_K); LAS bf16* VT = (LAS bf16*)(F.lds + L4_VT);
    LAS bf16* CS = (LAS bf16*)(F.lds + L4_CS); LAS bf16* Ss = (LAS bf16*)(F.lds + L4_S); LAS float* T = (LAS float*)(F.lds + L4_TAB);
    bf16* PR = WSP(bf16, WS_PR);
    const bf16* Qg = WSP(bf16, WS_QK); const bf16* Kg = Qg + (size_t)MROWS * 512;
    v4u rq[2], rk[2], rc[4], rv[2]; float rT0 = 0.f, rT1 = 0.f, rNS = 0.f, rMin;
#define P4_FETCH(UI) do { const int _chunk = (F.vcu & 31) + 32 * (UI); const int _m0 = b * SEQ + _chunk * 64; const int _uc = bh * 128 + _chunk; \
        _Pragma("unroll") for (int _k = 0; _k < 2; ++_k) { const int _i = tid + NTHR * _k; const int _t = _i >> 4, _c8 = (_i & 15) * 8; const size_t _go = (size_t)(_m0 + _t) * 512 + h * 128 + _c8; rq[_k] = *(const v4u*)(Qg + _go); rk[_k] = *(const v4u*)(Kg + _go); \
            rv[_k] = *(const v4u*)(PR + (size_t)(_m0 + _t) * NPROJ + CV_ + h * 128 + _c8); } \
        _Pragma("unroll") for (int _k = 0; _k < 4; ++_k) { const int _i = tid + NTHR * _k; const int _e = _i >> 4, _c8 = (_i & 15) * 8; rc[_k] = *(const v4u*)(WSP(bf16, WS_U) + (size_t)_uc * 16384 + _e * 128 + _c8); } \
        if (tid < 64) { rT0 = WSP(float, WS_BT)[(_m0 + tid) * 4 + h]; rT1 = WSP(float, WS_GI)[(_m0 + tid) * 4 + h]; } \
        if (tid >= 128 && tid < 256) rNS = WSP(float, WS_NS)[(size_t)_uc * 128 + tid - 128]; \
        rMin = WSP(float, WS_MIN)[_uc]; } while (0)
    P4_FETCH(0);
    for (int ui = 0; ui < 4; ++ui) {
        const int chunk = (F.vcu & 31) + 32 * ui; const int m0 = b * SEQ + chunk * 64;
        __syncthreads();
#pragma unroll
        for (int k = 0; k < 2; ++k) { const int i = tid + NTHR * k; const int t = i >> 4, c8 = (i & 15) * 8; *(LAS v4u*)(Qs + t * 136 + c8) = rq[k]; *(LAS v4u*)(Ks + t * 136 + c8) = rk[k];
            const v4u pv = rv[k];
#pragma unroll
            for (int q = 0; q < 4; ++q) { VT[(c8 + 2 * q) * 72 + t] = (bf16)(pv[q] & 0xffffu); VT[(c8 + 2 * q + 1) * 72 + t] = (bf16)(pv[q] >> 16); } }
#pragma unroll
        for (int k = 0; k < 4; ++k) { const int i = tid + NTHR * k; const int e = i >> 4, c8 = (i & 15) * 8; *(LAS v4u*)(CS + e * 136 + c8) = rc[k]; }
        if (tid < 64) { T[tid] = rT0; T[64 + tid] = rT1; }
        if (tid >= 128 && tid < 256) T[640 + tid - 128] = rNS;
        const float Min = rMin;
        P4_FETCH(ui + 1 < 4 ? ui + 1 : 3);
        __syncthreads();
        if (wave == 0) {
            const float bt = T[lane], li = T[64 + lane]; float pm = li - bt;
            pm = wave_scan_max(pm, lane);
            const float Mt = bt + fmaxf(Min, pm);
            T[128 + lane] = Mt; T[192 + lane] = __expf(bt + Min - Mt);
        }
        { const int t = tid >> 3, part = tid & 7; float s = 0.f;
#pragma unroll
          for (int j = 0; j < 16; ++j) s += bf2f(Qs[t * 136 + part * 16 + j]) * T[640 + part * 16 + j];
          s += dpp_f<0xB1>(s); s += dpp_f<0x4E>(s); s += dpp_f<0x124>(s);
          if (part == 0) T[256 + t] = s; }
        __syncthreads();
#pragma unroll
        for (int j = 0; j < 2; ++j) { const int tt = wave >> 1, st = 2 * (wave & 1) + j; f32x4 a = {0.f, 0.f, 0.f, 0.f};
            a = mma_rows<4>(Qs + (16 * tt + l15) * 136 + 8 * g, Ks + (16 * st + l15) * 136 + 8 * g, a);
            const int s = 16 * st + l15; const float cs = T[64 + s] - T[s];
#pragma unroll
            for (int r = 0; r < 4; ++r) { const int t = 16 * tt + 4 * g + r; const float wgt = (s <= t) ? __expf(T[t] + cs - T[128 + t]) : 0.f; const float v = a[r] * wgt;
                Ss[t * 72 + s] = (bf16)f2bf(v); const float rs = row16_sum(v);
                if (l15 == 0) T[384 + st * 64 + t] = rs; } }
        __syncthreads();
        if (tid < 64) { const float den = T[192 + tid] * T[256 + tid] + (T[384 + tid] + T[448 + tid]) + (T[512 + tid] + T[576 + tid]); T[320 + tid] = 1.0f / fmaxf(fabsf(den), __expf(-T[128 + tid])); }
        f32x4 acc[4];
        const int tt = wave >> 1, tl = 16 * tt + l15;
#pragma unroll
        for (int j = 0; j < 4; ++j) { const int et = 4 * (wave & 1) + j; f32x4 a = {0.f, 0.f, 0.f, 0.f};
            a = mma_rows<4>(CS + (16 * et + l15) * 136 + 8 * g, Qs + (16 * tt + l15) * 136 + 8 * g, a);
            a = a * T[192 + tl];
            a = mma_rows<2>(VT + (16 * et + l15) * 72 + 8 * g, Ss + (16 * tt + l15) * 72 + 8 * g, a);
            acc[j] = a; }
        __syncthreads();
        float ps = 0.f, pq = 0.f; const float invd = T[320 + tl];
        const size_t orow = (size_t)(m0 + tl) * NPROJ + CO_ + h * 128, crow = (size_t)(m0 + tl) * 512 + h * 128;
#pragma unroll
        for (int j = 0; j < 4; ++j) { const int e0 = 16 * (4 * (wave & 1) + j) + 4 * g; const v2u opk = *(const v2u*)(PR + orow + e0);
            const float op[4] = {bf2f(opk[0] & 0xffffu), __uint_as_float(opk[0] & 0xffff0000u), bf2f(opk[1] & 0xffffu), __uint_as_float(opk[1] & 0xffff0000u)};
#pragma unroll
            for (int r = 0; r < 4; ++r) { const float hv = acc[j][r] * invd / (1.f + __expf(-op[r])); acc[j][r] = hv; ps += hv; pq += hv * hv; } }
        ps += __shfl_xor(ps, 16); ps += __shfl_xor(ps, 32); pq += __shfl_xor(pq, 16); pq += __shfl_xor(pq, 32);
        if (g == 0) { T[768 + (wave & 1) * 64 + tl] = ps; T[896 + (wave & 1) * 64 + tl] = pq; }
        __syncthreads();
        { const float mu = (T[768 + tl] + T[832 + tl]) * (1.f / 128.f); const float var = (T[896 + tl] + T[960 + tl]) * (1.f / 128.f) - mu * mu; const float rsd = 1.0f / sqrtf(fmaxf(var, 0.f) + EPS);
#pragma unroll
          for (int j = 0; j < 4; ++j) { const int e0 = 16 * (4 * (wave & 1) + j) + 4 * g; const f32x4 gn = *(const f32x4*)(F.gn_g + h * 128 + e0), sk = *(const f32x4*)(F.skip + h * 128 + e0);
              const v2u cpk = *(const v2u*)(WSP(bf16, WS_CB) + crow + e0);
              const float cv[4] = {bf2f(cpk[0] & 0xffffu), __uint_as_float(cpk[0] & 0xffff0000u), bf2f(cpk[1] & 0xffffu), __uint_as_float(cpk[1] & 0xffff0000u)};
              float y[4];
#pragma unroll
              for (int r = 0; r < 4; ++r) y[r] = (acc[j][r] - mu) * rsd * gn[r] + sk[r] * cv[r];
              v2u o; o[0] = pk2(y[0], y[1]); o[1] = pk2(y[2], y[3]); *(v2u*)(PR + orow + e0) = o; } }
    }
    __syncthreads();
}

constexpr int L7_SK = 0, L7_LS = 69632;
__device__ __forceinline__ int pack_key(float v, int idx, unsigned mask) { int k = (int)((__builtin_bit_cast(unsigned, v) & ~mask) | (unsigned)idx); return k < 0 ? (k ^ 0x7fffffff) : k; }
__device__ __forceinline__ float key_val(int k, unsigned mask) { const int u = k < 0 ? (k ^ 0x7fffffff) : k; return __builtin_bit_cast(float, (unsigned)u & ~mask); }
__device__ __forceinline__ int key_idx(int k, unsigned mask) { const int u = k < 0 ? (k ^ 0x7fffffff) : k; return (int)((unsigned)u & mask); }
__device__ __forceinline__ void bitonic_sort16_desc(int (&t)[16]) {
#pragma unroll
    for (int k = 2; k <= 16; k <<= 1)
#pragma unroll
        for (int j = k >> 1; j > 0; j >>= 1)
#pragma unroll
            for (int i = 0; i < 16; ++i) { const int l = i ^ j; if (l > i) { const bool desc = ((i & k) == 0); const int hi = max(t[i], t[l]), lo = min(t[i], t[l]); t[i] = desc ? hi : lo; t[l] = desc ? lo : hi; } }
}
__device__ __forceinline__ void bitonic_merge16_desc(int (&t)[16]) {
#pragma unroll
    for (int j = 8; j > 0; j >>= 1)
#pragma unroll
        for (int i = 0; i < 16; ++i) { const int l = i ^ j; if (l > i) { const int hi = max(t[i], t[l]), lo = min(t[i], t[l]); t[i] = hi; t[l] = lo; } }
}
#define TOPK_INS(t, x) do { int _x = (x); _Pragma("unroll") for (int _i = 0; _i < 16; ++_i) { const int _hi = max(t[_i], _x); _x = min(t[_i], _x); t[_i] = _hi; } } while (0)
__device__ __forceinline__ void p7_topk(Frame& F) {
    const int tid = F.tid, lane = F.lane, wave = F.wave, g = lane >> 4, l15 = lane & 15;
    LAS bf16* SK = (LAS bf16*)(F.lds + L7_SK); LAS int* LS = (LAS int*)(F.lds + L7_LS); LAS int* HIST = (LAS int*)(F.lds + L7_LS + 65536);
    const bf16* QP = WSP(bf16, WS_QP);
    __syncthreads();
    for (int i = tid; i < 4096; i += NTHR) { const int row = i >> 4, c8 = (i & 15) * 8; *(LAS v4u*)(SK + row * 136 + c8) = *(const v4u*)(WSP(bf16, WS_SKB) + (size_t)row * 128 + c8); }
    __syncthreads();
    for (int unit = F.vcu; unit < MROWS / 64; unit += F.G) {
        const int tok0 = unit * 64, h = wave;
        for (int i = tid; i < 2048; i += NTHR) HIST[i] = 0;
        bf16x8 qf[4], qn[4];
        { const bf16* qrow = QP + (size_t)(tok0 + l15) * 2048 + h * 256 + 8 * g;
#pragma unroll
          for (int k = 0; k < 4; ++k) qf[k] = *(const bf16x8*)(qrow + 32 * k); }
#pragma unroll 1
        for (int it = 0; it < 8; ++it) {
            const int p = it >> 2, tt = it & 3;
            if (it + 1 < 8) { const int p2 = (it + 1) >> 2, tt2 = (it + 1) & 3; const bf16* qrow = QP + (size_t)(tok0 + 16 * tt2 + l15) * 2048 + h * 256 + p2 * 128 + 8 * g;
#pragma unroll
                for (int k = 0; k < 4; ++k) qn[k] = *(const bf16x8*)(qrow + 32 * k); }
            int ta[16], tb[16];
#pragma unroll
            for (int kt = 0; kt < 8; ++kt) { f32x4 a = {0.f, 0.f, 0.f, 0.f}; const LAS bf16* sk = SK + (p * 128 + 16 * kt + l15) * 136 + 8 * g;
#pragma unroll
                for (int k = 0; k < 4; ++k) a = __builtin_amdgcn_mfma_f32_16x16x32_bf16(*(const LAS bf16x8*)(sk + 32 * k), qf[k], a, 0, 0, 0);
#pragma unroll
                for (int r = 0; r < 4; ++r) { const int key = pack_key(a[r], 16 * kt + 4 * g + r, 127u); if (kt < 4) ta[4 * kt + r] = key; else tb[4 * (kt - 4) + r] = key; } }
            bitonic_sort16_desc(ta); bitonic_sort16_desc(tb);
#pragma unroll
            for (int i = 0; i < 16; ++i) ta[i] = max(ta[i], tb[15 - i]);
            bitonic_merge16_desc(ta);
#pragma unroll
            for (int dd = 16; dd <= 32; dd <<= 1) {
#pragma unroll
                for (int i = 0; i < 16; ++i) tb[i] = __shfl_xor(ta[i], dd);
#pragma unroll
                for (int i = 0; i < 16; ++i) ta[i] = max(ta[i], tb[15 - i]);
                bitonic_merge16_desc(ta); }
            if (g == 0) { LAS int* dst = LS + (((16 * tt + l15) * 8 + h) * 2 + p) * 16;
#pragma unroll
                for (int i = 0; i < 16; ++i) dst[i] = ta[i]; }
#pragma unroll
            for (int k = 0; k < 4; ++k) qf[k] = qn[k];
        }
        __syncthreads();
        { const int tok = tid >> 3, h2 = tid & 7; const LAS int* la = LS + ((tok * 8 + h2) * 2 + 0) * 16; const LAS int* lb = la + 16;
          float av[16], bv[16];
#pragma unroll
          for (int i = 0; i < 16; ++i) { av[i] = key_val(la[i], 127u); bv[i] = key_val(lb[i], 127u); }
          int top[16];
#pragma unroll
          for (int i = 0; i < 16; ++i) top[i] = (int)0x80000000;
#pragma unroll
          for (int i = 0; i < 16; ++i)
#pragma unroll
              for (int j = 0; j < 16; ++j) if ((i + 1) * (j + 1) <= 16) TOPK_INS(top, pack_key(av[i] + bv[j], i * 16 + j, 255u));
          const float vmax = key_val(top[0], 255u); float ev[16]; float z = 0.f;
#pragma unroll
          for (int k = 0; k < 16; ++k) { ev[k] = __expf(key_val(top[k], 255u) - vmax); z += ev[k]; }
          const float rz = 1.0f / z;
          int eidx[16]; float gate[16];
#pragma unroll
          for (int k = 0; k < 16; ++k) { const int ij = key_idx(top[k], 255u); const int ei = key_idx(la[ij >> 4], 127u), ej = key_idx(lb[ij & 15], 127u);
              eidx[k] = ei * 128 + ej; gate[k] = ev[k] * rz; __hip_atomic_fetch_add(HIST + tok * 32 + (eidx[k] >> 9), 1, __ATOMIC_RELAXED, __HIP_MEMORY_SCOPE_WORKGROUP); }
          __syncthreads();
          if (tid < 64) { int run = 0;
#pragma unroll
              for (int b = 0; b < 32; ++b) { const int c = HIST[tid * 32 + b]; HIST[tid * 32 + b] = run; run += c; } }
          __syncthreads();
          if (h2 == 0) { const f32x4* q = (const f32x4*)(WSP(float, WS_SSQ) + (size_t)(tok0 + tok) * 16); float ssq = 0.f;
#pragma unroll
              for (int j = 0; j < 4; ++j) { const f32x4 a = q[j]; ssq += (a[0] + a[1]) + (a[2] + a[3]); }
              WSP(float, WS_RS2)[tok0 + tok] = 1.0f / sqrtf(ssq * (1.0f / DM) + EPS); }
          v2u* tk = (v2u*)WSP(unsigned, WS_TK) + (size_t)(tok0 + tok) * 128;
#pragma unroll
          for (int k = 0; k < 16; ++k) { const int pos = __hip_atomic_fetch_add(HIST + tok * 32 + (eidx[k] >> 9), 1, __ATOMIC_RELAXED, __HIP_MEMORY_SCOPE_WORKGROUP);
              v2u o; o.x = (unsigned)eidx[k]; o.y = __builtin_bit_cast(unsigned, gate[k]); tk[pos] = o; } }
        asm volatile("s_waitcnt vmcnt(0)" ::: "memory");
        __syncthreads();
    }
}

__device__ __forceinline__ float gelu_erf(float v) { return 0.5f * v * (1.0f + erff(v * 0.70710678118654752f)); }
typedef float f32x2v __attribute__((ext_vector_type(2)));
#define P8_LOAD8(RB, G) P8_LOAD8X(RB, G, e0.x, e1.x)
#define P8_LOAD8X(RB, G, EX0, EX1) do { if ((G) < 32) { const unsigned char* _tab = ((G) < 16) ? EU : EV; _Pragma("unroll") for (int _j = 0; _j < 8; ++_j) { const int _k = 8 * ((G) & 15) + _j; const unsigned _s = (_k < 64) ? (EX0) : (EX1); \
        const unsigned _ei = (unsigned)__builtin_amdgcn_readlane((int)_s, _k & 63); RB[_j] = *(const v2u*)(_tab + (size_t)_ei * (DM / 2) + 8 * lane); } } } while (0)
__device__ __forceinline__ float gelu_as(float v) {
    const float av = fabsf(v), t = __builtin_amdgcn_rcpf(av * 0.2316418882f + 1.0f);
    float q = t * 0.5307027145f + (-0.7265760135f); q = q * t + 0.7107068705f; q = q * t + (-0.142248368f); q = q * t + 0.127414796f; q = q * t;
    const float m = v * (q * __builtin_amdgcn_exp2f((v * v) * (-0.72134752044f)));
    return v < 0.f ? m : v - m;
}
__device__ __forceinline__ float reduce8_butterfly(const float (&d)[8], int lane) {
    const bool b5 = (lane & 32) != 0, b4 = (lane & 16) != 0, b3 = (lane & 8) != 0;
    float k4[4];
#pragma unroll
    for (int i = 0; i < 4; ++i) { const float snd = b5 ? d[i] : d[i + 4], kp = b5 ? d[i + 4] : d[i]; k4[i] = kp + __shfl_xor(snd, 32); }
    float k2[2];
#pragma unroll
    for (int i = 0; i < 2; ++i) { const float snd = b4 ? k4[i] : k4[i + 2], kp = b4 ? k4[i + 2] : k4[i]; k2[i] = kp + __shfl_xor(snd, 16); }
    float k1; { const float snd = b3 ? k2[0] : k2[1], kp = b3 ? k2[1] : k2[0]; k1 = kp + __shfl_xor(snd, 8); }
    k1 += __shfl_xor(k1, 4); k1 += __shfl_xor(k1, 2); k1 += __shfl_xor(k1, 1);
    return k1;
}
#define P8_UDOT(UB, G) do { _Pragma("unroll") for (int _j = 0; _j < 8; ++_j) { \
            int _sh = __builtin_amdgcn_sdot8((int)UB[_j][0], (int)xh0, 0, false); _sh = __builtin_amdgcn_sdot8((int)UB[_j][1], (int)xh1, _sh, false); \
            int _sl = __builtin_amdgcn_sdot8((int)UB[_j][0], (int)xl0, 0, false); _sl = __builtin_amdgcn_sdot8((int)UB[_j][1], (int)xl1, _sl, false); const int _s = (_sh << 4) + _sl; \
            red[(8 * ((G) & 7) + _j) * 65 + lane] = (float)_s; } \
        if (((G) & 7) == 7) { float _t0 = 0.f, _t1 = 0.f, _t2 = 0.f, _t3 = 0.f; _Pragma("unroll") for (int _i = 0; _i < 64; _i += 4) { _t0 += red[lane * 65 + _i]; _t1 += red[lane * 65 + _i + 1]; _t2 += red[lane * 65 + _i + 2]; _t3 += red[lane * 65 + _i + 3]; } \
            const float _dl = (_t0 + _t1) + (_t2 + _t3); const bool _c1 = (G) >= 8; const float _gl = __uint_as_float(_c1 ? e1.y : e0.y), _su = __uint_as_float(_c1 ? s1x : s0x); \
            const float _cv = _gl * gelu_as((_dl + hsx) * _su * rsx) * 0.25f; if (_c1) c1 = _cv; else c0 = _cv; } } while (0)
#define P8_FP4ACC(w, sel, i0) { const f32x2v _f = __builtin_amdgcn_cvt_scalef32_pk_f32_fp4((w), 1.0f, sel); acc[i0] += _c * _f[0]; acc[(i0) + 1] += _c * _f[1]; }
#define P8_VACC(VB, G) do { const int _g = (G) - 16; const float _csrc = (_g < 8) ? c0 : c1; _Pragma("unroll") for (int _j = 0; _j < 8; ++_j) { \
            asm volatile("" : "+v"(VB[_j][0]), "+v"(VB[_j][1]) : "v"(acc[0]), "v"(acc[5]), "v"(acc[10]), "v"(acc[15])); \
            const float _c = __uint_as_float((unsigned)__builtin_amdgcn_readlane((int)__float_as_uint(_csrc), 8 * (_g & 7) + _j)); \
            P8_FP4ACC(VB[_j][0], 0, 0) P8_FP4ACC(VB[_j][0], 1, 2) P8_FP4ACC(VB[_j][0], 2, 4) P8_FP4ACC(VB[_j][0], 3, 6) P8_FP4ACC(VB[_j][1], 0, 8) P8_FP4ACC(VB[_j][1], 1, 10) P8_FP4ACC(VB[_j][1], 2, 12) P8_FP4ACC(VB[_j][1], 3, 14) } } while (0)
typedef int v8i __attribute__((ext_vector_type(8)));
#define P8_CLOAD_V(RB, PC, H) do { _Pragma("unroll") for (int _r = 0; _r < 8; ++_r) RB[_r] = *(const v4u*)(EV + (size_t)vofv[H][_r] + 128 * (PC)); } while (0)
#define P8_SLAB(RB, PC, H, FIRST) do { \
        _Pragma("unroll") for (int _r = 0; _r < 8; ++_r) { v4u _w = RB[_r]; if (_r >= 4) { const unsigned _t0 = _w[0], _t1 = _w[1]; _w[0] = _w[2]; _w[1] = _w[3]; _w[2] = _t0; _w[3] = _t1; } \
            *(LAS v4u*)(SLB + ((_r & 1) ? wa1 : wa0) + 1024 * _r) = _w; } \
        _Pragma("unroll") for (int _i = 0; _i < 16; ++_i) { const int _cb = 4 * (_i & 3) + (_i >> 2); const int _ta = (tb ^ (16 * (_cb >> 1))) ^ (8 * (_cb & 1)); \
            const v2i_t _t0 = __builtin_amdgcn_ds_read_tr4_b64_v2i32((LAS v2i_t*)(SLB + _ta)); const v2i_t _t1 = __builtin_amdgcn_ds_read_tr4_b64_v2i32((LAS v2i_t*)(SLB + _ta + 2048)); \
            v8i _b, _a; _b[0] = _t0[0]; _b[1] = _t0[1]; _b[2] = _t1[0]; _b[3] = _t1[1]; _b[4] = 0; _b[5] = 0; _b[6] = 0; _b[7] = 0; \
            const bool _keep = (ln >> 2) == (_cb & 3); _a[0] = _keep ? (int)ah[H][0] : 0; _a[1] = _keep ? (int)ah[H][1] : 0; _a[2] = _keep ? (int)ah[H][2] : 0; _a[3] = _keep ? (int)ah[H][3] : 0; _a[4] = 0; _a[5] = 0; _a[6] = 0; _a[7] = 0; \
            if ((FIRST) && (_cb & 3) == 0) { const f32x4 _z = {0.f, 0.f, 0.f, 0.f}; vacc[_cb >> 2] = _z; } \
            vacc[_cb >> 2] = __builtin_amdgcn_mfma_scale_f32_16x16x128_f8f6f4(_a, _b, vacc[_cb >> 2], 0, 4, 0, 0, 0, 0); } } while (0)
#define P8_VOUT(PC) do { _Pragma("unroll") for (int _a = 0; _a < 4; ++_a) OT[oto + 64 * (PC) + 16 * _a] = vacc[_a][0] + vacc[_a][1]; } while (0)
typedef int v2i_t __attribute__((ext_vector_type(2)));
__device__ __forceinline__ void p8_gather(Frame& F) {
    const int lane = F.lane; const int gw = F.vcu * NWAVES + F.wave, NGW = F.G * NWAVES;
    const unsigned char* EU = F.ws + WS_EU; const unsigned char* EV = F.ws + WS_EV; const bf16* H1B = WSP(bf16, WS_H1B);
    const unsigned long long* tkb = (const unsigned long long*)WSP(unsigned, WS_TK);
    unsigned long long nt0 = tkb[(size_t)(gw * 8) * 128 + lane], nt1 = tkb[(size_t)(gw * 8) * 128 + 64 + lane];
    v2u nx[4];
#pragma unroll
    for (int j = 0; j < 4; ++j) nx[j] = *(const v2u*)(H1B + (size_t)(gw * 8) * DM + 256 * j + 4 * lane);
    float nrs = WSP(float, WS_RS2)[gw * 8];
    const float* esc = WSP(float, WS_ESC);
    LAS float* red = (LAS float*)(F.lds + F.wave * 16640);
    LAS unsigned char* WL = F.lds + F.wave * 16640;
    LAS unsigned char* CTB = WL; LAS float* OT = (LAS float*)(WL + 1024); LAS unsigned char* SLB = WL + 8192;
    const int lq = lane >> 4, ln = lane & 15;
    const int cta = ((ln & 3) < 2 ? 128 * (ln & 3) : 256) + 16 * lq;
    const int wa0 = 128 * (lane >> 3) + 16 * ((lane & 7) ^ (lane >> 4)), wa1 = 128 * (lane >> 3) + 16 * ((lane & 7) ^ (4 + (lane >> 4)));
    const int tb = (32 * (lq & 1) + ln) * 128 + 16 * ((ln >> 1) & 7) + 8 * (lq & 1);
    const int oto = 256 * (ln >> 2) + 4 * lq + (ln & 3);
    f32x4 vacc[4];
    __syncthreads();
    float ns0x = esc[(unsigned)nt0], ns1x = esc[(unsigned)nt1];
    v2u b0[8], b1[8], b2[8];
    P8_LOAD8X(b0, 0, (unsigned)nt0, (unsigned)nt1); P8_LOAD8X(b1, 1, (unsigned)nt0, (unsigned)nt1);
    for (int tok = gw * 8; tok < gw * 8 + 8; ++tok) {
        float xf[16];
#pragma unroll
        for (int j = 0; j < 4; ++j) { const v2u xr = nx[j];
            xf[4 * j] = bf2f(xr[0] & 0xffffu); xf[4 * j + 1] = __uint_as_float(xr[0] & 0xffff0000u); xf[4 * j + 2] = bf2f(xr[1] & 0xffffu); xf[4 * j + 3] = __uint_as_float(xr[1] & 0xffff0000u); }
        v2u e0, e1; e0.x = (unsigned)nt0; e0.y = (unsigned)(nt0 >> 32); e1.x = (unsigned)nt1; e1.y = (unsigned)(nt1 >> 32);
        const unsigned s0x = __float_as_uint(ns0x), s1x = __float_as_uint(ns1x);
        float amax = 0.f;
#pragma unroll
        for (int i = 0; i < 16; ++i) amax = fmaxf(amax, fabsf(xf[i]));
        amax = wave_max(amax); const float sx = amax > 0.f ? 119.0f / amax : 1.0f;
        int sxl = 0; unsigned xh0 = 0u, xh1 = 0u, xl0 = 0u, xl1 = 0u;
#pragma unroll
        for (int i = 0; i < 16; ++i) { const int q = (int)rintf(xf[i] * sx); sxl += q; const int l = ((q + 8) & 15) - 8, h = (q - l) >> 4;
            if (i < 8) { xl0 |= ((unsigned)l & 15u) << (4 * i); xh0 |= ((unsigned)h & 15u) << (4 * i); } else { xl1 |= ((unsigned)l & 15u) << (4 * (i - 8)); xh1 |= ((unsigned)h & 15u) << (4 * (i - 8)); } }
        const float hsx = 0.5f * wave_sum((float)sxl);
        const float rsx = nrs / sx;
        float c0 = 0.f, c1 = 0.f;
        P8_LOAD8(b2, 2); P8_UDOT(b0, 0);
        P8_LOAD8(b0, 3); P8_UDOT(b1, 1);
        P8_LOAD8(b1, 4); P8_UDOT(b2, 2);
        P8_LOAD8(b2, 5); P8_UDOT(b0, 3);
        P8_LOAD8(b0, 6); P8_UDOT(b1, 4);
        P8_LOAD8(b1, 7); P8_UDOT(b2, 5);
        P8_LOAD8(b2, 8); P8_UDOT(b0, 6);
        P8_LOAD8(b0, 9); P8_UDOT(b1, 7);
        P8_LOAD8(b1, 10); P8_UDOT(b2, 8);
        P8_LOAD8(b2, 11); P8_UDOT(b0, 9);
        P8_LOAD8(b0, 12); P8_UDOT(b1, 10);
        P8_LOAD8(b1, 13); P8_UDOT(b2, 11);
        P8_LOAD8(b2, 14); P8_UDOT(b0, 12);
        P8_LOAD8(b0, 15); P8_UDOT(b1, 13);
        unsigned vofv[2][8];
#pragma unroll
        for (int h = 0; h < 2; ++h)
#pragma unroll
            for (int r = 0; r < 8; ++r) vofv[h][r] = (unsigned)__builtin_amdgcn_ds_bpermute(4 * (8 * r + (lane >> 3)), (int)(h ? e1.x : e0.x)) * 512u + 16u * (lane & 7);
        v4u sa[8], sb[8];
        P8_CLOAD_V(sa, 0, 0);
        P8_UDOT(b2, 14);
        P8_CLOAD_V(sb, 0, 1);
        P8_UDOT(b0, 15);
        asm volatile("" ::: "memory");
        const int tokn = tok + 1 < gw * 8 + 8 ? tok + 1 : tok;
        nt0 = tkb[(size_t)tokn * 128 + lane]; nt1 = tkb[(size_t)tokn * 128 + 64 + lane];
#pragma unroll
        for (int j = 0; j < 4; ++j) nx[j] = *(const v2u*)(H1B + (size_t)tokn * DM + 256 * j + 4 * lane);
        nrs = WSP(float, WS_RS2)[tokn];
        const float cmax = wave_max(fmaxf(fabsf(c0), fabsf(c1))); const float sc = cmax > 0.f ? 256.0f / cmax : 1.0f, rsc = 1.0f / sc;
        { const float a0 = c0 * sc, a1 = c1 * sc; const int h = __builtin_amdgcn_cvt_pk_fp8_f32(a0, a1, 0, false);
          const f32x2v rb = __builtin_amdgcn_cvt_pk_f32_fp8(h, false); const int l = __builtin_amdgcn_cvt_pk_fp8_f32(a0 - rb[0], a1 - rb[1], 0, false);
          CTB[lane] = (unsigned char)(h & 0xff); CTB[64 + lane] = (unsigned char)((h >> 8) & 0xff); CTB[128 + lane] = (unsigned char)(l & 0xff); CTB[192 + lane] = (unsigned char)((l >> 8) & 0xff);
          if (lane < 8) { v4u z; z[0] = 0u; z[1] = 0u; z[2] = 0u; z[3] = 0u; *(LAS v4u*)(CTB + 256 + 16 * lane) = z; } }
        v4u ah[2];
#pragma unroll
        for (int h = 0; h < 2; ++h) ah[h] = *(const LAS v4u*)(CTB + cta + 64 * h);
        P8_SLAB(sa, 0, 0, true);  P8_CLOAD_V(sa, 1, 0);
        P8_SLAB(sb, 0, 1, false); P8_CLOAD_V(sb, 1, 1);  P8_VOUT(0);
        P8_SLAB(sa, 1, 0, true);  P8_CLOAD_V(sa, 2, 0);
        P8_SLAB(sb, 1, 1, false); P8_CLOAD_V(sb, 2, 1);  P8_VOUT(1);
        P8_SLAB(sa, 2, 0, true);  P8_CLOAD_V(sa, 3, 0);
        P8_SLAB(sb, 2, 1, false); P8_CLOAD_V(sb, 3, 1);  P8_VOUT(2);
        ns0x = esc[(unsigned)nt0]; ns1x = esc[(unsigned)nt1];
        v2u hr[4];
#pragma unroll
        for (int j = 0; j < 4; ++j) hr[j] = *(const v2u*)(H1B + (size_t)tok * DM + 256 * j + 4 * lane);
        P8_LOAD8X(b2, 0, (unsigned)nt0, (unsigned)nt1);
        P8_SLAB(sa, 3, 0, true);
        P8_LOAD8X(b0, 1, (unsigned)nt0, (unsigned)nt1);
        P8_SLAB(sb, 3, 1, false); P8_VOUT(3);
        float acc[16];
#pragma unroll
        for (int j = 0; j < 4; ++j) { const f32x4 t = *(const LAS f32x4*)(OT + 256 * j + 4 * lane); acc[4 * j] = t[0] * rsc; acc[4 * j + 1] = t[1] * rsc; acc[4 * j + 2] = t[2] * rsc; acc[4 * j + 3] = t[3] * rsc; }
        f32x4* orow = (f32x4*)(F.out + (size_t)tok * DM) + lane; f32x4 hv[4]; float s2 = 0.f;
        f32x4 gv[4];
#pragma unroll
        for (int j = 0; j < 4; ++j) gv[j] = ((const f32x4*)F.g_fin)[lane + 64 * j];
#pragma unroll
        for (int j = 0; j < 4; ++j) {
            { const v2u xr = hr[j];
              hv[j][0] = bf2f(xr[0] & 0xffffu); hv[j][1] = __uint_as_float(xr[0] & 0xffff0000u); hv[j][2] = bf2f(xr[1] & 0xffffu); hv[j][3] = __uint_as_float(xr[1] & 0xffff0000u); }
#pragma unroll
            for (int i = 0; i < 4; ++i) { hv[j][i] += acc[4 * j + i]; s2 += hv[j][i] * hv[j][i]; } }
        s2 = wave_sum(s2); const float rstd3 = 1.0f / sqrtf(s2 * (1.0f / DM) + EPS);
#pragma unroll
        for (int j = 0; j < 4; ++j) orow[64 * j] = hv[j] * rstd3 * gv[j];
#pragma unroll
        for (int j = 0; j < 8; ++j) { const v2u t = b0[j]; b0[j] = b2[j]; b1[j] = t; }
        asm volatile("" ::: "memory");
    }
}

constexpr int CW_BAR = 4096;
static_assert((CW_BAR + XCD_BAR_WORDS) * 4 <= (int)CTL_ZERO_BYTES, "barrier words inside the zeroed region");

__global__ void __launch_bounds__(NTHR, 2) hybrid_fwd(Params prm) {
    extern __shared__ __attribute__((aligned(16))) unsigned char lds_raw[];
    Frame F;
    F.lds = (LAS unsigned char*)lds_raw;
    F.tid = threadIdx.x; F.lane = F.tid & 63; F.wave = __builtin_amdgcn_readfirstlane(F.tid >> 6);
    F.G = gridDim.x; { const int bx = blockIdx.x; F.vcu = (F.G % 8 == 0) ? (bx % 8) * (F.G / 8) + bx / 8 : bx; }
    F.x = prm.in[0]; F.meta = prm.in[1]; F.g_mix = prm.in[2]; F.w_in = prm.in[3]; F.conv_w = prm.in[4]; F.conv_b = prm.in[5]; F.w_qm = prm.in[6]; F.w_km = prm.in[7];
    F.b_i = prm.in[8]; F.b_f = prm.in[9]; F.skip = prm.in[10]; F.gn_g = prm.in[11]; F.sb_g = prm.in[12]; F.w_out = prm.in[13]; F.g_ffn = prm.in[14]; F.w_query = prm.in[15];
    F.sub_keys = prm.in[16]; F.eu = prm.in[17]; F.ev = prm.in[18]; F.g_fin = prm.in[19]; F.out = prm.out; F.ws = prm.ws;
    volatile LAS unsigned* MISC = (volatile LAS unsigned*)(F.lds + LDSCTL_OFF);
    if (F.tid < 64) MISC[F.tid] = 0u;
    __syncthreads();
    XcdBarrier bar = xcd_barrier_post((unsigned*)(F.ws + WS_CTL) + CW_BAR, MISC + 8);

    p0_prologue(F);
    xcd_barrier(bar);
    {
        pg8::Gemm g{WSP(bf16, WS_XB), WSP(bf16, WS_WINT), MROWS, NPROJ, DM, DM, DM}; pg8::StaticOrder S; S.init(MROWS, NPROJ, F.G, (int)blockIdx.x);
        pg8::EpiRowScaleBf16<0> E{WSP(bf16, WS_PR), NPROJ, WSP(float, WS_RSTD1), EPS};
        pg8::gemm_phase<pg8::EpiRowScaleBf16<0>, pg8::StaticOrder, PG8_ALIGN, PG8_SP2>(F.lds, g, S, E);
        p1_meta_tail(F);
    }
    xcd_barrier(bar);
    p2_mlstm_local(F);
    p2_sb_attention(F);
    xcd_barrier(bar);
    p3_scan(F);
    xcd_barrier(bar);
    p4_mlstm_out(F);
    xcd_barrier(bar);
    {
        pg8::Gemm g{WSP(bf16, WS_PR) + CO_, WSP(bf16, WS_WOUTT), MROWS, DM, DM, NPROJ, DM}; pg8::StaticOrder S; S.init(MROWS, DM, F.G, (int)blockIdx.x);
        pg8::EpiResidual E{F.x, F.out, WSP(bf16, WS_H1B), WSP(float, WS_SSQ), DM};
        pg8::gemm_phase<pg8::EpiResidual, pg8::StaticOrder, PG8_ALIGN, PG8_SP2>(F.lds, g, S, E);
    }
    xcd_barrier(bar);
    {
        pg8::Gemm g{WSP(bf16, WS_H1B), WSP(bf16, WS_WQT), MROWS, 2048, DM, DM, DM}; pg8::StaticOrder S; S.init(MROWS, 2048, F.G, (int)blockIdx.x);
        pg8::EpiRowScaleBf16<1> E{WSP(bf16, WS_QP), 2048, WSP(float, WS_SSQ), EPS};
        pg8::gemm_phase<pg8::EpiRowScaleBf16<1>, pg8::StaticOrder, PG8_ALIGN, PG8_SP2>(F.lds, g, S, E);
    }
    xcd_barrier(bar);
    p7_topk(F);
    p8_gather(F);
}

extern "C" void kernel_launch(void* const* d_in, const int* in_sizes, int n_in, void* d_out, int out_size, void* d_ws, size_t ws_size, hipStream_t stream) {
    static int grid = 0;
    if (grid == 0) {
        if (n_in != 20 || in_sizes[0] != MROWS * DM || out_size != MROWS * DM || ws_size < WS_END) {
            fprintf(stderr, "kernel_launch: unexpected shapes (n_in %d, in0 %d, out %d, ws %zu < %zu); nothing launched\n", n_in, n_in > 0 ? in_sizes[0] : -1, out_size, ws_size, (size_t)WS_END); grid = -1; return; }
        int dev = 0, cus = 0, per_cu = 0;
        if (hipGetDevice(&dev) != hipSuccess || hipDeviceGetAttribute(&cus, hipDeviceAttributeMultiprocessorCount, dev) != hipSuccess) { fprintf(stderr, "kernel_launch: device query failed\n"); grid = -1; return; }
        if (hipFuncSetAttribute((const void*)hybrid_fwd, hipFuncAttributeMaxDynamicSharedMemorySize, LDS_BYTES) != hipSuccess) { fprintf(stderr, "kernel_launch: hipFuncSetAttribute failed\n"); grid = -1; return; }
        if (hipOccupancyMaxActiveBlocksPerMultiprocessor(&per_cu, (const void*)hybrid_fwd, NTHR, LDS_BYTES) != hipSuccess || per_cu < 1) { fprintf(stderr, "kernel_launch: occupancy query says %d blocks/CU\n", per_cu); (void)hipGetLastError(); grid = -1; return; }
        grid = cus;
        if (grid != 256) { fprintf(stderr, "kernel_launch: this kernel is built for a 256-CU device (got %d)\n", grid); grid = -1; return; }
    }
    if (grid < 0) return;
    if (hipMemsetAsync((char*)d_ws + WS_CTL, 0, CTL_ZERO_BYTES, stream) != hipSuccess) { fprintf(stderr, "kernel_launch: memset failed\n"); return; }
    Params p{};
    for (int i = 0; i < 20; ++i) p.in[i] = (const float*)d_in[i];
    p.out = (float*)d_out; p.ws = (unsigned char*)d_ws;
    void* args[] = {&p};
    const hipError_t e = hipLaunchCooperativeKernel((const void*)hybrid_fwd, dim3(grid), dim3(NTHR), args, LDS_BYTES, stream);
    if (e != hipSuccess) fprintf(stderr, "kernel_launch: cooperative launch failed: %s\n", hipGetErrorString(e));
}
```

```cpp
#include <hip/hip_runtime.h>
#include <hip/hip_cooperative_groups.h>
#include <cstdio>
#include <cstdint>
namespace cg = cooperative_groups;

namespace pg8 {
#define PG8_LAS __attribute__((address_space(3)))
typedef unsigned short bf16_t;
typedef short bf16x8 __attribute__((ext_vector_type(8)));
typedef float f32x4 __attribute__((ext_vector_type(4)));
typedef unsigned u32x4 __attribute__((ext_vector_type(4)));
typedef unsigned u32x2 __attribute__((ext_vector_type(2)));
constexpr int BM = 256, BK = 64, HALF = 128, HTB = HALF * BK * 2  , STAGE_BYTES = 8 * HTB, NXCD = 8, WGM = 8;

__host__ __device__ __forceinline__ int lds_byte(int r, int c) { const int st = (r >> 4) * 2 + (c >> 5), rr = r & 15, cc = c & 31, ob = rr * 64 + cc * 2; return st * 1024 + (ob ^ (((ob >> 9) & 1) << 5)); }
__host__ __device__ __forceinline__ void stage_rc(int b, int& R, int& C) { const int st = b / 1024, sb = b % 1024, swz = sb ^ (((sb >> 9) & 1) << 5); R = (st >> 1) * 16 + swz / 64; C = (st & 1) * 32 + (swz % 64) / 2; }
__host__ __device__ __forceinline__ int perm32(int rho) { const int n = rho >> 4, i = rho & 15; return 8 * (i >> 2) + 4 * n + (i & 3); }

struct Unit { int pm, pn; };
struct Gemm { const bf16_t* A; const bf16_t* Bt; int M, N, K, lda, ldb; };

struct StaticOrder {
    int nM, nN, nwg, G, c;
    __host__ __device__ void init(int M, int N, int G_, int c_) { nM = M / BM; nN = N / BM; nwg = nM * nN; G = G_; c = c_; }
    __host__ __device__ bool next(int i, Unit& u) const {
        const long L = (long)i * G + c; if (L >= nwg) return false;
        int wgid = (int)L; { const int q = nwg / NXCD, r = nwg % NXCD, xcd = wgid % NXCD, off = wgid / NXCD; wgid = (xcd < r ? xcd * (q + 1) : r * (q + 1) + (xcd - r) * q) + off; }
        const int nig = WGM * nN, gid = wgid / nig, fm = gid * WGM, gsz = (nM - fm) < WGM ? (nM - fm) : WGM;
        u.pm = fm + ((wgid % nig) % gsz); u.pn = (wgid % nig) / gsz; return true;
    }
    __device__ __forceinline__ void a_ready(const Unit&) const {}
    __device__ __forceinline__ void done(const Unit&) const {}
};

__device__ __forceinline__ unsigned cvt_pk_bf16(float lo, float hi) { unsigned r; asm volatile("v_cvt_pk_bf16_f32 %0, %1, %2" : "=v"(r) : "v"(lo), "v"(hi)); return r; }

template <int MODE> struct EpiRowScaleBf16 {
    static constexpr bool PERM = true, AFTER_DRAIN = false;
    bf16_t* O; int ldc; const float* rs; float eps;
    __device__ __forceinline__ void operator()(const f32x4 (&acc)[2][2][4][2], const Unit& u, int wr, int wc, int fr, int fq) const {
        const int row0 = u.pm * BM + wr * 64 + fr; const int col0 = u.pn * BM + wc * 32 + 8 * fq;
#pragma unroll
        for (int ai = 0; ai < 2; ++ai)
#pragma unroll
            for (int m = 0; m < 4; ++m) { const int row = row0 + ai * HALF + m * 16; float sc;
                if (MODE == 0) sc = rs[row];
                else { const f32x4* q = (const f32x4*)(rs + (size_t)row * 16); const f32x4 a = q[0], b = q[1], c = q[2], d = q[3];
                       const float s = ((a[0] + a[1]) + (a[2] + a[3])) + ((b[0] + b[1]) + (b[2] + b[3])) + ((c[0] + c[1]) + (c[2] + c[3])) + ((d[0] + d[1]) + (d[2] + d[3]));
                       sc = 1.0f / sqrtf(s * (1.0f / 1024.0f) + eps); }
                bf16_t* rowp = O + (size_t)row * ldc + col0;
#pragma unroll
                for (int bj = 0; bj < 2; ++bj) { const f32x4 v0 = acc[ai][bj][m][0] * sc, v1 = acc[ai][bj][m][1] * sc;
                    u32x4 w; w.x = cvt_pk_bf16(v0[0], v0[1]); w.y = cvt_pk_bf16(v0[2], v0[3]); w.z = cvt_pk_bf16(v1[0], v1[1]); w.w = cvt_pk_bf16(v1[2], v1[3]);
                    *(u32x4*)(rowp + bj * HALF) = w; } }
    }
};
struct EpiResidual {
    static constexpr bool PERM = false, AFTER_DRAIN = false;
    const float* base; float* out; bf16_t* outb; float* ssq; int ldc;
    __device__ __forceinline__ void operator()(const f32x4 (&acc)[2][2][4][2], const Unit& u, int wr, int wc, int fr, int fq) const {
        const int col0 = u.pn * BM + wc * 32 + 4 * fq;
#pragma unroll
        for (int ai = 0; ai < 2; ++ai)
#pragma unroll
            for (int m = 0; m < 4; ++m) { const int row = u.pm * BM + ai * HALF + wr * 64 + m * 16 + fr; const size_t off = (size_t)row * ldc + col0; float s = 0.f;
#pragma unroll
                for (int bj = 0; bj < 2; ++bj)
#pragma unroll
                    for (int n = 0; n < 2; ++n) { const size_t o = off + bj * HALF + n * 16; const f32x4 h = *(const f32x4*)(base + o) + acc[ai][bj][m][n];
                        u32x2 w; w.x = cvt_pk_bf16(h[0], h[1]); w.y = cvt_pk_bf16(h[2], h[3]); *(u32x2*)(outb + o) = w;
                        s += (h[0] * h[0] + h[1] * h[1]) + (h[2] * h[2] + h[3] * h[3]); }
                s += __shfl_xor(s, 16); s += __shfl_xor(s, 32);
                if (fq == 0) ssq[(size_t)row * 16 + u.pn * 4 + wc] = s; }
    }
};
template <class Epi, class Sched, bool ALIGN_EPI = false, bool SP2 = false>
__device__ __forceinline__ void gemm_phase(PG8_LAS unsigned char* lds, const Gemm g, const Sched& S, const Epi& E) {
    int tid_ = threadIdx.x; asm volatile("" : "+v"(tid_));
    const int tid = tid_, wid = __builtin_amdgcn_readfirstlane(tid >> 6), lane = tid & 63, wr = wid >> 2, wc = wid & 3, fr = lane & 15, fq = lane >> 4;
    const int K = g.K, nt = K / BK;
    unsigned voffA[2], voffB[2];
#pragma unroll
    for (int i = 0; i < 2; ++i) { int R, C; stage_rc(tid * 16 + i * 8192, R, C); const int Rb = Epi::PERM ? ((R & ~31) + perm32(R & 31)) : R;
        voffA[i] = (unsigned)(R * g.lda + C) * 2u; voffB[i] = (unsigned)(Rb * g.ldb + C) * 2u; }
    const size_t kstep = (size_t)(BK * 2);
    const size_t hstepA = (size_t)HALF * g.lda * 2, hstepB = (size_t)HALF * g.ldb * 2;
    const size_t tstepA = 2 * hstepA, tstepB = 2 * hstepB;
    const unsigned ldsw = (unsigned)wid * 1024u;
    const int aoff = lds_byte(wr * 64 + fr, fq * 8), boff = lds_byte(wc * 32 + fr, fq * 8);
#define PG8_SA(b, h) (((b) * 2 + (h)) * HTB)
#define PG8_SB(b, h) ((4 + (b) * 2 + (h)) * HTB)
#define PG8_STAGE(bufoff, gbase, voff) do { _Pragma("unroll") for (int _i = 0; _i < 2; ++_i) \
        __builtin_amdgcn_global_load_lds((const unsigned*)((const char*)(gbase) + (voff)[_i]), (PG8_LAS unsigned*)(lds + (bufoff) + ldsw + _i * 8192), 16, 0, 0); } while (0)
#define PG8_LDA(dst, b, h) do { _Pragma("unroll") for (int m = 0; m < 4; ++m) _Pragma("unroll") for (int k = 0; k < 2; ++k) dst[m][k] = *(const PG8_LAS bf16x8*)(lds + PG8_SA(b, h) + aoff + m * 2048 + k * 1024); } while (0)
#define PG8_LDB(dst, b, h) do { _Pragma("unroll") for (int n = 0; n < 2; ++n) _Pragma("unroll") for (int k = 0; k < 2; ++k) dst[n][k] = *(const PG8_LAS bf16x8*)(lds + PG8_SB(b, h) + boff + n * 2048 + k * 1024); } while (0)
#define PG8_MMA(ai, bj, At, Bt) do { __builtin_amdgcn_s_setprio(1); _Pragma("unroll") for (int m = 0; m < 4; ++m) _Pragma("unroll") for (int n = 0; n < 2; ++n) _Pragma("unroll") for (int k = 0; k < 2; ++k) \
        acc[ai][bj][m][n] = __builtin_amdgcn_mfma_f32_16x16x32_bf16(Bt[n][k], At[m][k], acc[ai][bj][m][n], 0, 0, 0); __builtin_amdgcn_s_setprio(0); } while (0)
#define PG8_WAIT_V(n) asm volatile("s_waitcnt vmcnt(" #n ")" ::: "memory")
#define PG8_WAIT_L(n) asm volatile("s_waitcnt lgkmcnt(" #n ")" ::: "memory")
#define PG8_BAR __builtin_amdgcn_s_barrier()
#define PG8_SCHED __builtin_amdgcn_sched_barrier(0)
    Unit cur, nxt; int ui = 0;
    if (!S.next(0, cur)) return;
    f32x4 acc[2][2][4][2];
#pragma unroll
    for (int a = 0; a < 2; ++a)
#pragma unroll
        for (int b = 0; b < 2; ++b)
#pragma unroll
            for (int m = 0; m < 4; ++m)
#pragma unroll
                for (int n = 0; n < 2; ++n) acc[a][b][m][n] = (f32x4){0.f, 0.f, 0.f, 0.f};
    bf16x8 At[4][2], B0[2][2], B1[2][2];
    const char* cA = (const char*)g.A + (size_t)cur.pm * tstepA; const char* cB = (const char*)g.Bt + (size_t)cur.pn * tstepB;
    S.a_ready(cur);
    if constexpr (SP2) {
        PG8_STAGE(PG8_SB(0, 0), cB, voffB); PG8_STAGE(PG8_SB(0, 1), cB + hstepB, voffB); PG8_STAGE(PG8_SA(0, 0), cA, voffA); PG8_STAGE(PG8_SA(0, 1), cA + hstepA, voffA);
        if (wr == 1) PG8_BAR;
        PG8_WAIT_V(2); PG8_BAR;
        PG8_STAGE(PG8_SB(1, 0), cB + kstep, voffB); PG8_STAGE(PG8_SA(1, 0), cA + kstep, voffA); PG8_STAGE(PG8_SB(1, 1), cB + hstepB + kstep, voffB);
        PG8_WAIT_V(6); PG8_BAR;
    } else {
        PG8_STAGE(PG8_SB(0, 0), cB, voffB); PG8_STAGE(PG8_SA(0, 0), cA, voffA); PG8_STAGE(PG8_SB(0, 1), cB + hstepB, voffB); PG8_STAGE(PG8_SA(0, 1), cA + hstepA, voffA);
        if (wr == 1) PG8_BAR;
        PG8_WAIT_V(4); PG8_BAR;
        PG8_STAGE(PG8_SB(1, 0), cB + kstep, voffB); PG8_STAGE(PG8_SA(1, 0), cA + kstep, voffA); PG8_STAGE(PG8_SB(1, 1), cB + hstepB + kstep, voffB);
        PG8_WAIT_V(6); PG8_BAR;
    }
    for (;;) {
        const bool has_next = S.next(ui + 1, nxt);
        const char* nA = has_next ? (const char*)g.A + (size_t)nxt.pm * tstepA : cA; const char* nB = has_next ? (const char*)g.Bt + (size_t)nxt.pn * tstepB : cB;
        for (int t = 0; t < nt; t += 2) {
            const bool last = (t == nt - 2);
            const char* a1 = cA + (size_t)(t + 1) * kstep;
            const char* a2 = last ? nA : cA + (size_t)(t + 2) * kstep; const char* b2 = last ? nB : cB + (size_t)(t + 2) * kstep;
            const char* a3 = a2 + kstep; const char* b3 = b2 + kstep;
            if (last && has_next) S.a_ready(nxt);
            if constexpr (SP2) {
            PG8_LDB(B0, 0, 0); PG8_LDB(B1, 0, 1); PG8_SCHED; PG8_LDA(At, 0, 0); PG8_STAGE(PG8_SA(1, 1), a1 + hstepA, voffA);
            PG8_WAIT_V(8); PG8_WAIT_L(0); PG8_BAR; PG8_MMA(0, 0, At, B0); PG8_MMA(0, 1, At, B1); PG8_BAR; PG8_SCHED;
            PG8_LDA(At, 0, 1); PG8_STAGE(PG8_SB(0, 0), b2, voffB); PG8_STAGE(PG8_SB(0, 1), b2 + hstepB, voffB); PG8_STAGE(PG8_SA(0, 0), a2, voffA);
            PG8_WAIT_V(8); PG8_WAIT_L(0); PG8_BAR; PG8_MMA(1, 0, At, B0); PG8_MMA(1, 1, At, B1); PG8_BAR; PG8_SCHED;
            PG8_LDB(B0, 1, 0); PG8_LDB(B1, 1, 1); PG8_SCHED; PG8_LDA(At, 1, 0); PG8_STAGE(PG8_SA(0, 1), a2 + hstepA, voffA);
            PG8_WAIT_V(8); PG8_WAIT_L(0); PG8_BAR; PG8_MMA(0, 0, At, B0); PG8_MMA(0, 1, At, B1); PG8_BAR; PG8_SCHED;
            PG8_LDA(At, 1, 1); PG8_STAGE(PG8_SB(1, 0), b3, voffB); PG8_STAGE(PG8_SB(1, 1), b3 + hstepB, voffB); PG8_STAGE(PG8_SA(1, 0), a3, voffA);
            PG8_WAIT_V(8); PG8_WAIT_L(0); PG8_BAR; PG8_MMA(1, 0, At, B0); PG8_MMA(1, 1, At, B1); PG8_BAR; PG8_SCHED;
            } else {
            PG8_LDB(B0, 0, 0); PG8_SCHED; PG8_LDA(At, 0, 0); PG8_STAGE(PG8_SA(1, 1), a1 + hstepA, voffA);
            PG8_WAIT_L(8); PG8_BAR; PG8_WAIT_L(0); PG8_MMA(0, 0, At, B0); PG8_BAR; PG8_SCHED;
            PG8_LDB(B1, 0, 1); PG8_STAGE(PG8_SB(0, 0), b2, voffB);
            PG8_BAR; PG8_WAIT_L(0); PG8_MMA(0, 1, At, B1); PG8_BAR;
            PG8_LDA(At, 0, 1); PG8_STAGE(PG8_SA(0, 0), a2, voffA);
            PG8_BAR; PG8_WAIT_L(0); PG8_MMA(1, 0, At, B0); PG8_BAR; PG8_SCHED;
            PG8_STAGE(PG8_SB(0, 1), b2 + hstepB, voffB);
            PG8_WAIT_V(6); PG8_BAR; PG8_MMA(1, 1, At, B1); PG8_BAR;
            PG8_LDB(B0, 1, 0); PG8_SCHED; PG8_LDA(At, 1, 0); PG8_STAGE(PG8_SA(0, 1), a2 + hstepA, voffA);
            PG8_WAIT_L(8); PG8_BAR; PG8_WAIT_L(0); PG8_MMA(0, 0, At, B0); PG8_BAR; PG8_SCHED;
            PG8_LDB(B1, 1, 1); PG8_STAGE(PG8_SB(1, 0), b3, voffB);
            PG8_BAR; PG8_WAIT_L(0); PG8_MMA(0, 1, At, B1); PG8_BAR;
            PG8_LDA(At, 1, 1); PG8_STAGE(PG8_SA(1, 0), a3, voffA);
            PG8_BAR; PG8_WAIT_L(0); PG8_MMA(1, 0, At, B0); PG8_BAR; PG8_SCHED;
            PG8_STAGE(PG8_SB(1, 1), b3 + hstepB, voffB);
            PG8_WAIT_V(6); PG8_BAR; PG8_MMA(1, 1, At, B1); PG8_BAR;
            }
        }
        if constexpr (ALIGN_EPI) { if (wr == 0) PG8_BAR; }
        if constexpr (!Epi::AFTER_DRAIN) { E(acc, cur, wr, wc, fr, fq); S.done(cur); }
        if (!has_next) break;
#pragma unroll
        for (int a = 0; a < 2; ++a)
#pragma unroll
            for (int b = 0; b < 2; ++b)
#pragma unroll
                for (int m = 0; m < 4; ++m)
#pragma unroll
                    for (int n = 0; n < 2; ++n) acc[a][b][m][n] = (f32x4){0.f, 0.f, 0.f, 0.f};
        cur = nxt; cA = nA; cB = nB; ++ui;
        if constexpr (ALIGN_EPI) { if (wr == 1) PG8_BAR; }
    }
    PG8_WAIT_V(0);
    if constexpr (!ALIGN_EPI) { if (wr == 0) PG8_BAR; }
    PG8_BAR;
    if constexpr (Epi::AFTER_DRAIN) { E.fused(acc, cur, wr, wc, fr, fq, lds, wid, lane); S.done(cur); }
#undef PG8_SA
#undef PG8_SB
#undef PG8_STAGE
#undef PG8_LDA
#undef PG8_LDB
#undef PG8_MMA
#undef PG8_WAIT_V
#undef PG8_WAIT_L
#undef PG8_BAR
#undef PG8_SCHED
}
}
#define PG8_SP2 true
#define PG8_ALIGN true

#define GAS __attribute__((address_space(1)))
#define LAS __attribute__((address_space(3)))
typedef unsigned short bf16;
typedef unsigned v4u __attribute__((ext_vector_type(4)));
typedef unsigned v2u __attribute__((ext_vector_type(2)));
typedef float f32x4 __attribute__((ext_vector_type(4)));
typedef float f32x2 __attribute__((ext_vector_type(2)));
typedef short bf16x8 __attribute__((ext_vector_type(8)));
#define RLX_AGENT __ATOMIC_RELAXED, __HIP_MEMORY_SCOPE_AGENT

constexpr int NWAVES = 8, NTHR = 512;
constexpr int SEQ = 8192, DM = 1024, MROWS = 16384, NMETA = 16;
constexpr int NIN = 3080, NPROJ = 3072;
constexpr int CU_ = 0, CV_ = 512, CO_ = 1024, CQS = 1536, CKS = 2048, CVS = 2560;
constexpr int OU_ = 0, OV_ = 512, OI_ = 1536, OF_ = 1540, OKS = 2056, OVS = 2568;
constexpr float EPS = 1e-6f;
constexpr int NEXP = 16384;

constexpr size_t KiB = 1024, MiB = 1024 * 1024;
constexpr size_t WS_CTL = 0, CTL_ZERO_BYTES = 64 * KiB;
constexpr size_t WS_RSTD1 = 64 * KiB;
constexpr size_t WS_SSQ   = WS_RSTD1 + 64 * KiB;
constexpr size_t WS_GI    = WS_SSQ + 1 * MiB;
constexpr size_t WS_GF    = WS_GI + 256 * KiB;
constexpr size_t WS_BT    = WS_GF + 256 * KiB;
constexpr size_t WS_NU    = WS_BT + 256 * KiB;
constexpr size_t WS_NS    = WS_NU + 512 * KiB;
constexpr size_t WS_AC    = WS_NS + 512 * KiB;
constexpr size_t WS_BC    = WS_AC + 4 * KiB;
constexpr size_t WS_MIN   = WS_BC + 4 * KiB;
constexpr size_t WS_PRM   = WS_MIN + 4 * KiB;
constexpr size_t WS_KM    = WS_PRM + 196 * KiB;
constexpr size_t WS_WQMT  = WS_KM + 32 * KiB;
constexpr size_t WS_WKMT  = WS_WQMT + 128 * KiB;
constexpr size_t WS_SKB   = WS_WKMT + 128 * KiB;
constexpr size_t WS_RSTDM = WS_SKB + 64 * KiB;
constexpr size_t WS_RS2 = WS_RSTDM + 4 * KiB;
constexpr size_t WS_ESC = WS_RS2 + 64 * KiB;
constexpr size_t WS_SMALL_END = WS_ESC + 128 * KiB;
static_assert(WS_SMALL_END <= 4 * MiB, "small region");
constexpr size_t WS_WINT = 4 * MiB, WS_WOUTT = 10 * MiB, WS_WQT = 12 * MiB;
constexpr size_t WS_EU = 16 * MiB, WS_EV = 32 * MiB;
constexpr size_t WS_PR = 80 * MiB;
constexpr size_t WS_QP = WS_PR;
constexpr size_t WS_QK = 176 * MiB;
constexpr size_t WS_XB = WS_QK, WS_H1B = WS_QK;
constexpr size_t WS_U = 208 * MiB;
constexpr size_t WS_PRMP = WS_U, WS_TK = WS_U;
constexpr size_t WS_CB = 240 * MiB;
constexpr size_t WS_END = 256 * MiB;

constexpr int LDS_BYTES = 147456, LDSCTL_OFF = LDS_BYTES - 256;

__device__ __forceinline__ unsigned f2bf(float f) { unsigned u = __builtin_bit_cast(unsigned, f); return (u + 0x7fffu + ((u >> 16) & 1u)) >> 16; }
__device__ __forceinline__ unsigned pk2(float lo, float hi) { return f2bf(lo) | (f2bf(hi) << 16); }
__device__ __forceinline__ unsigned pk_fp8x4(f32x4 v) {
    const float a = fminf(fmaxf(v[0], -448.f), 448.f), b = fminf(fmaxf(v[1], -448.f), 448.f), c = fminf(fmaxf(v[2], -448.f), 448.f), d = fminf(fmaxf(v[3], -448.f), 448.f);
    int r = __builtin_amdgcn_cvt_pk_fp8_f32(a, b, 0, false); r = __builtin_amdgcn_cvt_pk_fp8_f32(c, d, r, true); return (unsigned)r; }
__device__ __forceinline__ unsigned pk_fp4x8(f32x4 a, f32x4 b) {
    unsigned r = 0u; r = __builtin_amdgcn_cvt_scalef32_pk_fp4_f32(r, a[0], a[1], 1.0f, 0); r = __builtin_amdgcn_cvt_scalef32_pk_fp4_f32(r, a[2], a[3], 1.0f, 1);
    r = __builtin_amdgcn_cvt_scalef32_pk_fp4_f32(r, b[0], b[1], 1.0f, 2); r = __builtin_amdgcn_cvt_scalef32_pk_fp4_f32(r, b[2], b[3], 1.0f, 3); return r; }
__device__ __forceinline__ float bf2f(unsigned h) { return __builtin_bit_cast(float, h << 16); }
template <int CTRL> __device__ __forceinline__ float dpp_f(float v) { return __builtin_bit_cast(float, __builtin_amdgcn_update_dpp(0, __builtin_bit_cast(int, v), CTRL, 0xf, 0xf, true)); }
__device__ __forceinline__ float rdl_f(float v, int l) { return __builtin_bit_cast(float, __builtin_amdgcn_readlane(__builtin_bit_cast(int, v), l)); }
__device__ __forceinline__ float wave_sum(float v) {
    v += dpp_f<0xB1>(v); v += dpp_f<0x4E>(v); v += dpp_f<0x124>(v); v += dpp_f<0x128>(v);
    return (rdl_f(v, 0) + rdl_f(v, 16)) + (rdl_f(v, 32) + rdl_f(v, 48));
}
__device__ __forceinline__ float wave_max(float v) {
    v = fmaxf(v, dpp_f<0xB1>(v)); v = fmaxf(v, dpp_f<0x4E>(v)); v = fmaxf(v, dpp_f<0x124>(v)); v = fmaxf(v, dpp_f<0x128>(v));
    return fmaxf(fmaxf(rdl_f(v, 0), rdl_f(v, 16)), fmaxf(rdl_f(v, 32), rdl_f(v, 48)));
}
__device__ __forceinline__ float row16_sum(float v) { v += dpp_f<0xB1>(v); v += dpp_f<0x4E>(v); v += dpp_f<0x124>(v); v += dpp_f<0x128>(v); return v; }
__device__ __forceinline__ float row16_min(float v) { v = fminf(v, dpp_f<0xB1>(v)); v = fminf(v, dpp_f<0x4E>(v)); v = fminf(v, dpp_f<0x124>(v)); v = fminf(v, dpp_f<0x128>(v)); return v; }
template <int CTRL> __device__ __forceinline__ float dpp_shr(float v, float idv) { return __builtin_bit_cast(float, __builtin_amdgcn_update_dpp(__builtin_bit_cast(int, idv), __builtin_bit_cast(int, v), CTRL, 0xf, 0xf, false)); }
__device__ __forceinline__ float wave_scan_sum(float v, int lane) {
    v += dpp_shr<0x111>(v, 0.f); v += dpp_shr<0x112>(v, 0.f); v += dpp_shr<0x114>(v, 0.f); v += dpp_shr<0x118>(v, 0.f);
    const float r0 = rdl_f(v, 15), r1 = rdl_f(v, 31), r2 = rdl_f(v, 47);
    return v + (lane < 16 ? 0.f : lane < 32 ? r0 : lane < 48 ? r0 + r1 : (r0 + r1) + r2);
}
__device__ __forceinline__ float wave_scan_max(float v, int lane) {
    const float NI = -3.0e38f;
    v = fmaxf(v, dpp_shr<0x111>(v, NI)); v = fmaxf(v, dpp_shr<0x112>(v, NI)); v = fmaxf(v, dpp_shr<0x114>(v, NI)); v = fmaxf(v, dpp_shr<0x118>(v, NI));
    const float r0 = rdl_f(v, 15), r1 = rdl_f(v, 31), r2 = rdl_f(v, 47);
    return fmaxf(v, lane < 16 ? NI : lane < 32 ? r0 : lane < 48 ? fmaxf(r0, r1) : fmaxf(fmaxf(r0, r1), r2));
}
__device__ __forceinline__ float logsigmoidf_(float a) { return fminf(a, 0.f) - log1pf(__expf(-fabsf(a))); }
__device__ __forceinline__ float siluf_(float a) { return a / (1.f + __expf(-a)); }
template <int KS> __device__ __forceinline__ f32x4 mma_rows(const LAS bf16* a, const LAS bf16* b, f32x4 acc) {
#pragma unroll
    for (int k = 0; k < KS; ++k) { const bf16x8 av = *(const LAS bf16x8*)(a + 32 * k), bv = *(const LAS bf16x8*)(b + 32 * k); acc = __builtin_amdgcn_mfma_f32_16x16x32_bf16(av, bv, acc, 0, 0, 0); }
    return acc;
}
#define XB_TMO      128
#define XB_XCNT(j)  (256  + 64 * (j))
#define XB_XSUB(j)  (1280 + 64 * (j))
#define XB_XGEN(j)  (2304 + 64 * (j))
#define XB_TOP      3328
#define XB_TOPGEN   3392
#define XCD_BAR_WORDS 3456
#define XB_SPIN_CAP (1u << 18)

__device__ __forceinline__ unsigned xb_ld(unsigned* p)              { return __hip_atomic_load(p, __ATOMIC_RELAXED, __HIP_MEMORY_SCOPE_AGENT); }
__device__ __forceinline__ unsigned xb_add(unsigned* p, unsigned v) { return __hip_atomic_fetch_add(p, v, __ATOMIC_RELAXED, __HIP_MEMORY_SCOPE_AGENT); }
__device__ __forceinline__ unsigned xb_xcc_id() { return (unsigned)__builtin_amdgcn_s_getreg((3 << 11) | 20) & 0xFu; }
#define XB_SPIN(cond, bar) do { unsigned _sp = 0; while (cond) { __builtin_amdgcn_s_sleep(1); \
    if ((++_sp & 255u) == 0u) { if (xb_ld(&(bar)[XB_TMO])) break; if (_sp > XB_SPIN_CAP) { atomicAdd(&(bar)[XB_TMO], 1u); break; } } } } while (0)

struct XcdBarrier {
    unsigned* bar; unsigned x;
    volatile LAS unsigned* st;
};

__device__ __forceinline__ XcdBarrier xcd_barrier_post(unsigned* bar, volatile LAS unsigned* st) {
    XcdBarrier b; b.bar = bar; b.x = xb_xcc_id(); b.st = st;
    if (threadIdx.x == 0) (void)xb_add(&bar[XB_XCNT(b.x)], 1u);
    return b;
}
__device__ __forceinline__ void xcd_barrier_complete(unsigned* bar, unsigned x, unsigned& nloc, unsigned& nx) {
    const unsigned G = gridDim.x * gridDim.y * gridDim.z;
    unsigned sum, cnt, mine, sp = 0u;
    for (;;) {
        sum = 0u; cnt = 0u; mine = 0u;
#pragma unroll
        for (unsigned j = 0; j < 16; ++j) { const unsigned c = xb_ld(&bar[XB_XCNT(j)]); sum += c; cnt += (c > 0u) ? 1u : 0u; mine = (j == x) ? c : mine; }
        if (sum == G) break;
        __builtin_amdgcn_s_sleep(1);
        if ((++sp & 255u) == 0u) { if (xb_ld(&bar[XB_TMO])) break; if (sp > XB_SPIN_CAP) { atomicAdd(&bar[XB_TMO], 1u); break; } }
    }
    nloc = mine > 0u ? mine : 1u; nx = cnt > 0u ? cnt : 1u;
}

__device__ __forceinline__ void xcd_barrier(const XcdBarrier& b) {
    asm volatile("s_waitcnt vmcnt(0)" ::: "memory");
    __syncthreads();
    if (threadIdx.x == 0) {
        unsigned* bar = b.bar;
        __builtin_amdgcn_s_waitcnt(0);
        unsigned nloc = b.st[0], nx = b.st[1];
        if (nloc == 0u) { xcd_barrier_complete(bar, b.x, nloc, nx); b.st[0] = nloc; b.st[1] = nx; }
        const unsigned old = xb_add(&bar[XB_XSUB(b.x)], 1u);
        const unsigned gen = old / nloc;
        if (old + 1u == (gen + 1u) * nloc) {
            __builtin_amdgcn_fence(__ATOMIC_RELEASE, "agent");
            asm volatile("s_waitcnt vmcnt(0)" ::: "memory");
            const unsigned og = xb_add(&bar[XB_TOP], 1u);
            const unsigned tg = og / nx;
            if (og + 1u == (tg + 1u) * nx) xb_add(&bar[XB_TOPGEN], 1u);
            else XB_SPIN(xb_ld(&bar[XB_TOPGEN]) == tg, bar);
            __builtin_amdgcn_fence(__ATOMIC_ACQUIRE, "agent");
            xb_add(&bar[XB_XGEN(b.x)], 1u);
            asm volatile("s_waitcnt vmcnt(0)" ::: "memory");
        } else {
            XB_SPIN(xb_ld(&bar[XB_XGEN(b.x)]) == gen, bar);
            __builtin_amdgcn_fence(__ATOMIC_ACQUIRE, "agent");
            asm volatile("s_waitcnt vmcnt(0)" ::: "memory");
        }
    }
    __syncthreads();
}

struct Params { const float* in[20]; float* out; unsigned char* ws; };
struct Frame {
    LAS unsigned char* lds;
    int tid, lane, wave, vcu, G;
    const float *x, *meta, *g_mix, *w_in, *conv_w, *conv_b, *w_qm, *w_km, *b_i, *b_f, *skip, *gn_g, *sb_g, *w_out, *g_ffn, *w_query, *sub_keys, *eu, *ev, *g_fin;
    float* out; unsigned char* ws;
};
#define WSP(T, off) ((T*)(F.ws + (off)))

__device__ __forceinline__ void p0_transpose_item(const float* W, int ldw, int k0, int srccol0, bf16* WT, int K, int dstrow0, const float* gk, float cs, LAS float* scr, int lane, const float* META, float* PRMP) {
#pragma unroll 8
    for (int i = 0; i < 32; ++i) { const int kk = 2 * i + (lane >> 5); const float sc = gk ? gk[k0 + kk] * cs : cs; scr[kk * 33 + (lane & 31)] = W[(size_t)(k0 + kk) * ldw + srccol0 + (lane & 31)] * sc; }
    if (META) { LAS float* mb = scr + 64 * 33;
#pragma unroll
        for (int i = 0; i < 16; ++i) mb[i * 64 + lane] = META[(size_t)i * DM + k0 + lane]; }
    const int c = lane & 7;
#pragma unroll
    for (int j = 0; j < 4; ++j) { const int n = (lane >> 3) + 8 * j; const LAS float* s = scr + (8 * c) * 33 + n;
        v4u o; o.x = pk2(s[0 * 33], s[1 * 33]); o.y = pk2(s[2 * 33], s[3 * 33]); o.z = pk2(s[4 * 33], s[5 * 33]); o.w = pk2(s[6 * 33], s[7 * 33]);
        *(v4u*)(WT + (size_t)(dstrow0 + n) * K + k0 + 8 * c) = o; }
    if (META) { const LAS float* mb = scr + 64 * 33; const int n = lane & 31, r0 = (lane >> 5) * 8; float acc[8];
#pragma unroll
        for (int r = 0; r < 8; ++r) acc[r] = 0.f;
#pragma unroll 4
        for (int kk = 0; kk < 64; kk += 4) { const float w0 = scr[kk * 33 + n], w1 = scr[(kk + 1) * 33 + n], w2 = scr[(kk + 2) * 33 + n], w3 = scr[(kk + 3) * 33 + n];
#pragma unroll
            for (int r = 0; r < 8; ++r) { const f32x4 m = *(const LAS f32x4*)(mb + (r0 + r) * 64 + kk); acc[r] += (m[0] * w0 + m[1] * w1) + (m[2] * w2 + m[3] * w3); } }
#pragma unroll
        for (int r = 0; r < 8; ++r) PRMP[((size_t)(k0 >> 6) * 16 + r0 + r) * NIN + srccol0 + n] = acc[r]; }
}

__device__ __forceinline__ void p0_pack_row_i4(Frame& F, f32x4 (&a)[4], const f32x4 (&gf)[4], int r, int lane) {
    const bool isu = r < NEXP; float ss = 0.f;
#pragma unroll
    for (int j = 0; j < 4; ++j) { if (isu) a[j] = a[j] * gf[j]; ss += (a[j][0] * a[j][0] + a[j][1] * a[j][1]) + (a[j][2] * a[j][2] + a[j][3] * a[j][3]); }
    ss = wave_sum(ss);
    const float rms = sqrtf(ss * (1.0f / DM)); const float step = rms > 0.f ? 0.3125f * rms : 1.0f, inv = 1.0f / step;
    v2u o;
#pragma unroll
    for (int d = 0; d < 2; ++d) { unsigned w = 0u;
#pragma unroll
        for (int n = 0; n < 8; ++n) { const int i = 8 * d + n; const float q = floorf(a[i >> 2][i & 3] * inv); const int k = (int)fminf(fmaxf(q, -8.f), 7.f); w |= ((unsigned)k & 0xfu) << (4 * n); }
        o[d] = w; }
    *((v2u*)(F.ws + (isu ? WS_EU : WS_EV) + (size_t)(r & (NEXP - 1)) * (DM / 2)) + lane) = o;
    if (lane == 0) WSP(float, WS_ESC)[r] = step;
}

__device__ __forceinline__ void p0_prologue(Frame& F) {
    LAS float* scr = (LAS float*)(F.lds + 32768 + F.wave * 14336);
    LAS float* wg = (LAS float*)F.lds;
    const int gw = F.vcu * NWAVES + F.wave, NGW = F.G * NWAVES, lane = F.lane;
    for (int i = F.tid; i < 8192; i += NTHR) { const int jj = i >> 10, k = i & 1023; wg[i] = F.w_in[(size_t)k * NIN + OI_ + jj] * F.g_mix[k]; }
    {
        constexpr int I_IN = 16 * 96, I_OUT = 16 * 32, I_Q = 16 * 64, I_M = 2 * 4;
        constexpr int NITEMS = I_IN + I_OUT + I_Q + 8 * I_M;
        for (int it = gw; it < NITEMS; it += NGW) {
            int r = it;
            if (r < I_IN) { const int kb = r / 96, nb = r % 96; const int n0 = 32 * nb; p0_transpose_item(F.w_in, NIN, 64 * kb, n0 + (n0 >= 1536 ? 8 : 0), WSP(bf16, WS_WINT), DM, n0, F.g_mix, 1.f, scr, lane, F.meta, WSP(float, WS_PRMP)); continue; } r -= I_IN;
            if (r < I_OUT) { const int kb = r / 32, nb = r % 32; p0_transpose_item(F.w_out, DM, 64 * kb, 32 * nb, WSP(bf16, WS_WOUTT), DM, 32 * nb, nullptr, 1.f, scr, lane, nullptr, nullptr); continue; } r -= I_OUT;
            if (r < I_Q) { const int kb = r / 64, nb = r % 64; p0_transpose_item(F.w_query, 2048, 64 * kb, 32 * nb, WSP(bf16, WS_WQT), DM, 32 * nb, F.g_ffn, 1.f, scr, lane, nullptr, nullptr); continue; } r -= I_Q;
            { const int mat = r / I_M, q = r % I_M, kb = q / 4, nb = q % 4, h = mat & 3;
              const float* W = (mat < 4 ? F.w_qm : F.w_km) + (size_t)h * 16384; bf16* WT = WSP(bf16, mat < 4 ? WS_WQMT : WS_WKMT) + (size_t)h * 16384;
              p0_transpose_item(W, 128, 64 * kb, 32 * nb, WT, 128, 32 * nb, nullptr, mat < 4 ? 1.f : 0.08838834764831845f, scr, lane, nullptr, nullptr); }
        }
        for (int i = gw * 64 + lane; i < 32768 / 4; i += NGW * 64) { const f32x4 v = ((const f32x4*)F.sub_keys)[i]; v2u o; o.x = pk2(v[0], v[1]); o.y = pk2(v[2], v[3]); ((v2u*)WSP(bf16, WS_SKB))[i] = o; }
    }
    __syncthreads();
    {
        float bi[4], bfv[4];
#pragma unroll
        for (int j = 0; j < 4; ++j) { bi[j] = F.b_i[j]; bfv[j] = F.b_f[j]; }
        f32x4 v[4], vn[4];
        { const f32x4* xr = (const f32x4*)(F.x + (size_t)gw * DM) + lane;
#pragma unroll
          for (int j = 0; j < 4; ++j) v[j] = xr[64 * j]; }
        for (int m = gw; m < MROWS + NMETA; m += NGW) {
            const int mn = m + NGW;
            if (mn < MROWS + NMETA) { const f32x4* xr = (const f32x4*)(mn < MROWS ? F.x + (size_t)mn * DM : F.meta + (size_t)(mn - MROWS) * DM) + lane;
#pragma unroll
                for (int j = 0; j < 4; ++j) vn[j] = xr[64 * j]; }
            float ss = 0.f; float g8[8];
#pragma unroll
            for (int jj = 0; jj < 8; ++jj) g8[jj] = 0.f;
#pragma unroll
            for (int j = 0; j < 4; ++j) ss += (v[j][0] * v[j][0] + v[j][1] * v[j][1]) + (v[j][2] * v[j][2] + v[j][3] * v[j][3]);
#pragma unroll
            for (int j = 0; j < 4; ++j)
#pragma unroll
                for (int jj = 0; jj < 8; ++jj) { const f32x4 w = *(const LAS f32x4*)(wg + jj * 1024 + 256 * j + 4 * lane); g8[jj] += (v[j][0] * w[0] + v[j][1] * w[1]) + (v[j][2] * w[2] + v[j][3] * w[3]); }
            ss = wave_sum(ss);
#pragma unroll
            for (int jj = 0; jj < 8; ++jj) g8[jj] = wave_sum(g8[jj]);
            const float rstd = 1.0f / sqrtf(ss * (1.0f / DM) + EPS);
            if (m < MROWS) {
                v2u* o8 = (v2u*)(WSP(bf16, WS_XB) + (size_t)m * DM) + lane;
#pragma unroll
                for (int j = 0; j < 4; ++j) { v2u o; o.x = pk2(v[j][0], v[j][1]); o.y = pk2(v[j][2], v[j][3]); o8[64 * j] = o; }
                if (lane == 0) WSP(float, WS_RSTD1)[m] = rstd;
#pragma unroll
                for (int jj = 0; jj < 4; ++jj) if (lane == jj) { WSP(float, WS_GI)[m * 4 + jj] = g8[jj] * rstd + bi[jj]; WSP(float, WS_GF)[m * 4 + jj] = logsigmoidf_(g8[4 + jj] * rstd + bfv[jj]); }
            } else {
                const int r = m - MROWS;
                if (lane == 0) WSP(float, WS_RSTDM)[r] = rstd;
#pragma unroll
                for (int jj = 0; jj < 8; ++jj) if (lane == jj) WSP(float, WS_PRM)[(size_t)r * NIN + OI_ + jj] = g8[jj] * rstd;
            }
#pragma unroll
            for (int j = 0; j < 4; ++j) v[j] = vn[j];
        }
    }
    {
        f32x4 gf[4];
#pragma unroll
        for (int j = 0; j < 4; ++j) gf[j] = ((const f32x4*)F.g_ffn)[lane + 64 * j];
        for (int r = gw; r < 2 * NEXP; r += 2 * NGW) {
            const int r2 = r + NGW; const bool has2 = r2 < 2 * NEXP;
            const f32x4* s1 = (const f32x4*)((r >= NEXP ? F.ev : F.eu) + (size_t)(r & (NEXP - 1)) * DM) + lane;
            const f32x4* s2 = (const f32x4*)((r2 >= NEXP ? F.ev : F.eu) + (size_t)(r2 & (NEXP - 1)) * DM) + lane;
            f32x4 a[4], b[4];
#pragma unroll
            for (int j = 0; j < 4; ++j) { a[j] = s1[64 * j]; if (has2) b[j] = s2[64 * j]; }
            if (r < NEXP) p0_pack_row_i4(F, a, gf, r, lane);
            else { v2u o; o[0] = pk_fp4x8(a[0] * 4.0f, a[1] * 4.0f); o[1] = pk_fp4x8(a[2] * 4.0f, a[3] * 4.0f); *((v2u*)(F.ws + WS_EV + (size_t)(r - NEXP) * (DM / 2)) + lane) = o; }
            if (has2) { if (r2 < NEXP) p0_pack_row_i4(F, b, gf, r2, lane);
                else { v2u o; o[0] = pk_fp4x8(b[0] * 4.0f, b[1] * 4.0f); o[1] = pk_fp4x8(b[2] * 4.0f, b[3] * 4.0f); *((v2u*)(F.ws + WS_EV + (size_t)(r2 - NEXP) * (DM / 2)) + lane) = o; } }
        }
    }
}

__device__ __forceinline__ void p1_meta_tail(Frame& F) {
    const float* P = WSP(float, WS_PRMP); int tid_ = F.tid; asm volatile("" : "+v"(tid_)); const int tid = tid_;
    const int nrounds = (96 + F.G - 1) / F.G;
    for (int rnd = 0; rnd < nrounds; ++rnd) { const int item = F.vcu + rnd * F.G; if (item >= 96) break;
        if (item < 64) {
            const int h = item >> 4, t = item & 15;
            LAS float* um = (LAS float*)F.lds; LAS float* cm = um + 512; LAS float* part = cm + 128;
            __syncthreads();
            { const int j = tid >> 7, ch = tid & 127, tt = t - 3 + j; float s = 0.f;
              if (tt >= 0) {
#pragma unroll 4
                  for (int kp = 0; kp < 16; ++kp) s += P[(size_t)(kp * 16 + tt) * NIN + OU_ + h * 128 + ch];
                  s *= WSP(float, WS_RSTDM)[tt]; }
              um[j * 128 + ch] = s; }
            __syncthreads();
            if (tid < 128) { const int c = h * 128 + tid; float s = F.conv_b[c];
#pragma unroll
                for (int j = 0; j < 4; ++j) { if (t - 3 + j >= 0) s += F.conv_w[j * 512 + c] * um[j * 128 + tid]; }
                cm[tid] = siluf_(s); }
            __syncthreads();
            { const int e = tid & 127, dp = tid >> 7; float s = 0.f;
#pragma unroll 4
              for (int d = 32 * dp; d < 32 * dp + 32; ++d) s += cm[d] * F.w_km[(size_t)h * 16384 + d * 128 + e];
              part[dp * 128 + e] = s; }
            __syncthreads();
            if (tid < 128) WSP(float, WS_KM)[(h * 16 + t) * 128 + tid] = ((part[tid] + part[128 + tid]) + (part[256 + tid] + part[384 + tid])) * 0.08838834764831845f;
        } else {
            const int part = item - 64, per = 16 * NIN / 32;
            for (int i = part * per + tid; i < (part + 1) * per; i += NTHR) { const int r = i / NIN, n = i - r * NIN; if (n >= OI_ && n < OI_ + 8) continue; float s = 0.f;
#pragma unroll 4
                for (int kp = 0; kp < 16; ++kp) s += P[(size_t)kp * 16 * NIN + i];
                WSP(float, WS_PRM)[i] = s * WSP(float, WS_RSTDM)[r]; }
        }
    }
    __syncthreads();
}

constexpr int L2_WQ = 0, L2_WK = 34816, L2_C = 69632, L2_KT = 87040, L2_WV = 105472, L2_U = 123904, L2_TAB = 141056;
__device__ __forceinline__ void p2_mlstm_local(Frame& F) {
    const int bh = F.vcu >> 5, b = bh >> 2, h = bh & 3, tid = F.tid, lane = F.lane, wave = F.wave, g = lane >> 4, l15 = lane & 15;
    LAS bf16* WQ = (LAS bf16*)(F.lds + L2_WQ); LAS bf16* WK = (LAS bf16*)(F.lds + L2_WK); LAS bf16* Cs = (LAS bf16*)(F.lds + L2_C);
    LAS bf16* KT = (LAS bf16*)(F.lds + L2_KT); LAS bf16* WV = (LAS bf16*)(F.lds + L2_WV); LAS bf16* Us = (LAS bf16*)(F.lds + L2_U);
    LAS float* TAB = (LAS float*)(F.lds + L2_TAB);
    const bf16* PR = WSP(bf16, WS_PR); const float* PRM = WSP(float, WS_PRM);
    for (int i = tid; i < 2048; i += NTHR) { const int e = i >> 4, c8 = (i & 15) * 8;
        *(LAS v4u*)(WQ + e * 136 + c8) = *(const v4u*)(WSP(bf16, WS_WQMT) + (size_t)h * 16384 + e * 128 + c8);
        *(LAS v4u*)(WK + e * 136 + c8) = *(const v4u*)(WSP(bf16, WS_WKMT) + (size_t)h * 16384 + e * 128 + c8); }
    v4u ur[3], vr[2]; float gli = 0.f, glf = 0.f;
#define P2_FETCH_U(chunkx) do { const int _m0 = b * SEQ + (chunkx) * 64; _Pragma("unroll") for (int _k = 0; _k < 3; ++_k) { const int _i = tid + NTHR * _k; if (_i < 67 * 16) { const int _rr = _i >> 4, _c8 = (_i & 15) * 8, _t = _rr - 3; \
            if ((chunkx) == 0 && _t < 0) { const float* _s = PRM + (size_t)(NMETA + _t) * NIN + OU_ + h * 128 + _c8; ur[_k].x = pk2(_s[0], _s[1]); ur[_k].y = pk2(_s[2], _s[3]); ur[_k].z = pk2(_s[4], _s[5]); ur[_k].w = pk2(_s[6], _s[7]); } \
            else ur[_k] = *(const v4u*)(PR + (size_t)(_m0 + _t) * NPROJ + CU_ + h * 128 + _c8); } } \
        if (tid < 64) { gli = WSP(float, WS_GI)[(_m0 + tid) * 4 + h]; glf = WSP(float, WS_GF)[(_m0 + tid) * 4 + h]; } } while (0)
#define P2_FETCH_V(chunkx) do { const int _m0 = b * SEQ + (chunkx) * 64; _Pragma("unroll") for (int _k = 0; _k < 2; ++_k) { const int _i = tid + NTHR * _k; vr[_k] = *(const v4u*)(PR + (size_t)(_m0 + (_i >> 4)) * NPROJ + CV_ + h * 128 + (_i & 15) * 8); } } while (0)
    P2_FETCH_U(F.vcu & 31); P2_FETCH_V(F.vcu & 31);
    for (int ui = 0; ui < 4; ++ui) {
        const int chunk = (F.vcu & 31) + 32 * ui; const int m0 = b * SEQ + chunk * 64;
        __syncthreads();
#pragma unroll
        for (int k = 0; k < 3; ++k) { const int i = tid + NTHR * k; if (i < 67 * 16) *(LAS v4u*)(Us + (i >> 4) * 128 + (i & 15) * 8) = ur[k]; }
        if (tid < 64) { TAB[tid] = gli; TAB[64 + tid] = glf; }
        if (ui + 1 < 4) P2_FETCH_U(chunk + 32);
        __syncthreads();
        { const int ch = tid & 127, c = h * 128 + ch; const float w0 = F.conv_w[c], w1 = F.conv_w[512 + c], w2 = F.conv_w[1024 + c], w3 = F.conv_w[1536 + c], cb = F.conv_b[c];
#pragma unroll 4
          for (int jj = 0; jj < 16; ++jj) { const int t = (tid >> 7) + 4 * jj;
              const float s = cb + w0 * bf2f(Us[t * 128 + ch]) + w1 * bf2f(Us[(t + 1) * 128 + ch]) + w2 * bf2f(Us[(t + 2) * 128 + ch]) + w3 * bf2f(Us[(t + 3) * 128 + ch]);
              const unsigned cv = f2bf(siluf_(s)); Cs[t * 136 + ch] = (bf16)cv; } }
        if (wave == 0) {
            const float li = TAB[lane], lf = TAB[64 + lane]; float bs = lf;
            bs = wave_scan_sum(bs, lane);
            const float bL = rdl_f(bs, 63); const float gg = bL - bs + li; const float Bc = wave_max(gg);
            TAB[128 + lane] = bs; TAB[192 + lane] = __expf(gg - Bc);
            WSP(float, WS_BT)[(m0 + lane) * 4 + h] = bs;
            if (lane == 0) { WSP(float, WS_AC)[bh * 128 + chunk] = bL; WSP(float, WS_BC)[bh * 128 + chunk] = Bc; }
        }
        __syncthreads();
        {
            bf16* Qg = WSP(bf16, WS_QK); bf16* Kg = Qg + (size_t)MROWS * 512;
#pragma unroll
            for (int tt = 0; tt < 4; ++tt) {
                f32x4 aq = {0.f, 0.f, 0.f, 0.f}, ak = {0.f, 0.f, 0.f, 0.f};
                aq = mma_rows<4>(WQ + (16 * wave + l15) * 136 + 8 * g, Cs + (16 * tt + l15) * 136 + 8 * g, aq);
                ak = mma_rows<4>(WK + (16 * wave + l15) * 136 + 8 * g, Cs + (16 * tt + l15) * 136 + 8 * g, ak);
                const int t = 16 * tt + l15, e0 = 16 * wave + 4 * g; const size_t go = (size_t)(m0 + t) * 512 + h * 128 + e0;
                v2u oq; oq.x = pk2(aq[0], aq[1]); oq.y = pk2(aq[2], aq[3]); *(v2u*)(Qg + go) = oq;
                v2u ok; ok.x = pk2(ak[0], ak[1]); ok.y = pk2(ak[2], ak[3]); *(v2u*)(Kg + go) = ok;
                KT[(e0 + 0) * 72 + t] = (bf16)(ok.x & 0xffffu); KT[(e0 + 1) * 72 + t] = (bf16)(ok.x >> 16); KT[(e0 + 2) * 72 + t] = (bf16)(ok.y & 0xffffu); KT[(e0 + 3) * 72 + t] = (bf16)(ok.y >> 16);
            }
            for (int i = tid; i < 1024; i += NTHR) { const int t = i >> 4, c8 = (i & 15) * 8; *(v4u*)(WSP(bf16, WS_CB) + (size_t)(m0 + t) * 512 + h * 128 + c8) = *(const LAS v4u*)(Cs + t * 136 + c8); }
#pragma unroll
            for (int k = 0; k < 2; ++k) { const int i = tid + NTHR * k; const int s = i >> 4, e8 = (i & 15) * 8; const v4u pv = vr[k]; const float w = TAB[192 + s];
#pragma unroll
                for (int q = 0; q < 4; ++q) { WV[(e8 + 2 * q) * 72 + s] = (bf16)f2bf(bf2f(pv[q] & 0xffffu) * w); WV[(e8 + 2 * q + 1) * 72 + s] = (bf16)f2bf(__uint_as_float(pv[q] & 0xffff0000u) * w); } }
            if (ui + 1 < 4) P2_FETCH_V(chunk + 32);
        }
        __syncthreads();
        {
            bf16* Ug = WSP(bf16, WS_U) + (size_t)(bh * 128 + chunk) * 16384;
#pragma unroll
            for (int et = 0; et < 8; ++et) { f32x4 a = {0.f, 0.f, 0.f, 0.f};
                a = mma_rows<2>(KT + (16 * wave + l15) * 72 + 8 * g, WV + (16 * et + l15) * 72 + 8 * g, a);
                v2u o; o.x = pk2(a[0], a[1]); o.y = pk2(a[2], a[3]); *(v2u*)(Ug + (size_t)(16 * et + l15) * 128 + 16 * wave + 4 * g) = o; }
            if (tid < 128) { float s = 0.f; for (int t = 0; t < 64; ++t) s += bf2f(KT[tid * 72 + t]) * TAB[192 + t]; WSP(float, WS_NU)[(size_t)(bh * 128 + chunk) * 128 + tid] = s; }
        }
    }
#undef P2_FETCH_U
#undef P2_FETCH_V
    __syncthreads();
}

constexpr int L3_K = 0, L3_VT = 9216, L3_MIN = 18432;
__device__ __forceinline__ void p2_sb_attention(Frame& F) {
    const int tid = F.tid, lane = F.lane, wave = F.wave, g = lane >> 4, l15 = lane & 15;
    LAS bf16* Ks = (LAS bf16*)(F.lds + L3_K); LAS bf16* VT = (LAS bf16*)(F.lds + L3_VT); LAS float* MINR = (LAS float*)(F.lds + L3_MIN);
    bf16* PR = WSP(bf16, WS_PR); const float* PRM = WSP(float, WS_PRM);
    const int bhd = F.vcu >> 4, b = bhd >> 3, hd = bhd & 7;
    for (int ui = 0; ui < 4; ++ui) {
        const int qb = (F.vcu & 15) + 16 * ui;
        const int tq = 128 * qb + 16 * wave + l15;
        const size_t qrow = (size_t)(b * SEQ + tq) * NPROJ;
        const bf16x8 q0 = *(const bf16x8*)(PR + qrow + CQS + hd * 64 + 8 * g), q1 = *(const bf16x8*)(PR + qrow + CQS + hd * 64 + 32 + 8 * g);
        f32x4 o[4];
#pragma unroll
        for (int i = 0; i < 4; ++i) o[i] = (f32x4){0.f, 0.f, 0.f, 0.f};
        float R = 0.f;
        const int kr = tid >> 3, c8 = (tid & 7) * 8;
        v4u kn, vn;
#define SB_FETCH(jbx) do { if ((jbx) >= 0) { const size_t _ro = (size_t)(b * SEQ + 64 * (jbx) + kr) * NPROJ + hd * 64 + c8; kn = *(const v4u*)(PR + _ro + CKS); vn = *(const v4u*)(PR + _ro + CVS); } \
            else if (kr < NMETA) { const float* _sk = PRM + (size_t)kr * NIN + OKS + hd * 64 + c8; const float* _sv = PRM + (size_t)kr * NIN + OVS + hd * 64 + c8; \
                kn.x = pk2(_sk[0], _sk[1]); kn.y = pk2(_sk[2], _sk[3]); kn.z = pk2(_sk[4], _sk[5]); kn.w = pk2(_sk[6], _sk[7]); vn.x = pk2(_sv[0], _sv[1]); vn.y = pk2(_sv[2], _sv[3]); vn.z = pk2(_sv[4], _sv[5]); vn.w = pk2(_sv[6], _sv[7]); } \
            else { kn = (v4u){0u, 0u, 0u, 0u}; vn = kn; } } while (0)
        SB_FETCH(2 * qb + 1);
        for (int jb = 2 * qb + 1; jb >= -1; --jb) {
            __syncthreads();
            if (jb < 2 * qb + 1) { float mn = MINR[0];
#pragma unroll
                for (int w = 1; w < 8; ++w) mn = fminf(mn, MINR[w]);
                if (mn >= 90.f) break; }
            { const v4u kv = kn, vv = vn;
              *(LAS v4u*)(Ks + kr * 72 + c8) = kv;
              VT[(c8 + 0) * 72 + kr] = (bf16)(vv.x & 0xffffu); VT[(c8 + 1) * 72 + kr] = (bf16)(vv.x >> 16); VT[(c8 + 2) * 72 + kr] = (bf16)(vv.y & 0xffffu); VT[(c8 + 3) * 72 + kr] = (bf16)(vv.y >> 16);
              VT[(c8 + 4) * 72 + kr] = (bf16)(vv.z & 0xffffu); VT[(c8 + 5) * 72 + kr] = (bf16)(vv.z >> 16); VT[(c8 + 6) * 72 + kr] = (bf16)(vv.w & 0xffffu); VT[(c8 + 7) * 72 + kr] = (bf16)(vv.w >> 16); }
            if (jb > -1) SB_FETCH(jb - 1);
            __syncthreads();
            if (jb == 2 * qb + 1 && wave < 4) { if (lane == 0) MINR[wave] = 0.f; continue; }
            float z[16];
#pragma unroll
            for (int i = 0; i < 4; ++i) { const LAS bf16* kp = Ks + (16 * (l15 >> 2) + 4 * i + (l15 & 3)) * 72 + 8 * g;
                f32x4 a = {0.f, 0.f, 0.f, 0.f};
                a = __builtin_amdgcn_mfma_f32_16x16x32_bf16(*(const LAS bf16x8*)kp, q0, a, 0, 0, 0);
                a = __builtin_amdgcn_mfma_f32_16x16x32_bf16(*(const LAS bf16x8*)(kp + 32), q1, a, 0, 0, 0);
                z[4 * i + 0] = a[0] * 0.125f; z[4 * i + 1] = a[1] * 0.125f; z[4 * i + 2] = a[2] * 0.125f; z[4 * i + 3] = a[3] * 0.125f; }
            const int kbase = (jb >= 0) ? 64 * jb + 16 * g : 16 * g;
            float cum[16]; float run = 0.f;
#pragma unroll
            for (int n = 15; n >= 0; --n) { const bool ok = (jb >= 0) ? (kbase + n < tq) : (kbase + n < NMETA);
                const float zz = z[n]; const float sp = fmaxf(zz, 0.f) + __logf(1.f + __expf(-fabsf(zz)));
                run += ok ? sp : 0.f; cum[n] = run; }
            const float t1 = __shfl(run, (lane + 16) & 63), t2 = __shfl(run, (lane + 32) & 63), t3 = __shfl(run, (lane + 48) & 63);
            const float higher = (g < 3 ? t1 : 0.f) + (g < 2 ? t2 : 0.f) + (g < 1 ? t3 : 0.f);
            const float lower = (g >= 1 ? t3 : 0.f) + (g >= 2 ? t2 : 0.f) + (g >= 3 ? t1 : 0.f);
            const float base = R + higher;
            float av[16];
#pragma unroll
            for (int n = 0; n < 16; ++n) { const bool ok = (jb >= 0) ? (kbase + n < tq) : (kbase + n < NMETA); av[n] = ok ? __expf(z[n] - (base + cum[n])) : 0.f; }
            R += run + higher + lower;
#pragma unroll
            for (int ks = 0; ks < 2; ++ks) { v4u bw; bw.x = pk2(av[8 * ks + 0], av[8 * ks + 1]); bw.y = pk2(av[8 * ks + 2], av[8 * ks + 3]); bw.z = pk2(av[8 * ks + 4], av[8 * ks + 5]); bw.w = pk2(av[8 * ks + 6], av[8 * ks + 7]);
                const bf16x8 bfr = __builtin_bit_cast(bf16x8, bw);
#pragma unroll
                for (int et = 0; et < 4; ++et) { const bf16x8 afr = *(const LAS bf16x8*)(VT + (16 * et + l15) * 72 + 16 * g + 8 * ks); o[et] = __builtin_amdgcn_mfma_f32_16x16x32_bf16(afr, bfr, o[et], 0, 0, 0); } }
            const float rm = row16_min(R);
            if (lane == 0) MINR[wave] = rm;
        }
        float ss = 0.f;
#pragma unroll
        for (int et = 0; et < 4; ++et) ss += (o[et][0] * o[et][0] + o[et][1] * o[et][1]) + (o[et][2] * o[et][2] + o[et][3] * o[et][3]);
        ss += __shfl_xor(ss, 16); ss += __shfl_xor(ss, 32);
        const float rstd = 1.0f / sqrtf(ss * (1.0f / 64.0f) + EPS);
#pragma unroll
        for (int et = 0; et < 4; ++et) { const int e = 16 * et + 4 * g; const f32x4 gg = *(const f32x4*)(F.sb_g + hd * 64 + e);
            v2u w; w.x = pk2(o[et][0] * rstd * gg[0], o[et][1] * rstd * gg[1]); w.y = pk2(o[et][2] * rstd * gg[2], o[et][3] * rstd * gg[3]);
            *(v2u*)(PR + qrow + CQS + hd * 64 + e) = w; }
    }
#undef SB_FETCH
    __syncthreads();
}

__device__ __forceinline__ void p3_scan(Frame& F) {
    const int bh = F.vcu >> 5, h = bh & 3, tid = F.tid, lane = F.lane;
    LAS float* DEC = (LAS float*)F.lds; LAS float* SCL = DEC + 128; LAS float* WM = DEC + 256;
    const float* PRM = WSP(float, WS_PRM);
    __syncthreads();
    if (F.wave == 0) {
        float li = -INFINITY, lf = 0.f;
        if (lane < NMETA) { li = PRM[(size_t)lane * NIN + OI_ + h] + F.b_i[h]; lf = logsigmoidf_(PRM[(size_t)lane * NIN + OF_ + h] + F.b_f[h]); }
        float bs = lf;
        bs = wave_scan_sum(bs, lane);
        const float bL = rdl_f(bs, 63); const float gg = bL - bs + li; float M = fmaxf(bL, wave_max(gg));
        if (lane < NMETA) WM[lane] = __expf(gg - M);
        const float* AC = WSP(float, WS_AC) + bh * 128; const float* BC = WSP(float, WS_BC) + bh * 128;
        const float a0 = AC[lane], a1 = AC[64 + lane], c0v = BC[lane], c1v = BC[64 + lane];
        float m0 = 0.f, m1 = 0.f, n0 = 0.f, n1 = 0.f;
#pragma unroll 8
        for (int c = 0; c < 64; ++c) { const float a = rdl_f(a0, c), bc = rdl_f(c0v, c); const float Mn = fmaxf(M + a, bc); if (lane == c) { m0 = M; n0 = Mn; } M = Mn; }
#pragma unroll 8
        for (int c = 0; c < 64; ++c) { const float a = rdl_f(a1, c), bc = rdl_f(c1v, c); const float Mn = fmaxf(M + a, bc); if (lane == c) { m1 = M; n1 = Mn; } M = Mn; }
        DEC[lane] = __expf(a0 + m0 - n0); SCL[lane] = __expf(c0v - n0); DEC[64 + lane] = __expf(a1 + m1 - n1); SCL[64 + lane] = __expf(c1v - n1);
        if ((F.vcu & 31) == 0) { WSP(float, WS_MIN)[bh * 128 + lane] = m0; WSP(float, WS_MIN)[bh * 128 + 64 + lane] = m1; }
    }
    __syncthreads();
    const int elem = (F.vcu & 31) * 512 + tid, e = elem >> 7, d = elem & 127;
    const float* KM = WSP(float, WS_KM) + (size_t)h * 16 * 128;
    float C = 0.f;
#pragma unroll
    for (int s = 0; s < NMETA; ++s) C += WM[s] * PRM[(size_t)s * NIN + OV_ + h * 128 + e] * KM[s * 128 + d];
    bf16* U = WSP(bf16, WS_U) + (size_t)bh * 128 * 16384 + elem;
    for (int c0 = 0; c0 < 128; c0 += 16) {
        unsigned short u[16];
#pragma unroll
        for (int j = 0; j < 16; ++j) u[j] = U[(size_t)(c0 + j) * 16384];
#pragma unroll
        for (int j = 0; j < 16; ++j) { U[(size_t)(c0 + j) * 16384] = (bf16)f2bf(C); C = DEC[c0 + j] * C + SCL[c0 + j] * bf2f(u[j]); }
    }
    if ((F.vcu & 31) == 0) {
        LAS float* NUL = (LAS float*)F.lds + 1024;
        const float* NUg = WSP(float, WS_NU) + (size_t)bh * 128 * 128;
        for (int i = tid; i < 4096; i += NTHR) ((LAS f32x4*)NUL)[i] = ((const f32x4*)NUg)[i];
        __syncthreads();
        if (tid < 128) {
            float n = 0.f;
#pragma unroll
            for (int s = 0; s < NMETA; ++s) n += WM[s] * KM[s * 128 + tid];
            float* NS = WSP(float, WS_NS) + (size_t)bh * 128 * 128 + tid;
#pragma unroll 8
            for (int c = 0; c < 128; ++c) { NS[c * 128] = n; n = DEC[c] * n + SCL[c] * NUL[c * 128 + tid]; }
        }
    }
    __syncthreads();
}

constexpr int L4_Q = 0, L4_K = 17408, L4_VT = 34816, L4_CS = 53248, L4_S = 88064, L4_TAB = 97280;
__device__ __forceinline__ void p4_mlstm_out(Frame& F) {
    const int bh = F.vcu >> 5, b = bh >> 2, h = bh & 3, tid = F.tid, lane = F.lane, wave = F.wave, g = lane >> 4, l15 = lane & 15;
    LAS bf16* Qs = (LAS bf16*)(F.lds + L4_Q); LAS bf16* Ks = (LAS bf16*)(F.lds + L4_K); LAS bf16* VT = (LAS bf16*)(F.lds + L4_VT);
    LAS bf16* CS = (LAS bf16*)(F.lds + L4_CS); LAS bf16* Ss = (LAS bf16*)(F.lds + L4_S); LAS float* T = (LAS float*)(F.lds + L4_TAB);
    bf16* PR = WSP(bf16, WS_PR);
    const bf16* Qg = WSP(bf16, WS_QK); const bf16* Kg = Qg + (size_t)MROWS * 512;
    v4u rq[2], rk[2], rc[4], rv[2]; float rT0 = 0.f, rT1 = 0.f, rNS = 0.f, rMin;
#define P4_FETCH(UI) do { const int _chunk = (F.vcu & 31) + 32 * (UI); const int _m0 = b * SEQ + _chunk * 64; const int _uc = bh * 128 + _chunk; \
        _Pragma("unroll") for (int _k = 0; _k < 2; ++_k) { const int _i = tid + NTHR * _k; const int _t = _i >> 4, _c8 = (_i & 15) * 8; const size_t _go = (size_t)(_m0 + _t) * 512 + h * 128 + _c8; rq[_k] = *(const v4u*)(Qg + _go); rk[_k] = *(const v4u*)(Kg + _go); \
            rv[_k] = *(const v4u*)(PR + (size_t)(_m0 + _t) * NPROJ + CV_ + h * 128 + _c8); } \
        _Pragma("unroll") for (int _k = 0; _k < 4; ++_k) { const int _i = tid + NTHR * _k; const int _e = _i >> 4, _c8 = (_i & 15) * 8; rc[_k] = *(const v4u*)(WSP(bf16, WS_U) + (size_t)_uc * 16384 + _e * 128 + _c8); } \
        if (tid < 64) { rT0 = WSP(float, WS_BT)[(_m0 + tid) * 4 + h]; rT1 = WSP(float, WS_GI)[(_m0 + tid) * 4 + h]; } \
        if (tid >= 128 && tid < 256) rNS = WSP(float, WS_NS)[(size_t)_uc * 128 + tid - 128]; \
        rMin = WSP(float, WS_MIN)[_uc]; } while (0)
    P4_FETCH(0);
    for (int ui = 0; ui < 4; ++ui) {
        const int chunk = (F.vcu & 31) + 32 * ui; const int m0 = b * SEQ + chunk * 64;
        __syncthreads();
#pragma unroll
        for (int k = 0; k < 2; ++k) { const int i = tid + NTHR * k; const int t = i >> 4, c8 = (i & 15) * 8; *(LAS v4u*)(Qs + t * 136 + c8) = rq[k]; *(LAS v4u*)(Ks + t * 136 + c8) = rk[k];
            const v4u pv = rv[k];
#pragma unroll
            for (int q = 0; q < 4; ++q) { VT[(c8 + 2 * q) * 72 + t] = (bf16)(pv[q] & 0xffffu); VT[(c8 + 2 * q + 1) * 72 + t] = (bf16)(pv[q] >> 16); } }
#pragma unroll
        for (int k = 0; k < 4; ++k) { const int i = tid + NTHR * k; const int e = i >> 4, c8 = (i & 15) * 8; *(LAS v4u*)(CS + e * 136 + c8) = rc[k]; }
        if (tid < 64) { T[tid] = rT0; T[64 + tid] = rT1; }
        if (tid >= 128 && tid < 256) T[640 + tid - 128] = rNS;
        const float Min = rMin;
        P4_FETCH(ui + 1 < 4 ? ui + 1 : 3);
        __syncthreads();
        if (wave == 0) {
            const float bt = T[lane], li = T[64 + lane]; float pm = li - bt;
            pm = wave_scan_max(pm, lane);
            const float Mt = bt + fmaxf(Min, pm);
            T[128 + lane] = Mt; T[192 + lane] = __expf(bt + Min - Mt);
        }
        { const int t = tid >> 3, part = tid & 7; float s = 0.f;
#pragma unroll
          for (int j = 0; j < 16; ++j) s += bf2f(Qs[t * 136 + part * 16 + j]) * T[640 + part * 16 + j];
          s += dpp_f<0xB1>(s); s += dpp_f<0x4E>(s); s += dpp_f<0x124>(s);
          if (part == 0) T[256 + t] = s; }
        __syncthreads();
#pragma unroll
        for (int j = 0; j < 2; ++j) { const int tt = wave >> 1, st = 2 * (wave & 1) + j; f32x4 a = {0.f, 0.f, 0.f, 0.f};
            a = mma_rows<4>(Qs + (16 * tt + l15) * 136 + 8 * g, Ks + (16 * st + l15) * 136 + 8 * g, a);
            const int s = 16 * st + l15; const float cs = T[64 + s] - T[s];
#pragma unroll
            for (int r = 0; r < 4; ++r) { const int t = 16 * tt + 4 * g + r; const float wgt = (s <= t) ? __expf(T[t] + cs - T[128 + t]) : 0.f; const float v = a[r] * wgt;
                Ss[t * 72 + s] = (bf16)f2bf(v); const float rs = row16_sum(v);
                if (l15 == 0) T[384 + st * 64 + t] = rs; } }
        __syncthreads();
        if (tid < 64) { const float den = T[192 + tid] * T[256 + tid] + (T[384 + tid] + T[448 + tid]) + (T[512 + tid] + T[576 + tid]); T[320 + tid] = 1.0f / fmaxf(fabsf(den), __expf(-T[128 + tid])); }
        f32x4 acc[4];
        const int tt = wave >> 1, tl = 16 * tt + l15;
#pragma unroll
        for (int j = 0; j < 4; ++j) { const int et = 4 * (wave & 1) + j; f32x4 a = {0.f, 0.f, 0.f, 0.f};
            a = mma_rows<4>(CS + (16 * et + l15) * 136 + 8 * g, Qs + (16 * tt + l15) * 136 + 8 * g, a);
            a = a * T[192 + tl];
            a = mma_rows<2>(VT + (16 * et + l15) * 72 + 8 * g, Ss + (16 * tt + l15) * 72 + 8 * g, a);
            acc[j] = a; }
        __syncthreads();
        float ps = 0.f, pq = 0.f; const float invd = T[320 + tl];
        const size_t orow = (size_t)(m0 + tl) * NPROJ + CO_ + h * 128, crow = (size_t)(m0 + tl) * 512 + h * 128;
#pragma unroll
        for (int j = 0; j < 4; ++j) { const int e0 = 16 * (4 * (wave & 1) + j) + 4 * g; const v2u opk = *(const v2u*)(PR + orow + e0);
            const float op[4] = {bf2f(opk[0] & 0xffffu), __uint_as_float(opk[0] & 0xffff0000u), bf2f(opk[1] & 0xffffu), __uint_as_float(opk[1] & 0xffff0000u)};
#pragma unroll
            for (int r = 0; r < 4; ++r) { const float hv = acc[j][r] * invd / (1.f + __expf(-op[r])); acc[j][r] = hv; ps += hv; pq += hv * hv; } }
        ps += __shfl_xor(ps, 16); ps += __shfl_xor(ps, 32); pq += __shfl_xor(pq, 16); pq += __shfl_xor(pq, 32);
        if (g == 0) { T[768 + (wave & 1) * 64 + tl] = ps; T[896 + (wave & 1) * 64 + tl] = pq; }
        __syncthreads();
        { const float mu = (T[768 + tl] + T[832 + tl]) * (1.f / 128.f); const float var = (T[896 + tl] + T[960 + tl]) * (1.f / 128.f) - mu * mu; const float rsd = 1.0f / sqrtf(fmaxf(var, 0.f) + EPS);
#pragma unroll
          for (int j = 0; j < 4; ++j) { const int e0 = 16 * (4 * (wave & 1) + j) + 4 * g; const f32x4 gn = *(const f32x4*)(F.gn_g + h * 128 + e0), sk = *(const f32x4*)(F.skip + h * 128 + e0);
              const v2u cpk = *(const v2u*)(WSP(bf16, WS_CB) + crow + e0);
              const float cv[4] = {bf2f(cpk[0] & 0xffffu), __uint_as_float(cpk[0] & 0xffff0000u), bf2f(cpk[1] & 0xffffu), __uint_as_float(cpk[1] & 0xffff0000u)};
              float y[4];
#pragma unroll
              for (int r = 0; r < 4; ++r) y[r] = (acc[j][r] - mu) * rsd * gn[r] + sk[r] * cv[r];
              v2u o; o[0] = pk2(y[0], y[1]); o[1] = pk2(y[2], y[3]); *(v2u*)(PR + orow + e0) = o; } }
    }
    __syncthreads();
}

constexpr int L7_SK = 0, L7_LS = 69632;
__device__ __forceinline__ int pack_key(float v, int idx, unsigned mask) { int k = (int)((__builtin_bit_cast(unsigned, v) & ~mask) | (unsigned)idx); return k < 0 ? (k ^ 0x7fffffff) : k; }
__device__ __forceinline__ float key_val(int k, unsigned mask) { const int u = k < 0 ? (k ^ 0x7fffffff) : k; return __builtin_bit_cast(float, (unsigned)u & ~mask); }
__device__ __forceinline__ int key_idx(int k, unsigned mask) { const int u = k < 0 ? (k ^ 0x7fffffff) : k; return (int)((unsigned)u & mask); }
__device__ __forceinline__ void bitonic_sort16_desc(int (&t)[16]) {
#pragma unroll
    for (int k = 2; k <= 16; k <<= 1)
#pragma unroll
        for (int j = k >> 1; j > 0; j >>= 1)
#pragma unroll
            for (int i = 0; i < 16; ++i) { const int l = i ^ j; if (l > i) { const bool desc = ((i & k) == 0); const int hi = max(t[i], t[l]), lo = min(t[i], t[l]); t[i] = desc ? hi : lo; t[l] = desc ? lo : hi; } }
}
__device__ __forceinline__ void bitonic_merge16_desc(int (&t)[16]) {
#pragma unroll
    for (int j = 8; j > 0; j >>= 1)
#pragma unroll
        for (int i = 0; i < 16; ++i) { const int l = i ^ j; if (l > i) { const int hi = max(t[i], t[l]), lo = min(t[i], t[l]); t[i] = hi; t[l] = lo; } }
}
#define TOPK_INS(t, x) do { int _x = (x); _Pragma("unroll") for (int _i = 0; _i < 16; ++_i) { const int _hi = max(t[_i], _x); _x = min(t[_i], _x); t[_i] = _hi; } } while (0)
__device__ __forceinline__ void p7_topk(Frame& F) {
    const int tid = F.tid, lane = F.lane, wave = F.wave, g = lane >> 4, l15 = lane & 15;
    LAS bf16* SK = (LAS bf16*)(F.lds + L7_SK); LAS int* LS = (LAS int*)(F.lds + L7_LS); LAS int* HIST = (LAS int*)(F.lds + L7_LS + 65536);
    const bf16* QP = WSP(bf16, WS_QP);
    __syncthreads();
    for (int i = tid; i < 4096; i += NTHR) { const int row = i >> 4, c8 = (i & 15) * 8; *(LAS v4u*)(SK + row * 136 + c8) = *(const v4u*)(WSP(bf16, WS_SKB) + (size_t)row * 128 + c8); }
    __syncthreads();
    for (int unit = F.vcu; unit < MROWS / 64; unit += F.G) {
        const int tok0 = unit * 64, h = wave;
        for (int i = tid; i < 2048; i += NTHR) HIST[i] = 0;
        bf16x8 qf[4], qn[4];
        { const bf16* qrow = QP + (size_t)(tok0 + l15) * 2048 + h * 256 + 8 * g;
#pragma unroll
          for (int k = 0; k < 4; ++k) qf[k] = *(const bf16x8*)(qrow + 32 * k); }
#pragma unroll 1
        for (int it = 0; it < 8; ++it) {
            const int p = it >> 2, tt = it & 3;
            if (it + 1 < 8) { const int p2 = (it + 1) >> 2, tt2 = (it + 1) & 3; const bf16* qrow = QP + (size_t)(tok0 + 16 * tt2 + l15) * 2048 + h * 256 + p2 * 128 + 8 * g;
#pragma unroll
                for (int k = 0; k < 4; ++k) qn[k] = *(const bf16x8*)(qrow + 32 * k); }
            int ta[16], tb[16];
#pragma unroll
            for (int kt = 0; kt < 8; ++kt) { f32x4 a = {0.f, 0.f, 0.f, 0.f}; const LAS bf16* sk = SK + (p * 128 + 16 * kt + l15) * 136 + 8 * g;
#pragma unroll
                for (int k = 0; k < 4; ++k) a = __builtin_amdgcn_mfma_f32_16x16x32_bf16(*(const LAS bf16x8*)(sk + 32 * k), qf[k], a, 0, 0, 0);
#pragma unroll
                for (int r = 0; r < 4; ++r) { const int key = pack_key(a[r], 16 * kt + 4 * g + r, 127u); if (kt < 4) ta[4 * kt + r] = key; else tb[4 * (kt - 4) + r] = key; } }
            bitonic_sort16_desc(ta); bitonic_sort16_desc(tb);
#pragma unroll
            for (int i = 0; i < 16; ++i) ta[i] = max(ta[i], tb[15 - i]);
            bitonic_merge16_desc(ta);
#pragma unroll
            for (int dd = 16; dd <= 32; dd <<= 1) {
#pragma unroll
                for (int i = 0; i < 16; ++i) tb[i] = __shfl_xor(ta[i], dd);
#pragma unroll
                for (int i = 0; i < 16; ++i) ta[i] = max(ta[i], tb[15 - i]);
                bitonic_merge16_desc(ta); }
            if (g == 0) { LAS int* dst = LS + (((16 * tt + l15) * 8 + h) * 2 + p) * 16;
#pragma unroll
                for (int i = 0; i < 16; ++i) dst[i] = ta[i]; }
#pragma unroll
            for (int k = 0; k < 4; ++k) qf[k] = qn[k];
        }
        __syncthreads();
        { const int tok = tid >> 3, h2 = tid & 7; const LAS int* la = LS + ((tok * 8 + h2) * 2 + 0) * 16; const LAS int* lb = la + 16;
          float av[16], bv[16];
#pragma unroll
          for (int i = 0; i < 16; ++i) { av[i] = key_val(la[i], 127u); bv[i] = key_val(lb[i], 127u); }
          int top[16];
#pragma unroll
          for (int i = 0; i < 16; ++i) top[i] = (int)0x80000000;
#pragma unroll
          for (int i = 0; i < 16; ++i)
#pragma unroll
              for (int j = 0; j < 16; ++j) if ((i + 1) * (j + 1) <= 16) TOPK_INS(top, pack_key(av[i] + bv[j], i * 16 + j, 255u));
          const float vmax = key_val(top[0], 255u); float ev[16]; float z = 0.f;
#pragma unroll
          for (int k = 0; k < 16; ++k) { ev[k] = __expf(key_val(top[k], 255u) - vmax); z += ev[k]; }
          const float rz = 1.0f / z;
          int eidx[16]; float gate[16];
#pragma unroll
          for (int k = 0; k < 16; ++k) { const int ij = key_idx(top[k], 255u); const int ei = key_idx(la[ij >> 4], 127u), ej = key_idx(lb[ij & 15], 127u);
              eidx[k] = ei * 128 + ej; gate[k] = ev[k] * rz; __hip_atomic_fetch_add(HIST + tok * 32 + (eidx[k] >> 9), 1, __ATOMIC_RELAXED, __HIP_MEMORY_SCOPE_WORKGROUP); }
          __syncthreads();
          if (tid < 64) { int run = 0;
#pragma unroll
              for (int b = 0; b < 32; ++b) { const int c = HIST[tid * 32 + b]; HIST[tid * 32 + b] = run; run += c; } }
          __syncthreads();
          if (h2 == 0) { const f32x4* q = (const f32x4*)(WSP(float, WS_SSQ) + (size_t)(tok0 + tok) * 16); float ssq = 0.f;
#pragma unroll
              for (int j = 0; j < 4; ++j) { const f32x4 a = q[j]; ssq += (a[0] + a[1]) + (a[2] + a[3]); }
              WSP(float, WS_RS2)[tok0 + tok] = 1.0f / sqrtf(ssq * (1.0f / DM) + EPS); }
          v2u* tk = (v2u*)WSP(unsigned, WS_TK) + (size_t)(tok0 + tok) * 128;
#pragma unroll
          for (int k = 0; k < 16; ++k) { const int pos = __hip_atomic_fetch_add(HIST + tok * 32 + (eidx[k] >> 9), 1, __ATOMIC_RELAXED, __HIP_MEMORY_SCOPE_WORKGROUP);
              v2u o; o.x = (unsigned)eidx[k]; o.y = __builtin_bit_cast(unsigned, gate[k]); tk[pos] = o; } }
        asm volatile("s_waitcnt vmcnt(0)" ::: "memory");
        __syncthreads();
    }
}

__device__ __forceinline__ float gelu_erf(float v) { return 0.5f * v * (1.0f + erff(v * 0.70710678118654752f)); }
typedef float f32x2v __attribute__((ext_vector_type(2)));
#define P8_LOAD8(RB, G) P8_LOAD8X(RB, G, e0.x, e1.x)
#define P8_LOAD8X(RB, G, EX0, EX1) do { if ((G) < 32) { const unsigned char* _tab = ((G) < 16) ? EU : EV; _Pragma("unroll") for (int _j = 0; _j < 8; ++_j) { const int _k = 8 * ((G) & 15) + _j; const unsigned _s = (_k < 64) ? (EX0) : (EX1); \
        const unsigned _ei = (unsigned)__builtin_amdgcn_readlane((int)_s, _k & 63); RB[_j] = *(const v2u*)(_tab + (size_t)_ei * (DM / 2) + 8 * lane); } } } while (0)
__device__ __forceinline__ float gelu_as(float v) {
    const float av = fabsf(v), t = __builtin_amdgcn_rcpf(av * 0.2316418882f + 1.0f);
    float q = t * 0.5307027145f + (-0.7265760135f); q = q * t + 0.7107068705f; q = q * t + (-0.142248368f); q = q * t + 0.127414796f; q = q * t;
    const float m = v * (q * __builtin_amdgcn_exp2f((v * v) * (-0.72134752044f)));
    return v < 0.f ? m : v - m;
}
__device__ __forceinline__ float reduce8_butterfly(const float (&d)[8], int lane) {
    const bool b5 = (lane & 32) != 0, b4 = (lane & 16) != 0, b3 = (lane & 8) != 0;
    float k4[4];
#pragma unroll
    for (int i = 0; i < 4; ++i) { const float snd = b5 ? d[i] : d[i + 4], kp = b5 ? d[i + 4] : d[i]; k4[i] = kp + __shfl_xor(snd, 32); }
    float k2[2];
#pragma unroll
    for (int i = 0; i < 2; ++i) { const float snd = b4 ? k4[i] : k4[i + 2], kp = b4 ? k4[i + 2] : k4[i]; k2[i] = kp + __shfl_xor(snd, 16); }
    float k1; { const float snd = b3 ? k2[0] : k2[1], kp = b3 ? k2[1] : k2[0]; k1 = kp + __shfl_xor(snd, 8); }
    k1 += __shfl_xor(k1, 4); k1 += __shfl_xor(k1, 2); k1 += __shfl_xor(k1, 1);
    return k1;
}
#define P8_UDOT(UB, G) do { _Pragma("unroll") for (int _j = 0; _j < 8; ++_j) { \
            int _sh = __builtin_amdgcn_sdot8((int)UB[_j][0], (int)xh0, 0, false); _sh = __builtin_amdgcn_sdot8((int)UB[_j][1], (int)xh1, _sh, false); \
            int _sl = __builtin_amdgcn_sdot8((int)UB[_j][0], (int)xl0, 0, false); _sl = __builtin_amdgcn_sdot8((int)UB[_j][1], (int)xl1, _sl, false); const int _s = (_sh << 4) + _sl; \
            red[(8 * ((G) & 7) + _j) * 65 + lane] = (float)_s; } \
        if (((G) & 7) == 7) { float _t0 = 0.f, _t1 = 0.f, _t2 = 0.f, _t3 = 0.f; _Pragma("unroll") for (int _i = 0; _i < 64; _i += 4) { _t0 += red[lane * 65 + _i]; _t1 += red[lane * 65 + _i + 1]; _t2 += red[lane * 65 + _i + 2]; _t3 += red[lane * 65 + _i + 3]; } \
            const float _dl = (_t0 + _t1) + (_t2 + _t3); const bool _c1 = (G) >= 8; const float _gl = __uint_as_float(_c1 ? e1.y : e0.y), _su = __uint_as_float(_c1 ? s1x : s0x); \
            const float _cv = _gl * gelu_as((_dl + hsx) * _su * rsx) * 0.25f; if (_c1) c1 = _cv; else c0 = _cv; } } while (0)
#define P8_FP4ACC(w, sel, i0) { const f32x2v _f = __builtin_amdgcn_cvt_scalef32_pk_f32_fp4((w), 1.0f, sel); acc[i0] += _c * _f[0]; acc[(i0) + 1] += _c * _f[1]; }
#define P8_VACC(VB, G) do { const int _g = (G) - 16; const float _csrc = (_g < 8) ? c0 : c1; _Pragma("unroll") for (int _j = 0; _j < 8; ++_j) { \
            asm volatile("" : "+v"(VB[_j][0]), "+v"(VB[_j][1]) : "v"(acc[0]), "v"(acc[5]), "v"(acc[10]), "v"(acc[15])); \
            const float _c = __uint_as_float((unsigned)__builtin_amdgcn_readlane((int)__float_as_uint(_csrc), 8 * (_g & 7) + _j)); \
            P8_FP4ACC(VB[_j][0], 0, 0) P8_FP4ACC(VB[_j][0], 1, 2) P8_FP4ACC(VB[_j][0], 2, 4) P8_FP4ACC(VB[_j][0], 3, 6) P8_FP4ACC(VB[_j][1], 0, 8) P8_FP4ACC(VB[_j][1], 1, 10) P8_FP4ACC(VB[_j][1], 2, 12) P8_FP4ACC(VB[_j][1], 3, 14) } } while (0)
typedef int v8i __attribute__((ext_vector_type(8)));
#define P8_CLOAD_V(RB, PC, H) do { _Pragma("unroll") for (int _r = 0; _r < 8; ++_r) RB[_r] = *(const v4u*)(EV + (size_t)vofv[H][_r] + 128 * (PC)); } while (0)
#define P8_SLAB(RB, PC, H, FIRST) do { \
        _Pragma("unroll") for (int _r = 0; _r < 8; ++_r) { v4u _w = RB[_r]; if (_r >= 4) { const unsigned _t0 = _w[0], _t1 = _w[1]; _w[0] = _w[2]; _w[1] = _w[3]; _w[2] = _t0; _w[3] = _t1; } \
            *(LAS v4u*)(SLB + ((_r & 1) ? wa1 : wa0) + 1024 * _r) = _w; } \
        _Pragma("unroll") for (int _i = 0; _i < 16; ++_i) { const int _cb = 4 * (_i & 3) + (_i >> 2); const int _ta = (tb ^ (16 * (_cb >> 1))) ^ (8 * (_cb & 1)); \
            const v2i_t _t0 = __builtin_amdgcn_ds_read_tr4_b64_v2i32((LAS v2i_t*)(SLB + _ta)); const v2i_t _t1 = __builtin_amdgcn_ds_read_tr4_b64_v2i32((LAS v2i_t*)(SLB + _ta + 2048)); \
            v8i _b, _a; _b[0] = _t0[0]; _b[1] = _t0[1]; _b[2] = _t1[0]; _b[3] = _t1[1]; _b[4] = 0; _b[5] = 0; _b[6] = 0; _b[7] = 0; \
            const bool _keep = (ln >> 2) == (_cb & 3); _a[0] = _keep ? (int)ah[H][0] : 0; _a[1] = _keep ? (int)ah[H][1] : 0; _a[2] = _keep ? (int)ah[H][2] : 0; _a[3] = _keep ? (int)ah[H][3] : 0; _a[4] = 0; _a[5] = 0; _a[6] = 0; _a[7] = 0; \
            if ((FIRST) && (_cb & 3) == 0) { const f32x4 _z = {0.f, 0.f, 0.f, 0.f}; vacc[_cb >> 2] = _z; } \
            vacc[_cb >> 2] = __builtin_amdgcn_mfma_scale_f32_16x16x128_f8f6f4(_a, _b, vacc[_cb >> 2], 0, 4, 0, 0, 0, 0); } } while (0)
#define P8_VOUT(PC) do { _Pragma("unroll") for (int _a = 0; _a < 4; ++_a) OT[oto + 64 * (PC) + 16 * _a] = vacc[_a][0] + vacc[_a][1]; } while (0)
typedef int v2i_t __attribute__((ext_vector_type(2)));
__device__ __forceinline__ void p8_gather(Frame& F) {
    const int lane = F.lane; const int gw = F.vcu * NWAVES + F.wave, NGW = F.G * NWAVES;
    const unsigned char* EU = F.ws + WS_EU; const unsigned char* EV = F.ws + WS_EV; const bf16* H1B = WSP(bf16, WS_H1B);
    const unsigned long long* tkb = (const unsigned long long*)WSP(unsigned, WS_TK);
    unsigned long long nt0 = tkb[(size_t)(gw * 8) * 128 + lane], nt1 = tkb[(size_t)(gw * 8) * 128 + 64 + lane];
    v2u nx[4];
#pragma unroll
    for (int j = 0; j < 4; ++j) nx[j] = *(const v2u*)(H1B + (size_t)(gw * 8) * DM + 256 * j + 4 * lane);
    float nrs = WSP(float, WS_RS2)[gw * 8];
    const float* esc = WSP(float, WS_ESC);
    LAS float* red = (LAS float*)(F.lds + F.wave * 16640);
    LAS unsigned char* WL = F.lds + F.wave * 16640;
    LAS unsigned char* CTB = WL; LAS float* OT = (LAS float*)(WL + 1024); LAS unsigned char* SLB = WL + 8192;
    const int lq = lane >> 4, ln = lane & 15;
    const int cta = ((ln & 3) < 2 ? 128 * (ln & 3) : 256) + 16 * lq;
    const int wa0 = 128 * (lane >> 3) + 16 * ((lane & 7) ^ (lane >> 4)), wa1 = 128 * (lane >> 3) + 16 * ((lane & 7) ^ (4 + (lane >> 4)));
    const int tb = (32 * (lq & 1) + ln) * 128 + 16 * ((ln >> 1) & 7) + 8 * (lq & 1);
    const int oto = 256 * (ln >> 2) + 4 * lq + (ln & 3);
    f32x4 vacc[4];
    __syncthreads();
    float ns0x = esc[(unsigned)nt0], ns1x = esc[(unsigned)nt1];
    v2u b0[8], b1[8], b2[8];
    P8_LOAD8X(b0, 0, (unsigned)nt0, (unsigned)nt1); P8_LOAD8X(b1, 1, (unsigned)nt0, (unsigned)nt1);
    for (int tok = gw * 8; tok < gw * 8 + 8; ++tok) {
        float xf[16];
#pragma unroll
        for (int j = 0; j < 4; ++j) { const v2u xr = nx[j];
            xf[4 * j] = bf2f(xr[0] & 0xffffu); xf[4 * j + 1] = __uint_as_float(xr[0] & 0xffff0000u); xf[4 * j + 2] = bf2f(xr[1] & 0xffffu); xf[4 * j + 3] = __uint_as_float(xr[1] & 0xffff0000u); }
        v2u e0, e1; e0.x = (unsigned)nt0; e0.y = (unsigned)(nt0 >> 32); e1.x = (unsigned)nt1; e1.y = (unsigned)(nt1 >> 32);
        const unsigned s0x = __float_as_uint(ns0x), s1x = __float_as_uint(ns1x);
        float amax = 0.f;
#pragma unroll
        for (int i = 0; i < 16; ++i) amax = fmaxf(amax, fabsf(xf[i]));
        amax = wave_max(amax); const float sx = amax > 0.f ? 119.0f / amax : 1.0f;
        int sxl = 0; unsigned xh0 = 0u, xh1 = 0u, xl0 = 0u, xl1 = 0u;
#pragma unroll
        for (int i = 0; i < 16; ++i) { const int q = (int)rintf(xf[i] * sx); sxl += q; const int l = ((q + 8) & 15) - 8, h = (q - l) >> 4;
            if (i < 8) { xl0 |= ((unsigned)l & 15u) << (4 * i); xh0 |= ((unsigned)h & 15u) << (4 * i); } else { xl1 |= ((unsigned)l & 15u) << (4 * (i - 8)); xh1 |= ((unsigned)h & 15u) << (4 * (i - 8)); } }
        const float hsx = 0.5f * wave_sum((float)sxl);
        const float rsx = nrs / sx;
        float c0 = 0.f, c1 = 0.f;
        P8_LOAD8(b2, 2); P8_UDOT(b0, 0);
        P8_LOAD8(b0, 3); P8_UDOT(b1, 1);
        P8_LOAD8(b1, 4); P8_UDOT(b2, 2);
        P8_LOAD8(b2, 5); P8_UDOT(b0, 3);
        P8_LOAD8(b0, 6); P8_UDOT(b1, 4);
        P8_LOAD8(b1, 7); P8_UDOT(b2, 5);
        P8_LOAD8(b2, 8); P8_UDOT(b0, 6);
        P8_LOAD8(b0, 9); P8_UDOT(b1, 7);
        P8_LOAD8(b1, 10); P8_UDOT(b2, 8);
        P8_LOAD8(b2, 11); P8_UDOT(b0, 9);
        P8_LOAD8(b0, 12); P8_UDOT(b1, 10);
        P8_LOAD8(b1, 13); P8_UDOT(b2, 11);
        P8_LOAD8(b2, 14); P8_UDOT(b0, 12);
        P8_LOAD8(b0, 15); P8_UDOT(b1, 13);
        unsigned vofv[2][8];
#pragma unroll
        for (int h = 0; h < 2; ++h)
#pragma unroll
            for (int r = 0; r < 8; ++r) vofv[h][r] = (unsigned)__builtin_amdgcn_ds_bpermute(4 * (8 * r + (lane >> 3)), (int)(h ? e1.x : e0.x)) * 512u + 16u * (lane & 7);
        v4u sa[8], sb[8];
        P8_CLOAD_V(sa, 0, 0);
        P8_UDOT(b2, 14);
        P8_CLOAD_V(sb, 0, 1);
        P8_UDOT(b0, 15);
        asm volatile("" ::: "memory");
        const int tokn = tok + 1 < gw * 8 + 8 ? tok + 1 : tok;
        nt0 = tkb[(size_t)tokn * 128 + lane]; nt1 = tkb[(size_t)tokn * 128 + 64 + lane];
#pragma unroll
        for (int j = 0; j < 4; ++j) nx[j] = *(const v2u*)(H1B + (size_t)tokn * DM + 256 * j + 4 * lane);
        nrs = WSP(float, WS_RS2)[tokn];
        const float cmax = wave_max(fmaxf(fabsf(c0), fabsf(c1))); const float sc = cmax > 0.f ? 256.0f / cmax : 1.0f, rsc = 1.0f / sc;
        { const float a0 = c0 * sc, a1 = c1 * sc; const int h = __builtin_amdgcn_cvt_pk_fp8_f32(a0, a1, 0, false);
          const f32x2v rb = __builtin_amdgcn_cvt_pk_f32_fp8(h, false); const int l = __builtin_amdgcn_cvt_pk_fp8_f32(a0 - rb[0], a1 - rb[1], 0, false);
          CTB[lane] = (unsigned char)(h & 0xff); CTB[64 + lane] = (unsigned char)((h >> 8) & 0xff); CTB[128 + lane] = (unsigned char)(l & 0xff); CTB[192 + lane] = (unsigned char)((l >> 8) & 0xff);
          if (lane < 8) { v4u z; z[0] = 0u; z[1] = 0u; z[2] = 0u; z[3] = 0u; *(LAS v4u*)(CTB + 256 + 16 * lane) = z; } }
        v4u ah[2];
#pragma unroll
        for (int h = 0; h < 2; ++h) ah[h] = *(const LAS v4u*)(CTB + cta + 64 * h);
        P8_SLAB(sa, 0, 0, true);  P8_CLOAD_V(sa, 1, 0);
        P8_SLAB(sb, 0, 1, false); P8_CLOAD_V(sb, 1, 1);  P8_VOUT(0);
        P8_SLAB(sa, 1, 0, true);  P8_CLOAD_V(sa, 2, 0);
        P8_SLAB(sb, 1, 1, false); P8_CLOAD_V(sb, 2, 1);  P8_VOUT(1);
        P8_SLAB(sa, 2, 0, true);  P8_CLOAD_V(sa, 3, 0);
        P8_SLAB(sb, 2, 1, false); P8_CLOAD_V(sb, 3, 1);  P8_VOUT(2);
        ns0x = esc[(unsigned)nt0]; ns1x = esc[(unsigned)nt1];
        v2u hr[4];
#pragma unroll
        for (int j = 0; j < 4; ++j) hr[j] = *(const v2u*)(H1B + (size_t)tok * DM + 256 * j + 4 * lane);
        P8_LOAD8X(b2, 0, (unsigned)nt0, (unsigned)nt1);
        P8_SLAB(sa, 3, 0, true);
        P8_LOAD8X(b0, 1, (unsigned)nt0, (unsigned)nt1);
        P8_SLAB(sb, 3, 1, false); P8_VOUT(3);
        float acc[16];
#pragma unroll
        for (int j = 0; j < 4; ++j) { const f32x4 t = *(const LAS f32x4*)(OT + 256 * j + 4 * lane); acc[4 * j] = t[0] * rsc; acc[4 * j + 1] = t[1] * rsc; acc[4 * j + 2] = t[2] * rsc; acc[4 * j + 3] = t[3] * rsc; }
        f32x4* orow = (f32x4*)(F.out + (size_t)tok * DM) + lane; f32x4 hv[4]; float s2 = 0.f;
        f32x4 gv[4];
#pragma unroll
        for (int j = 0; j < 4; ++j) gv[j] = ((const f32x4*)F.g_fin)[lane + 64 * j];
#pragma unroll
        for (int j = 0; j < 4; ++j) {
            { const v2u xr = hr[j];
              hv[j][0] = bf2f(xr[0] & 0xffffu); hv[j][1] = __uint_as_float(xr[0] & 0xffff0000u); hv[j][2] = bf2f(xr[1] & 0xffffu); hv[j][3] = __uint_as_float(xr[1] & 0xffff0000u); }
#pragma unroll
            for (int i = 0; i < 4; ++i) { hv[j][i] += acc[4 * j + i]; s2 += hv[j][i] * hv[j][i]; } }
        s2 = wave_sum(s2); const float rstd3 = 1.0f / sqrtf(s2 * (1.0f / DM) + EPS);
#pragma unroll
        for (int j = 0; j < 4; ++j) orow[64 * j] = hv[j] * rstd3 * gv[j];
#pragma unroll
        for (int j = 0; j < 8; ++j) { const v2u t = b0[j]; b0[j] = b2[j]; b1[j] = t; }
        asm volatile("" ::: "memory");
    }
}

constexpr int CW_BAR = 4096;
static_assert((CW_BAR + XCD_BAR_WORDS) * 4 <= (int)CTL_ZERO_BYTES, "barrier words inside the zeroed region");

__global__ void __launch_bounds__(NTHR, 2) hybrid_fwd(Params prm) {
    extern __shared__ __attribute__((aligned(16))) unsigned char lds_raw[];
    Frame F;
    F.lds = (LAS unsigned char*)lds_raw;
    F.tid = threadIdx.x; F.lane = F.tid & 63; F.wave = __builtin_amdgcn_readfirstlane(F.tid >> 6);
    F.G = gridDim.x; { const int bx = blockIdx.x; F.vcu = (F.G % 8 == 0) ? (bx % 8) * (F.G / 8) + bx / 8 : bx; }
    F.x = prm.in[0]; F.meta = prm.in[1]; F.g_mix = prm.in[2]; F.w_in = prm.in[3]; F.conv_w = prm.in[4]; F.conv_b = prm.in[5]; F.w_qm = prm.in[6]; F.w_km = prm.in[7];
    F.b_i = prm.in[8]; F.b_f = prm.in[9]; F.skip = prm.in[10]; F.gn_g = prm.in[11]; F.sb_g = prm.in[12]; F.w_out = prm.in[13]; F.g_ffn = prm.in[14]; F.w_query = prm.in[15];
    F.sub_keys = prm.in[16]; F.eu = prm.in[17]; F.ev = prm.in[18]; F.g_fin = prm.in[19]; F.out = prm.out; F.ws = prm.ws;
    volatile LAS unsigned* MISC = (volatile LAS unsigned*)(F.lds + LDSCTL_OFF);
    if (F.tid < 64) MISC[F.tid] = 0u;
    __syncthreads();
    XcdBarrier bar = xcd_barrier_post((unsigned*)(F.ws + WS_CTL) + CW_BAR, MISC + 8);

    p0_prologue(F);
    xcd_barrier(bar);
    {
        pg8::Gemm g{WSP(bf16, WS_XB), WSP(bf16, WS_WINT), MROWS, NPROJ, DM, DM, DM}; pg8::StaticOrder S; S.init(MROWS, NPROJ, F.G, (int)blockIdx.x);
        pg8::EpiRowScaleBf16<0> E{WSP(bf16, WS_PR), NPROJ, WSP(float, WS_RSTD1), EPS};
        pg8::gemm_phase<pg8::EpiRowScaleBf16<0>, pg8::StaticOrder, PG8_ALIGN, PG8_SP2>(F.lds, g, S, E);
        p1_meta_tail(F);
    }
    xcd_barrier(bar);
    p2_mlstm_local(F);
    p2_sb_attention(F);
    xcd_barrier(bar);
    p3_scan(F);
    xcd_barrier(bar);
    p4_mlstm_out(F);
    xcd_barrier(bar);
    {
        pg8::Gemm g{WSP(bf16, WS_PR) + CO_, WSP(bf16, WS_WOUTT), MROWS, DM, DM, NPROJ, DM}; pg8::StaticOrder S; S.init(MROWS, DM, F.G, (int)blockIdx.x);
        pg8::EpiResidual E{F.x, F.out, WSP(bf16, WS_H1B), WSP(float, WS_SSQ), DM};
        pg8::gemm_phase<pg8::EpiResidual, pg8::StaticOrder, PG8_ALIGN, PG8_SP2>(F.lds, g, S, E);
    }
    xcd_barrier(bar);
    {
        pg8::Gemm g{WSP(bf16, WS_H1B), WSP(bf16, WS_WQT), MROWS, 2048, DM, DM, DM}; pg8::StaticOrder S; S.init(MROWS, 2048, F.G, (int)blockIdx.x);
        pg8::EpiRowScaleBf16<1> E{WSP(bf16, WS_QP), 2048, WSP(float, WS_SSQ), EPS};
        pg8::gemm_phase<pg8::EpiRowScaleBf16<1>, pg8::StaticOrder, PG8_ALIGN, PG8_SP2>(F.lds, g, S, E);
    }
    xcd_barrier(bar);
    p7_topk(F);
    p8_gather(F);
}

extern "C" void kernel_launch(void* const* d_in, const int* in_sizes, int n_in, void* d_out, int out_size, void* d_ws, size_t ws_size, hipStream_t stream) {
    static int grid = 0;
    if (grid == 0) {
        if (n_in != 20 || in_sizes[0] != MROWS * DM || out_size != MROWS * DM || ws_size < WS_END) {
            fprintf(stderr, "kernel_launch: unexpected shapes (n_in %d, in0 %d, out %d, ws %zu < %zu); nothing launched\n", n_in, n_in > 0 ? in_sizes[0] : -1, out_size, ws_size, (size_t)WS_END); grid = -1; return; }
        int dev = 0, cus = 0, per_cu = 0;
        if (hipGetDevice(&dev) != hipSuccess || hipDeviceGetAttribute(&cus, hipDeviceAttributeMultiprocessorCount, dev) != hipSuccess) { fprintf(stderr, "kernel_launch: device query failed\n"); grid = -1; return; }
        if (hipFuncSetAttribute((const void*)hybrid_fwd, hipFuncAttributeMaxDynamicSharedMemorySize, LDS_BYTES) != hipSuccess) { fprintf(stderr, "kernel_launch: hipFuncSetAttribute failed\n"); grid = -1; return; }
        if (hipOccupancyMaxActiveBlocksPerMultiprocessor(&per_cu, (const void*)hybrid_fwd, NTHR, LDS_BYTES) != hipSuccess || per_cu < 1) { fprintf(stderr, "kernel_launch: occupancy query says %d blocks/CU\n", per_cu); (void)hipGetLastError(); grid = -1; return; }
        grid = cus;
        if (grid != 256) { fprintf(stderr, "kernel_launch: this kernel is built for a 256-CU device (got %d)\n", grid); grid = -1; return; }
    }
    if (grid < 0) return;
    if (hipMemsetAsync((char*)d_ws + WS_CTL, 0, CTL_ZERO_BYTES, stream) != hipSuccess) { fprintf(stderr, "kernel_launch: memset failed\n"); return; }
    Params p{};
    for (int i = 0; i < 20; ++i) p.in[i] = (const float*)d_in[i];
    p.out = (float*)d_out; p.ws = (unsigned char*)d_ws;
    void* args[] = {&p};
    const hipError_t e = hipLaunchCooperativeKernel((const void*)hybrid_fwd, dim3(grid), dim3(NTHR), args, LDS_BYTES, stream);
    if (e != hipSuccess) fprintf(stderr, "kernel_launch: cooperative launch failed: %s\n", hipGetErrorString(e));
}
```

```cpp
#include <hip/hip_runtime.h>
#include <hip/hip_cooperative_groups.h>
#include <cstdio>
#include <cstdint>
namespace cg = cooperative_groups;

namespace pg8 {
#define PG8_LAS __attribute__((address_space(3)))
typedef unsigned short bf16_t;
typedef short bf16x8 __attribute__((ext_vector_type(8)));
typedef float f32x4 __attribute__((ext_vector_type(4)));
typedef unsigned u32x4 __attribute__((ext_vector_type(4)));
typedef unsigned u32x2 __attribute__((ext_vector_type(2)));
constexpr int BM = 256, BK = 64, HALF = 128, HTB = HALF * BK * 2  , STAGE_BYTES = 8 * HTB, NXCD = 8, WGM = 8;

__host__ __device__ __forceinline__ int lds_byte(int r, int c) { const int st = (r >> 4) * 2 + (c >> 5), rr = r & 15, cc = c & 31, ob = rr * 64 + cc * 2; return st * 1024 + (ob ^ (((ob >> 9) & 1) << 5)); }
__host__ __device__ __forceinline__ void stage_rc(int b, int& R, int& C) { const int st = b / 1024, sb = b % 1024, swz = sb ^ (((sb >> 9) & 1) << 5); R = (st >> 1) * 16 + swz / 64; C = (st & 1) * 32 + (swz % 64) / 2; }
__host__ __device__ __forceinline__ int perm32(int rho) { const int n = rho >> 4, i = rho & 15; return 8 * (i >> 2) + 4 * n + (i & 3); }

struct Unit { int pm, pn; };
struct Gemm { const bf16_t* A; const bf16_t* Bt; int M, N, K, lda, ldb; };

struct StaticOrder {
    int nM, nN, nwg, G, c;
    __host__ __device__ void init(int M, int N, int G_, int c_) { nM = M / BM; nN = N / BM; nwg = nM * nN; G = G_; c = c_; }
    __host__ __device__ bool next(int i, Unit& u) const {
        const long L = (long)i * G + c; if (L >= nwg) return false;
        int wgid = (int)L; { const int q = nwg / NXCD, r = nwg % NXCD, xcd = wgid % NXCD, off = wgid / NXCD; wgid = (xcd < r ? xcd * (q + 1) : r * (q + 1) + (xcd - r) * q) + off; }
        const int nig = WGM * nN, gid = wgid / nig, fm = gid * WGM, gsz = (nM - fm) < WGM ? (nM - fm) : WGM;
        u.pm = fm + ((wgid % nig) % gsz); u.pn = (wgid % nig) / gsz; return true;
    }
    __device__ __forceinline__ void a_ready(const Unit&) const {}
    __device__ __forceinline__ void done(const Unit&) const {}
};

__device__ __forceinline__ unsigned cvt_pk_bf16(float lo, float hi) { unsigned r; asm volatile("v_cvt_pk_bf16_f32 %0, %1, %2" : "=v"(r) : "v"(lo), "v"(hi)); return r; }

template <int MODE> struct EpiRowScaleBf16 {
    static constexpr bool PERM = true, AFTER_DRAIN = false;
    bf16_t* O; int ldc; const float* rs; float eps;
    __device__ __forceinline__ void operator()(const f32x4 (&acc)[2][2][4][2], const Unit& u, int wr, int wc, int fr, int fq) const {
        const int row0 = u.pm * BM + wr * 64 + fr; const int col0 = u.pn * BM + wc * 32 + 8 * fq;
#pragma unroll
        for (int ai = 0; ai < 2; ++ai)
#pragma unroll
            for (int m = 0; m < 4; ++m) { const int row = row0 + ai * HALF + m * 16; float sc;
                if (MODE == 0) sc = rs[row];
                else { const f32x4* q = (const f32x4*)(rs + (size_t)row * 16); const f32x4 a = q[0], b = q[1], c = q[2], d = q[3];
                       const float s = ((a[0] + a[1]) + (a[2] + a[3])) + ((b[0] + b[1]) + (b[2] + b[3])) + ((c[0] + c[1]) + (c[2] + c[3])) + ((d[0] + d[1]) + (d[2] + d[3]));
                       sc = 1.0f / sqrtf(s * (1.0f / 1024.0f) + eps); }
                bf16_t* rowp = O + (size_t)row * ldc + col0;
#pragma unroll
                for (int bj = 0; bj < 2; ++bj) { const f32x4 v0 = acc[ai][bj][m][0] * sc, v1 = acc[ai][bj][m][1] * sc;
                    u32x4 w; w.x = cvt_pk_bf16(v0[0], v0[1]); w.y = cvt_pk_bf16(v0[2], v0[3]); w.z = cvt_pk_bf16(v1[0], v1[1]); w.w = cvt_pk_bf16(v1[2], v1[3]);
                    *(u32x4*)(rowp + bj * HALF) = w; } }
    }
};
struct EpiResidual {
    static constexpr bool PERM = false, AFTER_DRAIN = false;
    const float* base; float* out; bf16_t* outb; float* ssq; int ldc;
    __device__ __forceinline__ void operator()(const f32x4 (&acc)[2][2][4][2], const Unit& u, int wr, int wc, int fr, int fq) const {
        const int col0 = u.pn * BM + wc * 32 + 4 * fq;
#pragma unroll
        for (int ai = 0; ai < 2; ++ai)
#pragma unroll
            for (int m = 0; m < 4; ++m) { const int row = u.pm * BM + ai * HALF + wr * 64 + m * 16 + fr; const size_t off = (size_t)row * ldc + col0; float s = 0.f;
#pragma unroll
                for (int bj = 0; bj < 2; ++bj)
#pragma unroll
                    for (int n = 0; n < 2; ++n) { const size_t o = off + bj * HALF + n * 16; const f32x4 h = *(const f32x4*)(base + o) + acc[ai][bj][m][n];
                        u32x2 w; w.x = cvt_pk_bf16(h[0], h[1]); w.y = cvt_pk_bf16(h[2], h[3]); *(u32x2*)(outb + o) = w;
                        s += (h[0] * h[0] + h[1] * h[1]) + (h[2] * h[2] + h[3] * h[3]); }
                s += __shfl_xor(s, 16); s += __shfl_xor(s, 32);
                if (fq == 0) ssq[(size_t)row * 16 + u.pn * 4 + wc] = s; }
    }
};
template <class Epi, class Sched, bool ALIGN_EPI = false, bool SP2 = false>
__device__ __forceinline__ void gemm_phase(PG8_LAS unsigned char* lds, const Gemm g, const Sched& S, const Epi& E) {
    int tid_ = threadIdx.x; asm volatile("" : "+v"(tid_));
    const int tid = tid_, wid = __builtin_amdgcn_readfirstlane(tid >> 6), lane = tid & 63, wr = wid >> 2, wc = wid & 3, fr = lane & 15, fq = lane >> 4;
    const int K = g.K, nt = K / BK;
    unsigned voffA[2], voffB[2];
#pragma unroll
    for (int i = 0; i < 2; ++i) { int R, C; stage_rc(tid * 16 + i * 8192, R, C); const int Rb = Epi::PERM ? ((R & ~31) + perm32(R & 31)) : R;
        voffA[i] = (unsigned)(R * g.lda + C) * 2u; voffB[i] = (unsigned)(Rb * g.ldb + C) * 2u; }
    const size_t kstep = (size_t)(BK * 2);
    const size_t hstepA = (size_t)HALF * g.lda * 2, hstepB = (size_t)HALF * g.ldb * 2;
    const size_t tstepA = 2 * hstepA, tstepB = 2 * hstepB;
    const unsigned ldsw = (unsigned)wid * 1024u;
    const int aoff = lds_byte(wr * 64 + fr, fq * 8), boff = lds_byte(wc * 32 + fr, fq * 8);
#define PG8_SA(b, h) (((b) * 2 + (h)) * HTB)
#define PG8_SB(b, h) ((4 + (b) * 2 + (h)) * HTB)
#define PG8_STAGE(bufoff, gbase, voff) do { _Pragma("unroll") for (int _i = 0; _i < 2; ++_i) \
        __builtin_amdgcn_global_load_lds((const unsigned*)((const char*)(gbase) + (voff)[_i]), (PG8_LAS unsigned*)(lds + (bufoff) + ldsw + _i * 8192), 16, 0, 0); } while (0)
#define PG8_LDA(dst, b, h) do { _Pragma("unroll") for (int m = 0; m < 4; ++m) _Pragma("unroll") for (int k = 0; k < 2; ++k) dst[m][k] = *(const PG8_LAS bf16x8*)(lds + PG8_SA(b, h) + aoff + m * 2048 + k * 1024); } while (0)
#define PG8_LDB(dst, b, h) do { _Pragma("unroll") for (int n = 0; n < 2; ++n) _Pragma("unroll") for (int k = 0; k < 2; ++k) dst[n][k] = *(const PG8_LAS bf16x8*)(lds + PG8_SB(b, h) + boff + n * 2048 + k * 1024); } while (0)
#define PG8_MMA(ai, bj, At, Bt) do { __builtin_amdgcn_s_setprio(1); _Pragma("unroll") for (int m = 0; m < 4; ++m) _Pragma("unroll") for (int n = 0; n < 2; ++n) _Pragma("unroll") for (int k = 0; k < 2; ++k) \
        acc[ai][bj][m][n] = __builtin_amdgcn_mfma_f32_16x16x32_bf16(Bt[n][k], At[m][k], acc[ai][bj][m][n], 0, 0, 0); __builtin_amdgcn_s_setprio(0); } while (0)
#define PG8_WAIT_V(n) asm volatile("s_waitcnt vmcnt(" #n ")" ::: "memory")
#define PG8_WAIT_L(n) asm volatile("s_waitcnt lgkmcnt(" #n ")" ::: "memory")
#define PG8_BAR __builtin_amdgcn_s_barrier()
#define PG8_SCHED __builtin_amdgcn_sched_barrier(0)
    Unit cur, nxt; int ui = 0;
    if (!S.next(0, cur)) return;
    f32x4 acc[2][2][4][2];
#pragma unroll
    for (int a = 0; a < 2; ++a)
#pragma unroll
        for (int b = 0; b < 2; ++b)
#pragma unroll
            for (int m = 0; m < 4; ++m)
#pragma unroll
                for (int n = 0; n < 2; ++n) acc[a][b][m][n] = (f32x4){0.f, 0.f, 0.f, 0.f};
    bf16x8 At[4][2], B0[2][2], B1[2][2];
    const char* cA = (const char*)g.A + (size_t)cur.pm * tstepA; const char* cB = (const char*)g.Bt + (size_t)cur.pn * tstepB;
    S.a_ready(cur);
    if constexpr (SP2) {
        PG8_STAGE(PG8_SB(0, 0), cB, voffB); PG8_STAGE(PG8_SB(0, 1), cB + hstepB, voffB); PG8_STAGE(PG8_SA(0, 0), cA, voffA); PG8_STAGE(PG8_SA(0, 1), cA + hstepA, voffA);
        if (wr == 1) PG8_BAR;
        PG8_WAIT_V(2); PG8_BAR;
        PG8_STAGE(PG8_SB(1, 0), cB + kstep, voffB); PG8_STAGE(PG8_SA(1, 0), cA + kstep, voffA); PG8_STAGE(PG8_SB(1, 1), cB + hstepB + kstep, voffB);
        PG8_WAIT_V(6); PG8_BAR;
    } else {
        PG8_STAGE(PG8_SB(0, 0), cB, voffB); PG8_STAGE(PG8_SA(0, 0), cA, voffA); PG8_STAGE(PG8_SB(0, 1), cB + hstepB, voffB); PG8_STAGE(PG8_SA(0, 1), cA + hstepA, voffA);
        if (wr == 1) PG8_BAR;
        PG8_WAIT_V(4); PG8_BAR;
        PG8_STAGE(PG8_SB(1, 0), cB + kstep, voffB); PG8_STAGE(PG8_SA(1, 0), cA + kstep, voffA); PG8_STAGE(PG8_SB(1, 1), cB + hstepB + kstep, voffB);
        PG8_WAIT_V(6); PG8_BAR;
    }
    for (;;) {
        const bool has_next = S.next(ui + 1, nxt);
        const char* nA = has_next ? (const char*)g.A + (size_t)nxt.pm * tstepA : cA; const char* nB = has_next ? (const char*)g.Bt + (size_t)nxt.pn * tstepB : cB;
        for (int t = 0; t < nt; t += 2) {
            const bool last = (t == nt - 2);
            const char* a1 = cA + (size_t)(t + 1) * kstep;
            const char* a2 = last ? nA : cA + (size_t)(t + 2) * kstep; const char* b2 = last ? nB : cB + (size_t)(t + 2) * kstep;
            const char* a3 = a2 + kstep; const char* b3 = b2 + kstep;
            if (last && has_next) S.a_ready(nxt);
            if constexpr (SP2) {
            PG8_LDB(B0, 0, 0); PG8_LDB(B1, 0, 1); PG8_SCHED; PG8_LDA(At, 0, 0); PG8_STAGE(PG8_SA(1, 1), a1 + hstepA, voffA);
            PG8_WAIT_V(8); PG8_WAIT_L(0); PG8_BAR; PG8_MMA(0, 0, At, B0); PG8_MMA(0, 1, At, B1); PG8_BAR; PG8_SCHED;
            PG8_LDA(At, 0, 1); PG8_STAGE(PG8_SB(0, 0), b2, voffB); PG8_STAGE(PG8_SB(0, 1), b2 + hstepB, voffB); PG8_STAGE(PG8_SA(0, 0), a2, voffA);
            PG8_WAIT_V(8); PG8_WAIT_L(0); PG8_BAR; PG8_MMA(1, 0, At, B0); PG8_MMA(1, 1, At, B1); PG8_BAR; PG8_SCHED;
            PG8_LDB(B0, 1, 0); PG8_LDB(B1, 1, 1); PG8_SCHED; PG8_LDA(At, 1, 0); PG8_STAGE(PG8_SA(0, 1), a2 + hstepA, voffA);
            PG8_WAIT_V(8); PG8_WAIT_L(0); PG8_BAR; PG8_MMA(0, 0, At, B0); PG8_MMA(0, 1, At, B1); PG8_BAR; PG8_SCHED;
            PG8_LDA(At, 1, 1); PG8_STAGE(PG8_SB(1, 0), b3, voffB); PG8_STAGE(PG8_SB(1, 1), b3 + hstepB, voffB); PG8_STAGE(PG8_SA(1, 0), a3, voffA);
            PG8_WAIT_V(8); PG8_WAIT_L(0); PG8_BAR; PG8_MMA(1, 0, At, B0); PG8_MMA(1, 1, At, B1); PG8_BAR; PG8_SCHED;
            } else {
            PG8_LDB(B0, 0, 0); PG8_SCHED; PG8_LDA(At, 0, 0); PG8_STAGE(PG8_SA(1, 1), a1 + hstepA, voffA);
            PG8_WAIT_L(8); PG8_BAR; PG8_WAIT_L(0); PG8_MMA(0, 0, At, B0); PG8_BAR; PG8_SCHED;
            PG8_LDB(B1, 0, 1); PG8_STAGE(PG8_SB(0, 0), b2, voffB);
            PG8_BAR; PG8_WAIT_L(0); PG8_MMA(0, 1, At, B1); PG8_BAR;
            PG8_LDA(At, 0, 1); PG8_STAGE(PG8_SA(0, 0), a2, voffA);
            PG8_BAR; PG8_WAIT_L(0); PG8_MMA(1, 0, At, B0); PG8_BAR; PG8_SCHED;
            PG8_STAGE(PG8_SB(0, 1), b2 + hstepB, voffB);
            PG8_WAIT_V(6); PG8_BAR; PG8_MMA(1, 1, At, B1); PG8_BAR;
            PG8_LDB(B0, 1, 0); PG8_SCHED; PG8_LDA(At, 1, 0); PG8_STAGE(PG8_SA(0, 1), a2 + hstepA, voffA);
            PG8_WAIT_L(8); PG8_BAR; PG8_WAIT_L(0); PG8_MMA(0, 0, At, B0); PG8_BAR; PG8_SCHED;
            PG8_LDB(B1, 1, 1); PG8_STAGE(PG8_SB(1, 0), b3, voffB);
            PG8_BAR; PG8_WAIT_L(0); PG8_MMA(0, 1, At, B1); PG8_BAR;
            PG8_LDA(At, 1, 1); PG8_STAGE(PG8_SA(1, 0), a3, voffA);
            PG8_BAR; PG8_WAIT_L(0); PG8_MMA(1, 0, At, B0); PG8_BAR; PG8_SCHED;
            PG8_STAGE(PG8_SB(1, 1), b3 + hstepB, voffB);
            PG8_WAIT_V(6); PG8_BAR; PG8_MMA(1, 1, At, B1); PG8_BAR;
            }
        }
        if constexpr (ALIGN_EPI) { if (wr == 0) PG8_BAR; }
        if constexpr (!Epi::AFTER_DRAIN) { E(acc, cur, wr, wc, fr, fq); S.done(cur); }
        if (!has_next) break;
#pragma unroll
        for (int a = 0; a < 2; ++a)
#pragma unroll
            for (int b = 0; b < 2; ++b)
#pragma unroll
                for (int m = 0; m < 4; ++m)
#pragma unroll
                    for (int n = 0; n < 2; ++n) acc[a][b][m][n] = (f32x4){0.f, 0.f, 0.f, 0.f};
        cur = nxt; cA = nA; cB = nB; ++ui;
        if constexpr (ALIGN_EPI) { if (wr == 1) PG8_BAR; }
    }
    PG8_WAIT_V(0);
    if constexpr (!ALIGN_EPI) { if (wr == 0) PG8_BAR; }
    PG8_BAR;
    if constexpr (Epi::AFTER_DRAIN) { E.fused(acc, cur, wr, wc, fr, fq, lds, wid, lane); S.done(cur); }
#undef PG8_SA
#undef PG8_SB
#undef PG8_STAGE
#undef PG8_LDA
#undef PG8_LDB
#undef PG8_MMA
#undef PG8_WAIT_V
#undef PG8_WAIT_L
#undef PG8_BAR
#undef PG8_SCHED
}
}
#define PG8_SP2 true
#define PG8_ALIGN true

#define GAS __attribute__((address_space(1)))
#define LAS __attribute__((address_space(3)))
typedef unsigned short bf16;
typedef unsigned v4u __attribute__((ext_vector_type(4)));
typedef unsigned v2u __attribute__((ext_vector_type(2)));
typedef float f32x4 __attribute__((ext_vector_type(4)));
typedef float f32x2 __attribute__((ext_vector_type(2)));
typedef short bf16x8 __attribute__((ext_vector_type(8)));
#define RLX_AGENT __ATOMIC_RELAXED, __HIP_MEMORY_SCOPE_AGENT

constexpr int NWAVES = 8, NTHR = 512;
constexpr int SEQ = 8192, DM = 1024, MROWS = 16384, NMETA = 16;
constexpr int NIN = 3080, NPROJ = 3072;
constexpr int CU_ = 0, CV_ = 512, CO_ = 1024, CQS = 1536, CKS = 2048, CVS = 2560;
constexpr int OU_ = 0, OV_ = 512, OI_ = 1536, OF_ = 1540, OKS = 2056, OVS = 2568;
constexpr float EPS = 1e-6f;
constexpr int NEXP = 16384;

constexpr size_t KiB = 1024, MiB = 1024 * 1024;
constexpr size_t WS_CTL = 0, CTL_ZERO_BYTES = 64 * KiB;
constexpr size_t WS_RSTD1 = 64 * KiB;
constexpr size_t WS_SSQ   = WS_RSTD1 + 64 * KiB;
constexpr size_t WS_GI    = WS_SSQ + 1 * MiB;
constexpr size_t WS_GF    = WS_GI + 256 * KiB;
constexpr size_t WS_BT    = WS_GF + 256 * KiB;
constexpr size_t WS_NU    = WS_BT + 256 * KiB;
constexpr size_t WS_NS    = WS_NU + 512 * KiB;
constexpr size_t WS_AC    = WS_NS + 512 * KiB;
constexpr size_t WS_BC    = WS_AC + 4 * KiB;
constexpr size_t WS_MIN   = WS_BC + 4 * KiB;
constexpr size_t WS_PRM   = WS_MIN + 4 * KiB;
constexpr size_t WS_KM    = WS_PRM + 196 * KiB;
constexpr size_t WS_WQMT  = WS_KM + 32 * KiB;
constexpr size_t WS_WKMT  = WS_WQMT + 128 * KiB;
constexpr size_t WS_SKB   = WS_WKMT + 128 * KiB;
constexpr size_t WS_RSTDM = WS_SKB + 64 * KiB;
constexpr size_t WS_RS2 = WS_RSTDM + 4 * KiB;
constexpr size_t WS_ESC = WS_RS2 + 64 * KiB;
constexpr size_t WS_SMALL_END = WS_ESC + 128 * KiB;
static_assert(WS_SMALL_END <= 4 * MiB, "small region");
constexpr size_t WS_WINT = 4 * MiB, WS_WOUTT = 10 * MiB, WS_WQT = 12 * MiB;
constexpr size_t WS_EU = 16 * MiB, WS_EV = 32 * MiB;
constexpr size_t WS_PR = 80 * MiB;
constexpr size_t WS_QP = WS_PR;
constexpr size_t WS_QK = 176 * MiB;
constexpr size_t WS_XB = WS_QK, WS_H1B = WS_QK;
constexpr size_t WS_U = 208 * MiB;
constexpr size_t WS_PRMP = WS_U, WS_TK = WS_U;
constexpr size_t WS_CB = 240 * MiB;
constexpr size_t WS_END = 256 * MiB;

constexpr int LDS_BYTES = 147456, LDSCTL_OFF = LDS_BYTES - 256;

__device__ __forceinline__ unsigned f2bf(float f) { unsigned u = __builtin_bit_cast(unsigned, f); return (u + 0x7fffu + ((u >> 16) & 1u)) >> 16; }
__device__ __forceinline__ unsigned pk2(float lo, float hi) { return f2bf(lo) | (f2bf(hi) << 16); }
__device__ __forceinline__ unsigned pk_fp8x4(f32x4 v) {
    const float a = fminf(fmaxf(v[0], -448.f), 448.f), b = fminf(fmaxf(v[1], -448.f), 448.f), c = fminf(fmaxf(v[2], -448.f), 448.f), d = fminf(fmaxf(v[3], -448.f), 448.f);
    int r = __builtin_amdgcn_cvt_pk_fp8_f32(a, b, 0, false); r = __builtin_amdgcn_cvt_pk_fp8_f32(c, d, r, true); return (unsigned)r; }
__device__ __forceinline__ unsigned pk_fp4x8(f32x4 a, f32x4 b) {
    unsigned r = 0u; r = __builtin_amdgcn_cvt_scalef32_pk_fp4_f32(r, a[0], a[1], 1.0f, 0); r = __builtin_amdgcn_cvt_scalef32_pk_fp4_f32(r, a[2], a[3], 1.0f, 1);
    r = __builtin_amdgcn_cvt_scalef32_pk_fp4_f32(r, b[0], b[1], 1.0f, 2); r = __builtin_amdgcn_cvt_scalef32_pk_fp4_f32(r, b[2], b[3], 1.0f, 3); return r; }
__device__ __forceinline__ float bf2f(unsigned h) { return __builtin_bit_cast(float, h << 16); }
template <int CTRL> __device__ __forceinline__ float dpp_f(float v) { return __builtin_bit_cast(float, __builtin_amdgcn_update_dpp(0, __builtin_bit_cast(int, v), CTRL, 0xf, 0xf, true)); }
__device__ __forceinline__ float rdl_f(float v, int l) { return __builtin_bit_cast(float, __builtin_amdgcn_readlane(__builtin_bit_cast(int, v), l)); }
__device__ __forceinline__ float wave_sum(float v) {
    v += dpp_f<0xB1>(v); v += dpp_f<0x4E>(v); v += dpp_f<0x124>(v); v += dpp_f<0x128>(v);
    return (rdl_f(v, 0) + rdl_f(v, 16)) + (rdl_f(v, 32) + rdl_f(v, 48));
}
__device__ __forceinline__ float wave_max(float v) {
    v = fmaxf(v, dpp_f<0xB1>(v)); v = fmaxf(v, dpp_f<0x4E>(v)); v = fmaxf(v, dpp_f<0x124>(v)); v = fmaxf(v, dpp_f<0x128>(v));
    return fmaxf(fmaxf(rdl_f(v, 0), rdl_f(v, 16)), fmaxf(rdl_f(v, 32), rdl_f(v, 48)));
}
__device__ __forceinline__ float row16_sum(float v) { v += dpp_f<0xB1>(v); v += dpp_f<0x4E>(v); v += dpp_f<0x124>(v); v += dpp_f<0x128>(v); return v; }
__device__ __forceinline__ float row16_min(float v) { v = fminf(v, dpp_f<0xB1>(v)); v = fminf(v, dpp_f<0x4E>(v)); v = fminf(v, dpp_f<0x124>(v)); v = fminf(v, dpp_f<0x128>(v)); return v; }
template <int CTRL> __device__ __forceinline__ float dpp_shr(float v, float idv) { return __builtin_bit_cast(float, __builtin_amdgcn_update_dpp(__builtin_bit_cast(int, idv), __builtin_bit_cast(int, v), CTRL, 0xf, 0xf, false)); }
__device__ __forceinline__ float wave_scan_sum(float v, int lane) {
    v += dpp_shr<0x111>(v, 0.f); v += dpp_shr<0x112>(v, 0.f); v += dpp_shr<0x114>(v, 0.f); v += dpp_shr<0x118>(v, 0.f);
    const float r0 = rdl_f(v, 15), r1 = rdl_f(v, 31), r2 = rdl_f(v, 47);
    return v + (lane < 16 ? 0.f : lane < 32 ? r0 : lane < 48 ? r0 + r1 : (r0 + r1) + r2);
}
__device__ __forceinline__ float wave_scan_max(float v, int lane) {
    const float NI = -3.0e38f;
    v = fmaxf(v, dpp_shr<0x111>(v, NI)); v = fmaxf(v, dpp_shr<0x112>(v, NI)); v = fmaxf(v, dpp_shr<0x114>(v, NI)); v = fmaxf(v, dpp_shr<0x118>(v, NI));
    const float r0 = rdl_f(v, 15), r1 = rdl_f(v, 31), r2 = rdl_f(v, 47);
    return fmaxf(v, lane < 16 ? NI : lane < 32 ? r0 : lane < 48 ? fmaxf(r0, r1) : fmaxf(fmaxf(r0, r1), r2));
}
__device__ __forceinline__ float logsigmoidf_(float a) { return fminf(a, 0.f) - log1pf(__expf(-fabsf(a))); }
__device__ __forceinline__ float siluf_(float a) { return a / (1.f + __expf(-a)); }
template <int KS> __device__ __forceinline__ f32x4 mma_rows(const LAS bf16* a, const LAS bf16* b, f32x4 acc) {
#pragma unroll
    for (int k = 0; k < KS; ++k) { const bf16x8 av = *(const LAS bf16x8*)(a + 32 * k), bv = *(const LAS bf16x8*)(b + 32 * k); acc = __builtin_amdgcn_mfma_f32_16x16x32_bf16(av, bv, acc, 0, 0, 0); }
    return acc;
}
#define XB_TMO      128
#define XB_XCNT(j)  (256  + 64 * (j))
#define XB_XSUB(j)  (1280 + 64 * (j))
#define XB_XGEN(j)  (2304 + 64 * (j))
#define XB_TOP      3328
#define XB_TOPGEN   3392
#define XCD_BAR_WORDS 3456
#define XB_SPIN_CAP (1u << 18)

__device__ __forceinline__ unsigned xb_ld(unsigned* p)              { return __hip_atomic_load(p, __ATOMIC_RELAXED, __HIP_MEMORY_SCOPE_AGENT); }
__device__ __forceinline__ unsigned xb_add(unsigned* p, unsigned v) { return __hip_atomic_fetch_add(p, v, __ATOMIC_RELAXED, __HIP_MEMORY_SCOPE_AGENT); }
__device__ __forceinline__ unsigned xb_xcc_id() { return (unsigned)__builtin_amdgcn_s_getreg((3 << 11) | 20) & 0xFu; }
#define XB_SPIN(cond, bar) do { unsigned _sp = 0; while (cond) { __builtin_amdgcn_s_sleep(1); \
    if ((++_sp & 255u) == 0u) { if (xb_ld(&(bar)[XB_TMO])) break; if (_sp > XB_SPIN_CAP) { atomicAdd(&(bar)[XB_TMO], 1u); break; } } } } while (0)

struct XcdBarrier {
    unsigned* bar; unsigned x;
    volatile LAS unsigned* st;
};

__device__ __forceinline__ XcdBarrier xcd_barrier_post(unsigned* bar, volatile LAS unsigned* st) {
    XcdBarrier b; b.bar = bar; b.x = xb_xcc_id(); b.st = st;
    if (threadIdx.x == 0) (void)xb_add(&bar[XB_XCNT(b.x)], 1u);
    return b;
}
__device__ __forceinline__ void xcd_barrier_complete(unsigned* bar, unsigned x, unsigned& nloc, unsigned& nx) {
    const unsigned G = gridDim.x * gridDim.y * gridDim.z;
    unsigned sum, cnt, mine, sp = 0u;
    for (;;) {
        sum = 0u; cnt = 0u; mine = 0u;
#pragma unroll
        for (unsigned j = 0; j < 16; ++j) { const unsigned c = xb_ld(&bar[XB_XCNT(j)]); sum += c; cnt += (c > 0u) ? 1u : 0u; mine = (j == x) ? c : mine; }
        if (sum == G) break;
        __builtin_amdgcn_s_sleep(1);
        if ((++sp & 255u) == 0u) { if (xb_ld(&bar[XB_TMO])) break; if (sp > XB_SPIN_CAP) { atomicAdd(&bar[XB_TMO], 1u); break; } }
    }
    nloc = mine > 0u ? mine : 1u; nx = cnt > 0u ? cnt : 1u;
}

__device__ __forceinline__ void xcd_barrier(const XcdBarrier& b) {
    asm volatile("s_waitcnt vmcnt(0)" ::: "memory");
    __syncthreads();
    if (threadIdx.x == 0) {
        unsigned* bar = b.bar;
        __builtin_amdgcn_s_waitcnt(0);
        unsigned nloc = b.st[0], nx = b.st[1];
        if (nloc == 0u) { xcd_barrier_complete(bar, b.x, nloc, nx); b.st[0] = nloc; b.st[1] = nx; }
        const unsigned old = xb_add(&bar[XB_XSUB(b.x)], 1u);
        const unsigned gen = old / nloc;
        if (old + 1u == (gen + 1u) * nloc) {
            __builtin_amdgcn_fence(__ATOMIC_RELEASE, "agent");
            asm volatile("s_waitcnt vmcnt(0)" ::: "memory");
            const unsigned og = xb_add(&bar[XB_TOP], 1u);
            const unsigned tg = og / nx;
            if (og + 1u == (tg + 1u) * nx) xb_add(&bar[XB_TOPGEN], 1u);
            else XB_SPIN(xb_ld(&bar[XB_TOPGEN]) == tg, bar);
            __builtin_amdgcn_fence(__ATOMIC_ACQUIRE, "agent");
            xb_add(&bar[XB_XGEN(b.x)], 1u);
            asm volatile("s_waitcnt vmcnt(0)" ::: "memory");
        } else {
            XB_SPIN(xb_ld(&bar[XB_XGEN(b.x)]) == gen, bar);
            __builtin_amdgcn_fence(__ATOMIC_ACQUIRE, "agent");
            asm volatile("s_waitcnt vmcnt(0)" ::: "memory");
        }
    }
    __syncthreads();
}

struct Params { const float* in[20]; float* out; unsigned char* ws; };
struct Frame {
    LAS unsigned char* lds;
    int tid, lane, wave, vcu, G;
    const float *x, *meta, *g_mix, *w_in, *conv_w, *conv_b, *w_qm, *w_km, *b_i, *b_f, *skip, *gn_g, *sb_g, *w_out, *g_ffn, *w_query, *sub_keys, *eu, *ev, *g_fin;
    float* out; unsigned char* ws;
};
#define WSP(T, off) ((T*)(F.ws + (off)))

__device__ __forceinline__ void p0_transpose_item(const float* W, int ldw, int k0, int srccol0, bf16* WT, int K, int dstrow0, const float* gk, float cs, LAS float* scr, int lane, const float* META, float* PRMP) {
#pragma unroll 8
    for (int i = 0; i < 32; ++i) { const int kk = 2 * i + (lane >> 5); const float sc = gk ? gk[k0 + kk] * cs : cs; scr[kk * 33 + (lane & 31)] = W[(size_t)(k0 + kk) * ldw + srccol0 + (lane & 31)] * sc; }
    if (META) { LAS float* mb = scr + 64 * 33;
#pragma unroll
        for (int i = 0; i < 16; ++i) mb[i * 64 + lane] = META[(size_t)i * DM + k0 + lane]; }
    const int c = lane & 7;
#pragma unroll
    for (int j = 0; j < 4; ++j) { const int n = (lane >> 3) + 8 * j; const LAS float* s = scr + (8 * c) * 33 + n;
        v4u o; o.x = pk2(s[0 * 33], s[1 * 33]); o.y = pk2(s[2 * 33], s[3 * 33]); o.z = pk2(s[4 * 33], s[5 * 33]); o.w = pk2(s[6 * 33], s[7 * 33]);
        *(v4u*)(WT + (size_t)(dstrow0 + n) * K + k0 + 8 * c) = o; }
    if (META) { const LAS float* mb = scr + 64 * 33; const int n = lane & 31, r0 = (lane >> 5) * 8; float acc[8];
#pragma unroll
        for (int r = 0; r < 8; ++r) acc[r] = 0.f;
#pragma unroll 4
        for (int kk = 0; kk < 64; kk += 4) { const float w0 = scr[kk * 33 + n], w1 = scr[(kk + 1) * 33 + n], w2 = scr[(kk + 2) * 33 + n], w3 = scr[(kk + 3) * 33 + n];
#pragma unroll
            for (int r = 0; r < 8; ++r) { const f32x4 m = *(const LAS f32x4*)(mb + (r0 + r) * 64 + kk); acc[r] += (m[0] * w0 + m[1] * w1) + (m[2] * w2 + m[3] * w3); } }
#pragma unroll
        for (int r = 0; r < 8; ++r) PRMP[((size_t)(k0 >> 6) * 16 + r0 + r) * NIN + srccol0 + n] = acc[r]; }
}

__device__ __forceinline__ void p0_pack_row_i4(Frame& F, f32x4 (&a)[4], const f32x4 (&gf)[4], int r, int lane) {
    const bool isu = r < NEXP; float ss = 0.f;
#pragma unroll
    for (int j = 0; j < 4; ++j) { if (isu) a[j] = a[j] * gf[j]; ss += (a[j][0] * a[j][0] + a[j][1] * a[j][1]) + (a[j][2] * a[j][2] + a[j][3] * a[j][3]); }
    ss = wave_sum(ss);
    const float rms = sqrtf(ss * (1.0f / DM)); const float step = rms > 0.f ? 0.3125f * rms : 1.0f, inv = 1.0f / step;
    v2u o;
#pragma unroll
    for (int d = 0; d < 2; ++d) { unsigned w = 0u;
#pragma unroll
        for (int n = 0; n < 8; ++n) { const int i = 8 * d + n; const float q = floorf(a[i >> 2][i & 3] * inv); const int k = (int)fminf(fmaxf(q, -8.f), 7.f); w |= ((unsigned)k & 0xfu) << (4 * n); }
        o[d] = w; }
    *((v2u*)(F.ws + (isu ? WS_EU : WS_EV) + (size_t)(r & (NEXP - 1)) * (DM / 2)) + lane) = o;
    if (lane == 0) WSP(float, WS_ESC)[r] = step;
}

__device__ __forceinline__ void p0_prologue(Frame& F) {
    LAS float* scr = (LAS float*)(F.lds + 32768 + F.wave * 14336);
    LAS float* wg = (LAS float*)F.lds;
    const int gw = F.vcu * NWAVES + F.wave, NGW = F.G * NWAVES, lane = F.lane;
    for (int i = F.tid; i < 8192; i += NTHR) { const int jj = i >> 10, k = i & 1023; wg[i] = F.w_in[(size_t)k * NIN + OI_ + jj] * F.g_mix[k]; }
    {
        constexpr int I_IN = 16 * 96, I_OUT = 16 * 32, I_Q = 16 * 64, I_M = 2 * 4;
        constexpr int NITEMS = I_IN + I_OUT + I_Q + 8 * I_M;
        for (int it = gw; it < NITEMS; it += NGW) {
            int r = it;
            if (r < I_IN) { const int kb = r / 96, nb = r % 96; const int n0 = 32 * nb; p0_transpose_item(F.w_in, NIN, 64 * kb, n0 + (n0 >= 1536 ? 8 : 0), WSP(bf16, WS_WINT), DM, n0, F.g_mix, 1.f, scr, lane, F.meta, WSP(float, WS_PRMP)); continue; } r -= I_IN;
            if (r < I_OUT) { const int kb = r / 32, nb = r % 32; p0_transpose_item(F.w_out, DM, 64 * kb, 32 * nb, WSP(bf16, WS_WOUTT), DM, 32 * nb, nullptr, 1.f, scr, lane, nullptr, nullptr); continue; } r -= I_OUT;
            if (r < I_Q) { const int kb = r / 64, nb = r % 64; p0_transpose_item(F.w_query, 2048, 64 * kb, 32 * nb, WSP(bf16, WS_WQT), DM, 32 * nb, F.g_ffn, 1.f, scr, lane, nullptr, nullptr); continue; } r -= I_Q;
            { const int mat = r / I_M, q = r % I_M, kb = q / 4, nb = q % 4, h = mat & 3;
              const float* W = (mat < 4 ? F.w_qm : F.w_km) + (size_t)h * 16384; bf16* WT = WSP(bf16, mat < 4 ? WS_WQMT : WS_WKMT) + (size_t)h * 16384;
              p0_transpose_item(W, 128, 64 * kb, 32 * nb, WT, 128, 32 * nb, nullptr, mat < 4 ? 1.f : 0.08838834764831845f, scr, lane, nullptr, nullptr); }
        }
        for (int i = gw * 64 + lane; i < 32768 / 4; i += NGW * 64) { const f32x4 v = ((const f32x4*)F.sub_keys)[i]; v2u o; o.x = pk2(v[0], v[1]); o.y = pk2(v[2], v[3]); ((v2u*)WSP(bf16, WS_SKB))[i] = o; }
    }
    __syncthreads();
    {
        float bi[4], bfv[4];
#pragma unroll
        for (int j = 0; j < 4; ++j) { bi[j] = F.b_i[j]; bfv[j] = F.b_f[j]; }
        f32x4 v[4], vn[4];
        { const f32x4* xr = (const f32x4*)(F.x + (size_t)gw * DM) + lane;
#pragma unroll
          for (int j = 0; j < 4; ++j) v[j] = xr[64 * j]; }
        for (int m = gw; m < MROWS + NMETA; m += NGW) {
            const int mn = m + NGW;
            if (mn < MROWS + NMETA) { const f32x4* xr = (const f32x4*)(mn < MROWS ? F.x + (size_t)mn * DM : F.meta + (size_t)(mn - MROWS) * DM) + lane;
#pragma unroll
                for (int j = 0; j < 4; ++j) vn[j] = xr[64 * j]; }
            float ss = 0.f; float g8[8];
#pragma unroll
            for (int jj = 0; jj < 8; ++jj) g8[jj] = 0.f;
#pragma unroll
            for (int j = 0; j < 4; ++j) ss += (v[j][0] * v[j][0] + v[j][1] * v[j][1]) + (v[j][2] * v[j][2] + v[j][3] * v[j][3]);
#pragma unroll
            for (int j = 0; j < 4; ++j)
#pragma unroll
                for (int jj = 0; jj < 8; ++jj) { const f32x4 w = *(const LAS f32x4*)(wg + jj * 1024 + 256 * j + 4 * lane); g8[jj] += (v[j][0] * w[0] + v[j][1] * w[1]) + (v[j][2] * w[2] + v[j][3] * w[3]); }
            ss = wave_sum(ss);
#pragma unroll
            for (int jj = 0; jj < 8; ++jj) g8[jj] = wave_sum(g8[jj]);
            const float rstd = 1.0f / sqrtf(ss * (1.0f / DM) + EPS);
            if (m < MROWS) {
                v2u* o8 = (v2u*)(WSP(bf16, WS_XB) + (size_t)m * DM) + lane;
#pragma unroll
                for (int j = 0; j < 4; ++j) { v2u o; o.x = pk2(v[j][0], v[j][1]); o.y = pk2(v[j][2], v[j][3]); o8[64 * j] = o; }
                if (lane == 0) WSP(float, WS_RSTD1)[m] = rstd;
#pragma unroll
                for (int jj = 0; jj < 4; ++jj) if (lane == jj) { WSP(float, WS_GI)[m * 4 + jj] = g8[jj] * rstd + bi[jj]; WSP(float, WS_GF)[m * 4 + jj] = logsigmoidf_(g8[4 + jj] * rstd + bfv[jj]); }
            } else {
                const int r = m - MROWS;
                if (lane == 0) WSP(float, WS_RSTDM)[r] = rstd;
#pragma unroll
                for (int jj = 0; jj < 8; ++jj) if (lane == jj) WSP(float, WS_PRM)[(size_t)r * NIN + OI_ + jj] = g8[jj] * rstd;
            }
#pragma unroll
            for (int j = 0; j < 4; ++j) v[j] = vn[j];
        }
    }
    {
        f32x4 gf[4];
#pragma unroll
        for (int j = 0; j < 4; ++j) gf[j] = ((const f32x4*)F.g_ffn)[lane + 64 * j];
        for (int r = gw; r < 2 * NEXP; r += 2 * NGW) {
            const int r2 = r + NGW; const bool has2 = r2 < 2 * NEXP;
            const f32x4* s1 = (const f32x4*)((r >= NEXP ? F.ev : F.eu) + (size_t)(r & (NEXP - 1)) * DM) + lane;
            const f32x4* s2 = (const f32x4*)((r2 >= NEXP ? F.ev : F.eu) + (size_t)(r2 & (NEXP - 1)) * DM) + lane;
            f32x4 a[4], b[4];
#pragma unroll
            for (int j = 0; j < 4; ++j) { a[j] = s1[64 * j]; if (has2) b[j] = s2[64 * j]; }
            if (r < NEXP) p0_pack_row_i4(F, a, gf, r, lane);
            else { v2u o; o[0] = pk_fp4x8(a[0] * 4.0f, a[1] * 4.0f); o[1] = pk_fp4x8(a[2] * 4.0f, a[3] * 4.0f); *((v2u*)(F.ws + WS_EV + (size_t)(r - NEXP) * (DM / 2)) + lane) = o; }
            if (has2) { if (r2 < NEXP) p0_pack_row_i4(F, b, gf, r2, lane);
                else { v2u o; o[0] = pk_fp4x8(b[0] * 4.0f, b[1] * 4.0f); o[1] = pk_fp4x8(b[2] * 4.0f, b[3] * 4.0f); *((v2u*)(F.ws + WS_EV + (size_t)(r2 - NEXP) * (DM / 2)) + lane) = o; } }
        }
    }
}

__device__ __forceinline__ void p1_meta_tail(Frame& F) {
    const float* P = WSP(float, WS_PRMP); int tid_ = F.tid; asm volatile("" : "+v"(tid_)); const int tid = tid_;
    const int nrounds = (96 + F.G - 1) / F.G;
    for (int rnd = 0; rnd < nrounds; ++rnd) { const int item = F.vcu + rnd * F.G; if (item >= 96) break;
        if (item < 64) {
            const int h = item >> 4, t = item & 15;
            LAS float* um = (LAS float*)F.lds; LAS float* cm = um + 512; LAS float* part = cm + 128;
            __syncthreads();
            { const int j = tid >> 7, ch = tid & 127, tt = t - 3 + j; float s = 0.f;
              if (tt >= 0) {
#pragma unroll 4
                  for (int kp = 0; kp < 16; ++kp) s += P[(size_t)(kp * 16 + tt) * NIN + OU_ + h * 128 + ch];
                  s *= WSP(float, WS_RSTDM)[tt]; }
              um[j * 128 + ch] = s; }
            __syncthreads();
            if (tid < 128) { const int c = h * 128 + tid; float s = F.conv_b[c];
#pragma unroll
                for (int j = 0; j < 4; ++j) { if (t - 3 + j >= 0) s += F.conv_w[j * 512 + c] * um[j * 128 + tid]; }
                cm[tid] = siluf_(s); }
            __syncthreads();
            { const int e = tid & 127, dp = tid >> 7; float s = 0.f;
#pragma unroll 4
              for (int d = 32 * dp; d < 32 * dp + 32; ++d) s += cm[d] * F.w_km[(size_t)h * 16384 + d * 128 + e];
              part[dp * 128 + e] = s; }
            __syncthreads();
            if (tid < 128) WSP(float, WS_KM)[(h * 16 + t) * 128 + tid] = ((part[tid] + part[128 + tid]) + (part[256 + tid] + part[384 + tid])) * 0.08838834764831845f;
        } else {
            const int part = item - 64, per = 16 * NIN / 32;
            for (int i = part * per + tid; i < (part + 1) * per; i += NTHR) { const int r = i / NIN, n = i - r * NIN; if (n >= OI_ && n < OI_ + 8) continue; float s = 0.f;
#pragma unroll 4
                for (int kp = 0; kp < 16; ++kp) s += P[(size_t)kp * 16 * NIN + i];
                WSP(float, WS_PRM)[i] = s * WSP(float, WS_RSTDM)[r]; }
        }
    }
    __syncthreads();
}

constexpr int L2_WQ = 0, L2_WK = 34816, L2_C = 69632, L2_KT = 87040, L2_WV = 105472, L2_U = 123904, L2_TAB = 141056;
__device__ __forceinline__ void p2_mlstm_local(Frame& F) {
    const int bh = F.vcu >> 5, b = bh >> 2, h = bh & 3, tid = F.tid, lane = F.lane, wave = F.wave, g = lane >> 4, l15 = lane & 15;
    LAS bf16* WQ = (LAS bf16*)(F.lds + L2_WQ); LAS bf16* WK = (LAS bf16*)(F.lds + L2_WK); LAS bf16* Cs = (LAS bf16*)(F.lds + L2_C);
    LAS bf16* KT = (LAS bf16*)(F.lds + L2_KT); LAS bf16* WV = (LAS bf16*)(F.lds + L2_WV); LAS bf16* Us = (LAS bf16*)(F.lds + L2_U);
    LAS float* TAB = (LAS float*)(F.lds + L2_TAB);
    const bf16* PR = WSP(bf16, WS_PR); const float* PRM = WSP(float, WS_PRM);
    for (int i = tid; i < 2048; i += NTHR) { const int e = i >> 4, c8 = (i & 15) * 8;
        *(LAS v4u*)(WQ + e * 136 + c8) = *(const v4u*)(WSP(bf16, WS_WQMT) + (size_t)h * 16384 + e * 128 + c8);
        *(LAS v4u*)(WK + e * 136 + c8) = *(const v4u*)(WSP(bf16, WS_WKMT) + (size_t)h * 16384 + e * 128 + c8); }
    v4u ur[3], vr[2]; float gli = 0.f, glf = 0.f;
#define P2_FETCH_U(chunkx) do { const int _m0 = b * SEQ + (chunkx) * 64; _Pragma("unroll") for (int _k = 0; _k < 3; ++_k) { const int _i = tid + NTHR * _k; if (_i < 67 * 16) { const int _rr = _i >> 4, _c8 = (_i & 15) * 8, _t = _rr - 3; \
            if ((chunkx) == 0 && _t < 0) { const float* _s = PRM + (size_t)(NMETA + _t) * NIN + OU_ + h * 128 + _c8; ur[_k].x = pk2(_s[0], _s[1]); ur[_k].y = pk2(_s[2], _s[3]); ur[_k].z = pk2(_s[4], _s[5]); ur[_k].w = pk2(_s[6], _s[7]); } \
            else ur[_k] = *(const v4u*)(PR + (size_t)(_m0 + _t) * NPROJ + CU_ + h * 128 + _c8); } } \
        if (tid < 64) { gli = WSP(float, WS_GI)[(_m0 + tid) * 4 + h]; glf = WSP(float, WS_GF)[(_m0 + tid) * 4 + h]; } } while (0)
#define P2_FETCH_V(chunkx) do { const int _m0 = b * SEQ + (chunkx) * 64; _Pragma("unroll") for (int _k = 0; _k < 2; ++_k) { const int _i = tid + NTHR * _k; vr[_k] = *(const v4u*)(PR + (size_t)(_m0 + (_i >> 4)) * NPROJ + CV_ + h * 128 + (_i & 15) * 8); } } while (0)
    P2_FETCH_U(F.vcu & 31); P2_FETCH_V(F.vcu & 31);
    for (int ui = 0; ui < 4; ++ui) {
        const int chunk = (F.vcu & 31) + 32 * ui; const int m0 = b * SEQ + chunk * 64;
        __syncthreads();
#pragma unroll
        for (int k = 0; k < 3; ++k) { const int i = tid + NTHR * k; if (i < 67 * 16) *(LAS v4u*)(Us + (i >> 4) * 128 + (i & 15) * 8) = ur[k]; }
        if (tid < 64) { TAB[tid] = gli; TAB[64 + tid] = glf; }
        if (ui + 1 < 4) P2_FETCH_U(chunk + 32);
        __syncthreads();
        { const int ch = tid & 127, c = h * 128 + ch; const float w0 = F.conv_w[c], w1 = F.conv_w[512 + c], w2 = F.conv_w[1024 + c], w3 = F.conv_w[1536 + c], cb = F.conv_b[c];
#pragma unroll 4
          for (int jj = 0; jj < 16; ++jj) { const int t = (tid >> 7) + 4 * jj;
              const float s = cb + w0 * bf2f(Us[t * 128 + ch]) + w1 * bf2f(Us[(t + 1) * 128 + ch]) + w2 * bf2f(Us[(t + 2) * 128 + ch]) + w3 * bf2f(Us[(t + 3) * 128 + ch]);
              const unsigned cv = f2bf(siluf_(s)); Cs[t * 136 + ch] = (bf16)cv; } }
        if (wave == 0) {
            const float li = TAB[lane], lf = TAB[64 + lane]; float bs = lf;
            bs = wave_scan_sum(bs, lane);
            const float bL = rdl_f(bs, 63); const float gg = bL - bs + li; const float Bc = wave_max(gg);
            TAB[128 + lane] = bs; TAB[192 + lane] = __expf(gg - Bc);
            WSP(float, WS_BT)[(m0 + lane) * 4 + h] = bs;
            if (lane == 0) { WSP(float, WS_AC)[bh * 128 + chunk] = bL; WSP(float, WS_BC)[bh * 128 + chunk] = Bc; }
        }
        __syncthreads();
        {
            bf16* Qg = WSP(bf16, WS_QK); bf16* Kg = Qg + (size_t)MROWS * 512;
#pragma unroll
            for (int tt = 0; tt < 4; ++tt) {
                f32x4 aq = {0.f, 0.f, 0.f, 0.f}, ak = {0.f, 0.f, 0.f, 0.f};
                aq = mma_rows<4>(WQ + (16 * wave + l15) * 136 + 8 * g, Cs + (16 * tt + l15) * 136 + 8 * g, aq);
                ak = mma_rows<4>(WK + (16 * wave + l15) * 136 + 8 * g, Cs + (16 * tt + l15) * 136 + 8 * g, ak);
                const int t = 16 * tt + l15, e0 = 16 * wave + 4 * g; const size_t go = (size_t)(m0 + t) * 512 + h * 128 + e0;
                v2u oq; oq.x = pk2(aq[0], aq[1]); oq.y = pk2(aq[2], aq[3]); *(v2u*)(Qg + go) = oq;
                v2u ok; ok.x = pk2(ak[0], ak[1]); ok.y = pk2(ak[2], ak[3]); *(v2u*)(Kg + go) = ok;
                KT[(e0 + 0) * 72 + t] = (bf16)(ok.x & 0xffffu); KT[(e0 + 1) * 72 + t] = (bf16)(ok.x >> 16); KT[(e0 + 2) * 72 + t] = (bf16)(ok.y & 0xffffu); KT[(e0 + 3) * 72 + t] = (bf16)(ok.y >> 16);
            }
            for (int i = tid; i < 1024; i += NTHR) { const int t = i >> 4, c8 = (i & 15) * 8; *(v4u*)(WSP(bf16, WS_CB) + (size_t)(m0 + t) * 512 + h * 128 + c8) = *(const LAS v4u*)(Cs + t * 136 + c8); }
#pragma unroll
            for (int k = 0; k < 2; ++k) { const int i = tid + NTHR * k; const int s = i >> 4, e8 = (i & 15) * 8; const v4u pv = vr[k]; const float w = TAB[192 + s];
#pragma unroll
                for (int q = 0; q < 4; ++q) { WV[(e8 + 2 * q) * 72 + s] = (bf16)f2bf(bf2f(pv[q] & 0xffffu) * w); WV[(e8 + 2 * q + 1) * 72 + s] = (bf16)f2bf(__uint_as_float(pv[q] & 0xffff0000u) * w); } }
            if (ui + 1 < 4) P2_FETCH_V(chunk + 32);
        }
        __syncthreads();
        {
            bf16* Ug = WSP(bf16, WS_U) + (size_t)(bh * 128 + chunk) * 16384;
#pragma unroll
            for (int et = 0; et < 8; ++et) { f32x4 a = {0.f, 0.f, 0.f, 0.f};
                a = mma_rows<2>(KT + (16 * wave + l15) * 72 + 8 * g, WV + (16 * et + l15) * 72 + 8 * g, a);
                v2u o; o.x = pk2(a[0], a[1]); o.y = pk2(a[2], a[3]); *(v2u*)(Ug + (size_t)(16 * et + l15) * 128 + 16 * wave + 4 * g) = o; }
            { const int d = tid >> 2, q4 = tid & 3; float s = 0.f;
#pragma unroll
              for (int t = 16 * q4; t < 16 * q4 + 16; ++t) s += bf2f(KT[d * 72 + t]) * TAB[192 + t];
              s += dpp_f<0xB1>(s); s += dpp_f<0x4E>(s);
              if (q4 == 0) WSP(float, WS_NU)[(size_t)(bh * 128 + chunk) * 128 + d] = s; }
        }
    }
#undef P2_FETCH_U
#undef P2_FETCH_V
    __syncthreads();
}

constexpr int L3_K = 0, L3_VT = 9216, L3_MIN = 18432;
__device__ __forceinline__ void p2_sb_attention(Frame& F) {
    const int tid = F.tid, lane = F.lane, wave = F.wave, g = lane >> 4, l15 = lane & 15;
    LAS bf16* Ks = (LAS bf16*)(F.lds + L3_K); LAS bf16* VT = (LAS bf16*)(F.lds + L3_VT); LAS float* MINR = (LAS float*)(F.lds + L3_MIN);
    bf16* PR = WSP(bf16, WS_PR); const float* PRM = WSP(float, WS_PRM);
    const int bhd = F.vcu >> 4, b = bhd >> 3, hd = bhd & 7;
    for (int ui = 0; ui < 4; ++ui) {
        const int qb = (F.vcu & 15) + 16 * ui;
        const int tq = 128 * qb + 16 * wave + l15;
        const size_t qrow = (size_t)(b * SEQ + tq) * NPROJ;
        const bf16x8 q0 = *(const bf16x8*)(PR + qrow + CQS + hd * 64 + 8 * g), q1 = *(const bf16x8*)(PR + qrow + CQS + hd * 64 + 32 + 8 * g);
        f32x4 o[4];
#pragma unroll
        for (int i = 0; i < 4; ++i) o[i] = (f32x4){0.f, 0.f, 0.f, 0.f};
        float R = 0.f;
        const int kr = tid >> 3, c8 = (tid & 7) * 8;
        v4u kn, vn;
#define SB_FETCH(jbx) do { if ((jbx) >= 0) { const size_t _ro = (size_t)(b * SEQ + 64 * (jbx) + kr) * NPROJ + hd * 64 + c8; kn = *(const v4u*)(PR + _ro + CKS); vn = *(const v4u*)(PR + _ro + CVS); } \
            else if (kr < NMETA) { const float* _sk = PRM + (size_t)kr * NIN + OKS + hd * 64 + c8; const float* _sv = PRM + (size_t)kr * NIN + OVS + hd * 64 + c8; \
                kn.x = pk2(_sk[0], _sk[1]); kn.y = pk2(_sk[2], _sk[3]); kn.z = pk2(_sk[4], _sk[5]); kn.w = pk2(_sk[6], _sk[7]); vn.x = pk2(_sv[0], _sv[1]); vn.y = pk2(_sv[2], _sv[3]); vn.z = pk2(_sv[4], _sv[5]); vn.w = pk2(_sv[6], _sv[7]); } \
            else { kn = (v4u){0u, 0u, 0u, 0u}; vn = kn; } } while (0)
        SB_FETCH(2 * qb + 1);
        for (int jb = 2 * qb + 1; jb >= -1; --jb) {
            __syncthreads();
            if (jb < 2 * qb + 1) { float mn = MINR[0];
#pragma unroll
                for (int w = 1; w < 8; ++w) mn = fminf(mn, MINR[w]);
                if (mn >= 90.f) break; }
            { const v4u kv = kn, vv = vn;
              *(LAS v4u*)(Ks + kr * 72 + c8) = kv;
              VT[(c8 + 0) * 72 + kr] = (bf16)(vv.x & 0xffffu); VT[(c8 + 1) * 72 + kr] = (bf16)(vv.x >> 16); VT[(c8 + 2) * 72 + kr] = (bf16)(vv.y & 0xffffu); VT[(c8 + 3) * 72 + kr] = (bf16)(vv.y >> 16);
              VT[(c8 + 4) * 72 + kr] = (bf16)(vv.z & 0xffffu); VT[(c8 + 5) * 72 + kr] = (bf16)(vv.z >> 16); VT[(c8 + 6) * 72 + kr] = (bf16)(vv.w & 0xffffu); VT[(c8 + 7) * 72 + kr] = (bf16)(vv.w >> 16); }
            if (jb > -1) SB_FETCH(jb - 1);
            __syncthreads();
            if (jb == 2 * qb + 1 && wave < 4) { if (lane == 0) MINR[wave] = 0.f; continue; }
            float z[16];
#pragma unroll
            for (int i = 0; i < 4; ++i) { const LAS bf16* kp = Ks + (16 * (l15 >> 2) + 4 * i + (l15 & 3)) * 72 + 8 * g;
                f32x4 a = {0.f, 0.f, 0.f, 0.f};
                a = __builtin_amdgcn_mfma_f32_16x16x32_bf16(*(const LAS bf16x8*)kp, q0, a, 0, 0, 0);
                a = __builtin_amdgcn_mfma_f32_16x16x32_bf16(*(const LAS bf16x8*)(kp + 32), q1, a, 0, 0, 0);
                z[4 * i + 0] = a[0] * 0.125f; z[4 * i + 1] = a[1] * 0.125f; z[4 * i + 2] = a[2] * 0.125f; z[4 * i + 3] = a[3] * 0.125f; }
            const int kbase = (jb >= 0) ? 64 * jb + 16 * g : 16 * g;
            float cum[16]; float run = 0.f;
#pragma unroll
            for (int n = 15; n >= 0; --n) { const bool ok = (jb >= 0) ? (kbase + n < tq) : (kbase + n < NMETA);
                const float zz = z[n]; const float sp = fmaxf(zz, 0.f) + __logf(1.f + __expf(-fabsf(zz)));
                run += ok ? sp : 0.f; cum[n] = run; }
            const float t1 = __shfl(run, (lane + 16) & 63), t2 = __shfl(run, (lane + 32) & 63), t3 = __shfl(run, (lane + 48) & 63);
            const float higher = (g < 3 ? t1 : 0.f) + (g < 2 ? t2 : 0.f) + (g < 1 ? t3 : 0.f);
            const float lower = (g >= 1 ? t3 : 0.f) + (g >= 2 ? t2 : 0.f) + (g >= 3 ? t1 : 0.f);
            const float base = R + higher;
            float av[16];
#pragma unroll
            for (int n = 0; n < 16; ++n) { const bool ok = (jb >= 0) ? (kbase + n < tq) : (kbase + n < NMETA); av[n] = ok ? __expf(z[n] - (base + cum[n])) : 0.f; }
            R += run + higher + lower;
#pragma unroll
            for (int ks = 0; ks < 2; ++ks) { v4u bw; bw.x = pk2(av[8 * ks + 0], av[8 * ks + 1]); bw.y = pk2(av[8 * ks + 2], av[8 * ks + 3]); bw.z = pk2(av[8 * ks + 4], av[8 * ks + 5]); bw.w = pk2(av[8 * ks + 6], av[8 * ks + 7]);
                const bf16x8 bfr = __builtin_bit_cast(bf16x8, bw);
#pragma unroll
                for (int et = 0; et < 4; ++et) { const bf16x8 afr = *(const LAS bf16x8*)(VT + (16 * et + l15) * 72 + 16 * g + 8 * ks); o[et] = __builtin_amdgcn_mfma_f32_16x16x32_bf16(afr, bfr, o[et], 0, 0, 0); } }
            const float rm = row16_min(R);
            if (lane == 0) MINR[wave] = rm;
        }
        float ss = 0.f;
#pragma unroll
        for (int et = 0; et < 4; ++et) ss += (o[et][0] * o[et][0] + o[et][1] * o[et][1]) + (o[et][2] * o[et][2] + o[et][3] * o[et][3]);
        ss += __shfl_xor(ss, 16); ss += __shfl_xor(ss, 32);
        const float rstd = 1.0f / sqrtf(ss * (1.0f / 64.0f) + EPS);
#pragma unroll
        for (int et = 0; et < 4; ++et) { const int e = 16 * et + 4 * g; const f32x4 gg = *(const f32x4*)(F.sb_g + hd * 64 + e);
            v2u w; w.x = pk2(o[et][0] * rstd * gg[0], o[et][1] * rstd * gg[1]); w.y = pk2(o[et][2] * rstd * gg[2], o[et][3] * rstd * gg[3]);
            *(v2u*)(PR + qrow + CQS + hd * 64 + e) = w; }
    }
#undef SB_FETCH
    __syncthreads();
}

__device__ __forceinline__ void p3_scan(Frame& F) {
    const int bh = F.vcu >> 5, h = bh & 3, tid = F.tid, lane = F.lane;
    LAS float* DEC = (LAS float*)F.lds; LAS float* SCL = DEC + 128; LAS float* WM = DEC + 256;
    const float* PRM = WSP(float, WS_PRM);
    __syncthreads();
    if (F.wave == 0) {
        float li = -INFINITY, lf = 0.f;
        if (lane < NMETA) { li = PRM[(size_t)lane * NIN + OI_ + h] + F.b_i[h]; lf = logsigmoidf_(PRM[(size_t)lane * NIN + OF_ + h] + F.b_f[h]); }
        float bs = lf;
        bs = wave_scan_sum(bs, lane);
        const float bL = rdl_f(bs, 63); const float gg = bL - bs + li; float M = fmaxf(bL, wave_max(gg));
        if (lane < NMETA) WM[lane] = __expf(gg - M);
        const float* AC = WSP(float, WS_AC) + bh * 128; const float* BC = WSP(float, WS_BC) + bh * 128;
        const float a0 = AC[lane], a1 = AC[64 + lane], c0v = BC[lane], c1v = BC[64 + lane];
        float m0 = 0.f, m1 = 0.f, n0 = 0.f, n1 = 0.f;
#pragma unroll 8
        for (int c = 0; c < 64; ++c) { const float a = rdl_f(a0, c), bc = rdl_f(c0v, c); const float Mn = fmaxf(M + a, bc); if (lane == c) { m0 = M; n0 = Mn; } M = Mn; }
#pragma unroll 8
        for (int c = 0; c < 64; ++c) { const float a = rdl_f(a1, c), bc = rdl_f(c1v, c); const float Mn = fmaxf(M + a, bc); if (lane == c) { m1 = M; n1 = Mn; } M = Mn; }
        DEC[lane] = __expf(a0 + m0 - n0); SCL[lane] = __expf(c0v - n0); DEC[64 + lane] = __expf(a1 + m1 - n1); SCL[64 + lane] = __expf(c1v - n1);
        if ((F.vcu & 31) == 0) { WSP(float, WS_MIN)[bh * 128 + lane] = m0; WSP(float, WS_MIN)[bh * 128 + 64 + lane] = m1; }
    }
    __syncthreads();
    const int elem = (F.vcu & 31) * 512 + tid, e = elem >> 7, d = elem & 127;
    const float* KM = WSP(float, WS_KM) + (size_t)h * 16 * 128;
    float C = 0.f;
#pragma unroll
    for (int s = 0; s < NMETA; ++s) C += WM[s] * PRM[(size_t)s * NIN + OV_ + h * 128 + e] * KM[s * 128 + d];
    bf16* U = WSP(bf16, WS_U) + (size_t)bh * 128 * 16384 + elem;
    for (int c0 = 0; c0 < 128; c0 += 16) {
        unsigned short u[16];
#pragma unroll
        for (int j = 0; j < 16; ++j) u[j] = U[(size_t)(c0 + j) * 16384];
#pragma unroll
        for (int j = 0; j < 16; ++j) { U[(size_t)(c0 + j) * 16384] = (bf16)f2bf(C); C = DEC[c0 + j] * C + SCL[c0 + j] * bf2f(u[j]); }
    }
    if ((F.vcu & 31) == 0) {
        LAS float* NUL = (LAS float*)F.lds + 1024;
        const float* NUg = WSP(float, WS_NU) + (size_t)bh * 128 * 128;
        for (int i = tid; i < 4096; i += NTHR) ((LAS f32x4*)NUL)[i] = ((const f32x4*)NUg)[i];
        __syncthreads();
        if (tid < 128) {
            float n = 0.f;
#pragma unroll
            for (int s = 0; s < NMETA; ++s) n += WM[s] * KM[s * 128 + tid];
            float* NS = WSP(float, WS_NS) + (size_t)bh * 128 * 128 + tid;
#pragma unroll 8
            for (int c = 0; c < 128; ++c) { NS[c * 128] = n; n = DEC[c] * n + SCL[c] * NUL[c * 128 + tid]; }
        }
    }
    __syncthreads();
}

constexpr int L4_Q = 0, L4_K = 17408, L4_VT = 34816, L4_CS = 53248, L4_S = 88064, L4_TAB = 97280;
__device__ __forceinline__ void p4_mlstm_out(Frame& F) {
    const int bh = F.vcu >> 5, b = bh >> 2, h = bh & 3, tid = F.tid, lane = F.lane, wave = F.wave, g = lane >> 4, l15 = lane & 15;
    LAS bf16* Qs = (LAS bf16*)(F.lds + L4_Q); LAS bf16* Ks = (LAS bf16*)(F.lds + L4_K); LAS bf16* VT = (LAS bf16*)(F.lds + L4_VT);
    LAS bf16* CS = (LAS bf16*)(F.lds + L4_CS); LAS bf16* Ss = (LAS bf16*)(F.lds + L4_S); LAS float* T = (LAS float*)(F.lds + L4_TAB);
    bf16* PR = WSP(bf16, WS_PR);
    const bf16* Qg = WSP(bf16, WS_QK); const bf16* Kg = Qg + (size_t)MROWS * 512;
    v4u rq[2], rk[2], rc[4], rv[2]; float rT0 = 0.f, rT1 = 0.f, rNS = 0.f, rMin;
#define P4_FETCH(UI) do { const int _chunk = (F.vcu & 31) + 32 * (UI); const int _m0 = b * SEQ + _chunk * 64; const int _uc = bh * 128 + _chunk; \
        _Pragma("unroll") for (int _k = 0; _k < 2; ++_k) { const int _i = tid + NTHR * _k; const int _t = _i >> 4, _c8 = (_i & 15) * 8; const size_t _go = (size_t)(_m0 + _t) * 512 + h * 128 + _c8; rq[_k] = *(const v4u*)(Qg + _go); rk[_k] = *(const v4u*)(Kg + _go); \
            rv[_k] = *(const v4u*)(PR + (size_t)(_m0 + _t) * NPROJ + CV_ + h * 128 + _c8); } \
        _Pragma("unroll") for (int _k = 0; _k < 4; ++_k) { const int _i = tid + NTHR * _k; const int _e = _i >> 4, _c8 = (_i & 15) * 8; rc[_k] = *(const v4u*)(WSP(bf16, WS_U) + (size_t)_uc * 16384 + _e * 128 + _c8); } \
        if (tid < 64) { rT0 = WSP(float, WS_BT)[(_m0 + tid) * 4 + h]; rT1 = WSP(float, WS_GI)[(_m0 + tid) * 4 + h]; } \
        if (tid >= 128 && tid < 256) rNS = WSP(float, WS_NS)[(size_t)_uc * 128 + tid - 128]; \
        rMin = WSP(float, WS_MIN)[_uc]; } while (0)
    P4_FETCH(0);
    for (int ui = 0; ui < 4; ++ui) {
        const int chunk = (F.vcu & 31) + 32 * ui; const int m0 = b * SEQ + chunk * 64;
        __syncthreads();
#pragma unroll
        for (int k = 0; k < 2; ++k) { const int i = tid + NTHR * k; const int t = i >> 4, c8 = (i & 15) * 8; *(LAS v4u*)(Qs + t * 136 + c8) = rq[k]; *(LAS v4u*)(Ks + t * 136 + c8) = rk[k];
            const v4u pv = rv[k];
#pragma unroll
            for (int q = 0; q < 4; ++q) { VT[(c8 + 2 * q) * 72 + t] = (bf16)(pv[q] & 0xffffu); VT[(c8 + 2 * q + 1) * 72 + t] = (bf16)(pv[q] >> 16); } }
#pragma unroll
        for (int k = 0; k < 4; ++k) { const int i = tid + NTHR * k; const int e = i >> 4, c8 = (i & 15) * 8; *(LAS v4u*)(CS + e * 136 + c8) = rc[k]; }
        if (tid < 64) { T[tid] = rT0; T[64 + tid] = rT1; }
        if (tid >= 128 && tid < 256) T[640 + tid - 128] = rNS;
        const float Min = rMin;
        P4_FETCH(ui + 1 < 4 ? ui + 1 : 3);
        __syncthreads();
        if (wave == 0) {
            const float bt = T[lane], li = T[64 + lane]; float pm = li - bt;
            pm = wave_scan_max(pm, lane);
            const float Mt = bt + fmaxf(Min, pm);
            T[128 + lane] = Mt; T[192 + lane] = __expf(bt + Min - Mt);
        }
        { const int t = tid >> 3, part = tid & 7; float s = 0.f;
#pragma unroll
          for (int j = 0; j < 16; ++j) s += bf2f(Qs[t * 136 + part * 16 + j]) * T[640 + part * 16 + j];
          s += dpp_f<0xB1>(s); s += dpp_f<0x4E>(s); s += dpp_f<0x124>(s);
          if (part == 0) T[256 + t] = s; }
        __syncthreads();
#pragma unroll
        for (int j = 0; j < 2; ++j) { const int tt = wave >> 1, st = 2 * (wave & 1) + j; f32x4 a = {0.f, 0.f, 0.f, 0.f};
            a = mma_rows<4>(Qs + (16 * tt + l15) * 136 + 8 * g, Ks + (16 * st + l15) * 136 + 8 * g, a);
            const int s = 16 * st + l15; const float cs = T[64 + s] - T[s];
#pragma unroll
            for (int r = 0; r < 4; ++r) { const int t = 16 * tt + 4 * g + r; const float wgt = (s <= t) ? __expf(T[t] + cs - T[128 + t]) : 0.f; const float v = a[r] * wgt;
                Ss[t * 72 + s] = (bf16)f2bf(v); const float rs = row16_sum(v);
                if (l15 == 0) T[384 + st * 64 + t] = rs; } }
        __syncthreads();
        if (tid < 64) { const float den = T[192 + tid] * T[256 + tid] + (T[384 + tid] + T[448 + tid]) + (T[512 + tid] + T[576 + tid]); T[320 + tid] = 1.0f / fmaxf(fabsf(den), __expf(-T[128 + tid])); }
        f32x4 acc[4];
        const int tt = wave >> 1, tl = 16 * tt + l15;
#pragma unroll
        for (int j = 0; j < 4; ++j) { const int et = 4 * (wave & 1) + j; f32x4 a = {0.f, 0.f, 0.f, 0.f};
            a = mma_rows<4>(CS + (16 * et + l15) * 136 + 8 * g, Qs + (16 * tt + l15) * 136 + 8 * g, a);
            a = a * T[192 + tl];
            a = mma_rows<2>(VT + (16 * et + l15) * 72 + 8 * g, Ss + (16 * tt + l15) * 72 + 8 * g, a);
            acc[j] = a; }
        __syncthreads();
        float ps = 0.f, pq = 0.f; const float invd = T[320 + tl];
        const size_t orow = (size_t)(m0 + tl) * NPROJ + CO_ + h * 128, crow = (size_t)(m0 + tl) * 512 + h * 128;
#pragma unroll
        for (int j = 0; j < 4; ++j) { const int e0 = 16 * (4 * (wave & 1) + j) + 4 * g; const v2u opk = *(const v2u*)(PR + orow + e0);
            const float op[4] = {bf2f(opk[0] & 0xffffu), __uint_as_float(opk[0] & 0xffff0000u), bf2f(opk[1] & 0xffffu), __uint_as_float(opk[1] & 0xffff0000u)};
#pragma unroll
            for (int r = 0; r < 4; ++r) { const float hv = acc[j][r] * invd / (1.f + __expf(-op[r])); acc[j][r] = hv; ps += hv; pq += hv * hv; } }
        ps += __shfl_xor(ps, 16); ps += __shfl_xor(ps, 32); pq += __shfl_xor(pq, 16); pq += __shfl_xor(pq, 32);
        if (g == 0) { T[768 + (wave & 1) * 64 + tl] = ps; T[896 + (wave & 1) * 64 + tl] = pq; }
        __syncthreads();
        { const float mu = (T[768 + tl] + T[832 + tl]) * (1.f / 128.f); const float var = (T[896 + tl] + T[960 + tl]) * (1.f / 128.f) - mu * mu; const float rsd = 1.0f / sqrtf(fmaxf(var, 0.f) + EPS);
#pragma unroll
          for (int j = 0; j < 4; ++j) { const int e0 = 16 * (4 * (wave & 1) + j) + 4 * g; const f32x4 gn = *(const f32x4*)(F.gn_g + h * 128 + e0), sk = *(const f32x4*)(F.skip + h * 128 + e0);
              const v2u cpk = *(const v2u*)(WSP(bf16, WS_CB) + crow + e0);
              const float cv[4] = {bf2f(cpk[0] & 0xffffu), __uint_as_float(cpk[0] & 0xffff0000u), bf2f(cpk[1] & 0xffffu), __uint_as_float(cpk[1] & 0xffff0000u)};
              float y[4];
#pragma unroll
              for (int r = 0; r < 4; ++r) y[r] = (acc[j][r] - mu) * rsd * gn[r] + sk[r] * cv[r];
              v2u o; o[0] = pk2(y[0], y[1]); o[1] = pk2(y[2], y[3]); *(v2u*)(PR + orow + e0) = o; } }
    }
    __syncthreads();
}

constexpr int L7_SK = 0, L7_LS = 69632;
__device__ __forceinline__ int pack_key(float v, int idx, unsigned mask) { int k = (int)((__builtin_bit_cast(unsigned, v) & ~mask) | (unsigned)idx); return k < 0 ? (k ^ 0x7fffffff) : k; }
__device__ __forceinline__ float key_val(int k, unsigned mask) { const int u = k < 0 ? (k ^ 0x7fffffff) : k; return __builtin_bit_cast(float, (unsigned)u & ~mask); }
__device__ __forceinline__ int key_idx(int k, unsigned mask) { const int u = k < 0 ? (k ^ 0x7fffffff) : k; return (int)((unsigned)u & mask); }
__device__ __forceinline__ void bitonic_sort16_desc(int (&t)[16]) {
#pragma unroll
    for (int k = 2; k <= 16; k <<= 1)
#pragma unroll
        for (int j = k >> 1; j > 0; j >>= 1)
#pragma unroll
            for (int i = 0; i < 16; ++i) { const int l = i ^ j; if (l > i) { const bool desc = ((i & k) == 0); const int hi = max(t[i], t[l]), lo = min(t[i], t[l]); t[i] = desc ? hi : lo; t[l] = desc ? lo : hi; } }
}
__device__ __forceinline__ void bitonic_merge16_desc(int (&t)[16]) {
#pragma unroll
    for (int j = 8; j > 0; j >>= 1)
#pragma unroll
        for (int i = 0; i < 16; ++i) { const int l = i ^ j; if (l > i) { const int hi = max(t[i], t[l]), lo = min(t[i], t[l]); t[i] = hi; t[l] = lo; } }
}
#define TOPK_INS(t, x) do { int _x = (x); _Pragma("unroll") for (int _i = 0; _i < 16; ++_i) { const int _hi = max(t[_i], _x); _x = min(t[_i], _x); t[_i] = _hi; } } while (0)
__device__ __forceinline__ void p7_topk(Frame& F) {
    const int tid = F.tid, lane = F.lane, wave = F.wave, g = lane >> 4, l15 = lane & 15;
    LAS bf16* SK = (LAS bf16*)(F.lds + L7_SK); LAS int* LS = (LAS int*)(F.lds + L7_LS); LAS int* HIST = (LAS int*)(F.lds + L7_LS + 65536);
    const bf16* QP = WSP(bf16, WS_QP);
    __syncthreads();
    for (int i = tid; i < 4096; i += NTHR) { const int row = i >> 4, c8 = (i & 15) * 8; *(LAS v4u*)(SK + row * 136 + c8) = *(const v4u*)(WSP(bf16, WS_SKB) + (size_t)row * 128 + c8); }
    __syncthreads();
    for (int unit = F.vcu; unit < MROWS / 64; unit += F.G) {
        const int tok0 = unit * 64, h = wave;
        for (int i = tid; i < 64 * 33; i += NTHR) HIST[i] = 0;
        bf16x8 qf[4], qn[4];
        { const bf16* qrow = QP + (size_t)(tok0 + l15) * 2048 + h * 256 + 8 * g;
#pragma unroll
          for (int k = 0; k < 4; ++k) qf[k] = *(const bf16x8*)(qrow + 32 * k); }
#pragma unroll 1
        for (int it = 0; it < 8; ++it) {
            const int p = it >> 2, tt = it & 3;
            if (it + 1 < 8) { const int p2 = (it + 1) >> 2, tt2 = (it + 1) & 3; const bf16* qrow = QP + (size_t)(tok0 + 16 * tt2 + l15) * 2048 + h * 256 + p2 * 128 + 8 * g;
#pragma unroll
                for (int k = 0; k < 4; ++k) qn[k] = *(const bf16x8*)(qrow + 32 * k); }
            int ta[16], tb[16];
#pragma unroll
            for (int kt = 0; kt < 8; ++kt) { f32x4 a = {0.f, 0.f, 0.f, 0.f}; const LAS bf16* sk = SK + (p * 128 + 16 * kt + l15) * 136 + 8 * g;
#pragma unroll
                for (int k = 0; k < 4; ++k) a = __builtin_amdgcn_mfma_f32_16x16x32_bf16(*(const LAS bf16x8*)(sk + 32 * k), qf[k], a, 0, 0, 0);
#pragma unroll
                for (int r = 0; r < 4; ++r) { const int key = pack_key(a[r], 16 * kt + 4 * g + r, 127u); if (kt < 4) ta[4 * kt + r] = key; else tb[4 * (kt - 4) + r] = key; } }
            bitonic_sort16_desc(ta); bitonic_sort16_desc(tb);
#pragma unroll
            for (int i = 0; i < 16; ++i) ta[i] = max(ta[i], tb[15 - i]);
            bitonic_merge16_desc(ta);
#pragma unroll
            for (int dd = 16; dd <= 32; dd <<= 1) {
#pragma unroll
                for (int i = 0; i < 16; ++i) tb[i] = __shfl_xor(ta[i], dd);
#pragma unroll
                for (int i = 0; i < 16; ++i) ta[i] = max(ta[i], tb[15 - i]);
                bitonic_merge16_desc(ta); }
            if (g == 0) { LAS int* dst = LS + (((16 * tt + l15) * 8 + h) * 2 + p) * 16;
#pragma unroll
                for (int i = 0; i < 16; ++i) dst[i] = ta[i]; }
#pragma unroll
            for (int k = 0; k < 4; ++k) qf[k] = qn[k];
        }
        __syncthreads();
        { const int tok = tid >> 3, h2 = tid & 7; const LAS int* la = LS + ((tok * 8 + h2) * 2 + 0) * 16; const LAS int* lb = la + 16;
          float av[16], bv[16];
#pragma unroll
          for (int i = 0; i < 16; ++i) { av[i] = key_val(la[i], 127u); bv[i] = key_val(lb[i], 127u); }
          int top[16];
#pragma unroll
          for (int i = 0; i < 16; ++i) top[i] = (int)0x80000000;
#pragma unroll
          for (int i = 0; i < 16; ++i)
#pragma unroll
              for (int j = 0; j < 16; ++j) if ((i + 1) * (j + 1) <= 16) TOPK_INS(top, pack_key(av[i] + bv[j], i * 16 + j, 255u));
          const float vmax = key_val(top[0], 255u); float ev[16]; float z = 0.f;
#pragma unroll
          for (int k = 0; k < 16; ++k) { ev[k] = __expf(key_val(top[k], 255u) - vmax); z += ev[k]; }
          const float rz = 1.0f / z;
          int eidx[16]; float gate[16];
#pragma unroll
          for (int k = 0; k < 16; ++k) { const int ij = key_idx(top[k], 255u); const int ei = key_idx(la[ij >> 4], 127u), ej = key_idx(lb[ij & 15], 127u);
              eidx[k] = ei * 128 + ej; gate[k] = ev[k] * rz; __hip_atomic_fetch_add(HIST + tok * 33 + (eidx[k] >> 9), 1, __ATOMIC_RELAXED, __HIP_MEMORY_SCOPE_WORKGROUP); }
          __syncthreads();
          if (tid < 64) { int run = 0;
#pragma unroll
              for (int b = 0; b < 32; ++b) { const int c = HIST[tid * 33 + b]; HIST[tid * 33 + b] = run; run += c; } }
          __syncthreads();
          if (h2 == 0) { const f32x4* q = (const f32x4*)(WSP(float, WS_SSQ) + (size_t)(tok0 + tok) * 16); float ssq = 0.f;
#pragma unroll
              for (int j = 0; j < 4; ++j) { const f32x4 a = q[j]; ssq += (a[0] + a[1]) + (a[2] + a[3]); }
              WSP(float, WS_RS2)[tok0 + tok] = 1.0f / sqrtf(ssq * (1.0f / DM) + EPS); }
          v2u* tk = (v2u*)WSP(unsigned, WS_TK) + (size_t)(tok0 + tok) * 128;
#pragma unroll
          for (int k = 0; k < 16; ++k) { const int pos = __hip_atomic_fetch_add(HIST + tok * 33 + (eidx[k] >> 9), 1, __ATOMIC_RELAXED, __HIP_MEMORY_SCOPE_WORKGROUP);
              v2u o; o.x = (unsigned)eidx[k]; o.y = __builtin_bit_cast(unsigned, gate[k]); tk[pos] = o; } }
        asm volatile("s_waitcnt vmcnt(0)" ::: "memory");
        __syncthreads();
    }
}

__device__ __forceinline__ float gelu_erf(float v) { return 0.5f * v * (1.0f + erff(v * 0.70710678118654752f)); }
typedef float f32x2v __attribute__((ext_vector_type(2)));
#define P8_LOAD8(RB, G) P8_LOAD8X(RB, G, e0.x, e1.x)
#define P8_LOAD8X(RB, G, EX0, EX1) do { if ((G) < 32) { const unsigned char* _tab = ((G) < 16) ? EU : EV; _Pragma("unroll") for (int _j = 0; _j < 8; ++_j) { const int _k = 8 * ((G) & 15) + _j; const unsigned _s = (_k < 64) ? (EX0) : (EX1); \
        const unsigned _ei = (unsigned)__builtin_amdgcn_readlane((int)_s, _k & 63); RB[_j] = *(const v2u*)(_tab + (size_t)_ei * (DM / 2) + 8 * lane); } } } while (0)
__device__ __forceinline__ float gelu_as(float v) {
    const float av = fabsf(v), t = __builtin_amdgcn_rcpf(av * 0.2316418882f + 1.0f);
    float q = t * 0.5307027145f + (-0.7265760135f); q = q * t + 0.7107068705f; q = q * t + (-0.142248368f); q = q * t + 0.127414796f; q = q * t;
    const float m = v * (q * __builtin_amdgcn_exp2f((v * v) * (-0.72134752044f)));
    return v < 0.f ? m : v - m;
}
__device__ __forceinline__ float reduce8_butterfly(const float (&d)[8], int lane) {
    const bool b5 = (lane & 32) != 0, b4 = (lane & 16) != 0, b3 = (lane & 8) != 0;
    float k4[4];
#pragma unroll
    for (int i = 0; i < 4; ++i) { const float snd = b5 ? d[i] : d[i + 4], kp = b5 ? d[i + 4] : d[i]; k4[i] = kp + __shfl_xor(snd, 32); }
    float k2[2];
#pragma unroll
    for (int i = 0; i < 2; ++i) { const float snd = b4 ? k4[i] : k4[i + 2], kp = b4 ? k4[i + 2] : k4[i]; k2[i] = kp + __shfl_xor(snd, 16); }
    float k1; { const float snd = b3 ? k2[0] : k2[1], kp = b3 ? k2[1] : k2[0]; k1 = kp + __shfl_xor(snd, 8); }
    k1 += __shfl_xor(k1, 4); k1 += __shfl_xor(k1, 2); k1 += __shfl_xor(k1, 1);
    return k1;
}
#define P8_UDOT(UB, G) do { _Pragma("unroll") for (int _j = 0; _j < 8; ++_j) { \
            int _sh = __builtin_amdgcn_sdot8((int)UB[_j][0], (int)xh0, 0, false); _sh = __builtin_amdgcn_sdot8((int)UB[_j][1], (int)xh1, _sh, false); \
            int _sl = __builtin_amdgcn_sdot8((int)UB[_j][0], (int)xl0, 0, false); _sl = __builtin_amdgcn_sdot8((int)UB[_j][1], (int)xl1, _sl, false); const int _s = (_sh << 4) + _sl; \
            red[(8 * ((G) & 7) + _j) * 65 + lane] = (float)_s; } \
        if (((G) & 7) == 7) { float _t0 = 0.f, _t1 = 0.f, _t2 = 0.f, _t3 = 0.f; _Pragma("unroll") for (int _i = 0; _i < 64; _i += 4) { _t0 += red[lane * 65 + _i]; _t1 += red[lane * 65 + _i + 1]; _t2 += red[lane * 65 + _i + 2]; _t3 += red[lane * 65 + _i + 3]; } \
            const float _dl = (_t0 + _t1) + (_t2 + _t3); const bool _c1 = (G) >= 8; const float _gl = __uint_as_float(_c1 ? e1.y : e0.y), _su = __uint_as_float(_c1 ? s1x : s0x); \
            const float _cv = _gl * gelu_as((_dl + hsx) * _su * rsx) * 0.25f; if (_c1) c1 = _cv; else c0 = _cv; } } while (0)
#define P8_FP4ACC(w, sel, i0) { const f32x2v _f = __builtin_amdgcn_cvt_scalef32_pk_f32_fp4((w), 1.0f, sel); acc[i0] += _c * _f[0]; acc[(i0) + 1] += _c * _f[1]; }
#define P8_VACC(VB, G) do { const int _g = (G) - 16; const float _csrc = (_g < 8) ? c0 : c1; _Pragma("unroll") for (int _j = 0; _j < 8; ++_j) { \
            asm volatile("" : "+v"(VB[_j][0]), "+v"(VB[_j][1]) : "v"(acc[0]), "v"(acc[5]), "v"(acc[10]), "v"(acc[15])); \
            const float _c = __uint_as_float((unsigned)__builtin_amdgcn_readlane((int)__float_as_uint(_csrc), 8 * (_g & 7) + _j)); \
            P8_FP4ACC(VB[_j][0], 0, 0) P8_FP4ACC(VB[_j][0], 1, 2) P8_FP4ACC(VB[_j][0], 2, 4) P8_FP4ACC(VB[_j][0], 3, 6) P8_FP4ACC(VB[_j][1], 0, 8) P8_FP4ACC(VB[_j][1], 1, 10) P8_FP4ACC(VB[_j][1], 2, 12) P8_FP4ACC(VB[_j][1], 3, 14) } } while (0)
typedef int v8i __attribute__((ext_vector_type(8)));
#define P8_CLOAD_V(RB, PC, H) do { _Pragma("unroll") for (int _r = 0; _r < 8; ++_r) RB[_r] = *(const v4u*)(EV + (size_t)vofv[H][_r] + 128 * (PC)); } while (0)
#define P8_SLAB(RB, PC, H, FIRST) do { \
        _Pragma("unroll") for (int _r = 0; _r < 8; ++_r) { v4u _w = RB[_r]; if (_r >= 4) { const unsigned _t0 = _w[0], _t1 = _w[1]; _w[0] = _w[2]; _w[1] = _w[3]; _w[2] = _t0; _w[3] = _t1; } \
            *(LAS v4u*)(SLB + ((_r & 1) ? wa1 : wa0) + 1024 * _r) = _w; } \
        _Pragma("unroll") for (int _i = 0; _i < 16; ++_i) { const int _cb = 4 * (_i & 3) + (_i >> 2); const int _ta = (tb ^ (16 * (_cb >> 1))) ^ (8 * (_cb & 1)); \
            const v2i_t _t0 = __builtin_amdgcn_ds_read_tr4_b64_v2i32((LAS v2i_t*)(SLB + _ta)); const v2i_t _t1 = __builtin_amdgcn_ds_read_tr4_b64_v2i32((LAS v2i_t*)(SLB + _ta + 2048)); \
            v8i _b, _a; _b[0] = _t0[0]; _b[1] = _t0[1]; _b[2] = _t1[0]; _b[3] = _t1[1]; _b[4] = 0; _b[5] = 0; _b[6] = 0; _b[7] = 0; \
            const bool _keep = (ln >> 2) == (_cb & 3); _a[0] = _keep ? (int)ah[H][0] : 0; _a[1] = _keep ? (int)ah[H][1] : 0; _a[2] = _keep ? (int)ah[H][2] : 0; _a[3] = _keep ? (int)ah[H][3] : 0; _a[4] = 0; _a[5] = 0; _a[6] = 0; _a[7] = 0; \
            if ((FIRST) && (_cb & 3) == 0) { const f32x4 _z = {0.f, 0.f, 0.f, 0.f}; vacc[_cb >> 2] = _z; } \
            vacc[_cb >> 2] = __builtin_amdgcn_mfma_scale_f32_16x16x128_f8f6f4(_a, _b, vacc[_cb >> 2], 0, 4, 0, 0, 0, 0); } } while (0)
#define P8_VOUT(PC) do { _Pragma("unroll") for (int _a = 0; _a < 4; ++_a) OT[oto + 64 * (PC) + 16 * _a] = vacc[_a][0] + vacc[_a][1]; } while (0)
typedef int v2i_t __attribute__((ext_vector_type(2)));
__device__ __forceinline__ void p8_gather(Frame& F) {
    const int lane = F.lane; const int gw = F.vcu * NWAVES + F.wave, NGW = F.G * NWAVES;
    const unsigned char* EU = F.ws + WS_EU; const unsigned char* EV = F.ws + WS_EV; const bf16* H1B = WSP(bf16, WS_H1B);
    const unsigned long long* tkb = (const unsigned long long*)WSP(unsigned, WS_TK);
    unsigned long long nt0 = tkb[(size_t)(gw * 8) * 128 + lane], nt1 = tkb[(size_t)(gw * 8) * 128 + 64 + lane];
    v2u nx[4];
#pragma unroll
    for (int j = 0; j < 4; ++j) nx[j] = *(const v2u*)(H1B + (size_t)(gw * 8) * DM + 256 * j + 4 * lane);
    float nrs = WSP(float, WS_RS2)[gw * 8];
    const float* esc = WSP(float, WS_ESC);
    LAS float* red = (LAS float*)(F.lds + F.wave * 16640);
    LAS unsigned char* WL = F.lds + F.wave * 16640;
    LAS unsigned char* CTB = WL; LAS float* OT = (LAS float*)(WL + 1024); LAS unsigned char* SLB = WL + 8192;
    const int lq = lane >> 4, ln = lane & 15;
    const int cta = ((ln & 3) < 2 ? 128 * (ln & 3) : 256) + 16 * lq;
    const int wa0 = 128 * (lane >> 3) + 16 * ((lane & 7) ^ (lane >> 4)), wa1 = 128 * (lane >> 3) + 16 * ((lane & 7) ^ (4 + (lane >> 4)));
    const int tb = (32 * (lq & 1) + ln) * 128 + 16 * ((ln >> 1) & 7) + 8 * (lq & 1);
    const int oto = 256 * (ln >> 2) + 4 * lq + (ln & 3);
    f32x4 vacc[4];
    __syncthreads();
    float ns0x = esc[(unsigned)nt0], ns1x = esc[(unsigned)nt1];
    v2u b0[8], b1[8], b2[8];
    P8_LOAD8X(b0, 0, (unsigned)nt0, (unsigned)nt1); P8_LOAD8X(b1, 1, (unsigned)nt0, (unsigned)nt1);
    for (int tok = gw * 8; tok < gw * 8 + 8; ++tok) {
        float xf[16];
#pragma unroll
        for (int j = 0; j < 4; ++j) { const v2u xr = nx[j];
            xf[4 * j] = bf2f(xr[0] & 0xffffu); xf[4 * j + 1] = __uint_as_float(xr[0] & 0xffff0000u); xf[4 * j + 2] = bf2f(xr[1] & 0xffffu); xf[4 * j + 3] = __uint_as_float(xr[1] & 0xffff0000u); }
        v2u e0, e1; e0.x = (unsigned)nt0; e0.y = (unsigned)(nt0 >> 32); e1.x = (unsigned)nt1; e1.y = (unsigned)(nt1 >> 32);
        const unsigned s0x = __float_as_uint(ns0x), s1x = __float_as_uint(ns1x);
        float amax = 0.f;
#pragma unroll
        for (int i = 0; i < 16; ++i) amax = fmaxf(amax, fabsf(xf[i]));
        amax = wave_max(amax); const float sx = amax > 0.f ? 119.0f / amax : 1.0f;
        int sxl = 0; unsigned xh0 = 0u, xh1 = 0u, xl0 = 0u, xl1 = 0u;
#pragma unroll
        for (int i = 0; i < 16; ++i) { const int q = (int)rintf(xf[i] * sx); sxl += q; const int l = ((q + 8) & 15) - 8, h = (q - l) >> 4;
            if (i < 8) { xl0 |= ((unsigned)l & 15u) << (4 * i); xh0 |= ((unsigned)h & 15u) << (4 * i); } else { xl1 |= ((unsigned)l & 15u) << (4 * (i - 8)); xh1 |= ((unsigned)h & 15u) << (4 * (i - 8)); } }
        const float hsx = 0.5f * wave_sum((float)sxl);
        const float rsx = nrs / sx;
        float c0 = 0.f, c1 = 0.f;
        P8_LOAD8(b2, 2); P8_UDOT(b0, 0);
        P8_LOAD8(b0, 3); P8_UDOT(b1, 1);
        P8_LOAD8(b1, 4); P8_UDOT(b2, 2);
        P8_LOAD8(b2, 5); P8_UDOT(b0, 3);
        P8_LOAD8(b0, 6); P8_UDOT(b1, 4);
        P8_LOAD8(b1, 7); P8_UDOT(b2, 5);
        P8_LOAD8(b2, 8); P8_UDOT(b0, 6);
        P8_LOAD8(b0, 9); P8_UDOT(b1, 7);
        P8_LOAD8(b1, 10); P8_UDOT(b2, 8);
        P8_LOAD8(b2, 11); P8_UDOT(b0, 9);
        P8_LOAD8(b0, 12); P8_UDOT(b1, 10);
        P8_LOAD8(b1, 13); P8_UDOT(b2, 11);
        P8_LOAD8(b2, 14); P8_UDOT(b0, 12);
        P8_LOAD8(b0, 15); P8_UDOT(b1, 13);
        unsigned vofv[2][8];
#pragma unroll
        for (int h = 0; h < 2; ++h)
#pragma unroll
            for (int r = 0; r < 8; ++r) vofv[h][r] = (unsigned)__builtin_amdgcn_ds_bpermute(4 * (8 * r + (lane >> 3)), (int)(h ? e1.x : e0.x)) * 512u + 16u * (lane & 7);
        v4u sa[8], sb[8];
        P8_CLOAD_V(sa, 0, 0);
        P8_UDOT(b2, 14);
        P8_CLOAD_V(sb, 0, 1);
        P8_UDOT(b0, 15);
        asm volatile("" ::: "memory");
        const int tokn = tok + 1 < gw * 8 + 8 ? tok + 1 : tok;
        nt0 = tkb[(size_t)tokn * 128 + lane]; nt1 = tkb[(size_t)tokn * 128 + 64 + lane];
#pragma unroll
        for (int j = 0; j < 4; ++j) nx[j] = *(const v2u*)(H1B + (size_t)tokn * DM + 256 * j + 4 * lane);
        nrs = WSP(float, WS_RS2)[tokn];
        const float cmax = wave_max(fmaxf(fabsf(c0), fabsf(c1))); const float sc = cmax > 0.f ? 256.0f / cmax : 1.0f, rsc = 1.0f / sc;
        { const float a0 = c0 * sc, a1 = c1 * sc; const int h = __builtin_amdgcn_cvt_pk_fp8_f32(a0, a1, 0, false);
          const f32x2v rb = __builtin_amdgcn_cvt_pk_f32_fp8(h, false); const int l = __builtin_amdgcn_cvt_pk_fp8_f32(a0 - rb[0], a1 - rb[1], 0, false);
          CTB[lane] = (unsigned char)(h & 0xff); CTB[64 + lane] = (unsigned char)((h >> 8) & 0xff); CTB[128 + lane] = (unsigned char)(l & 0xff); CTB[192 + lane] = (unsigned char)((l >> 8) & 0xff);
          if (lane < 8) { v4u z; z[0] = 0u; z[1] = 0u; z[2] = 0u; z[3] = 0u; *(LAS v4u*)(CTB + 256 + 16 * lane) = z; } }
        v4u ah[2];
#pragma unroll
        for (int h = 0; h < 2; ++h) ah[h] = *(const LAS v4u*)(CTB + cta + 64 * h);
        P8_SLAB(sa, 0, 0, true);  P8_CLOAD_V(sa, 1, 0);
        P8_SLAB(sb, 0, 1, false); P8_CLOAD_V(sb, 1, 1);  P8_VOUT(0);
        P8_SLAB(sa, 1, 0, true);  P8_CLOAD_V(sa, 2, 0);
        P8_SLAB(sb, 1, 1, false); P8_CLOAD_V(sb, 2, 1);  P8_VOUT(1);
        P8_SLAB(sa, 2, 0, true);  P8_CLOAD_V(sa, 3, 0);
        P8_SLAB(sb, 2, 1, false); P8_CLOAD_V(sb, 3, 1);  P8_VOUT(2);
        ns0x = esc[(unsigned)nt0]; ns1x = esc[(unsigned)nt1];
        v2u hr[4];
#pragma unroll
        for (int j = 0; j < 4; ++j) hr[j] = *(const v2u*)(H1B + (size_t)tok * DM + 256 * j + 4 * lane);
        P8_LOAD8X(b2, 0, (unsigned)nt0, (unsigned)nt1);
        P8_SLAB(sa, 3, 0, true);
        P8_LOAD8X(b0, 1, (unsigned)nt0, (unsigned)nt1);
        P8_SLAB(sb, 3, 1, false); P8_VOUT(3);
        float acc[16];
#pragma unroll
        for (int j = 0; j < 4; ++j) { const f32x4 t = *(const LAS f32x4*)(OT + 256 * j + 4 * lane); acc[4 * j] = t[0] * rsc; acc[4 * j + 1] = t[1] * rsc; acc[4 * j + 2] = t[2] * rsc; acc[4 * j + 3] = t[3] * rsc; }
        f32x4* orow = (f32x4*)(F.out + (size_t)tok * DM) + lane; f32x4 hv[4]; float s2 = 0.f;
        f32x4 gv[4];
#pragma unroll
        for (int j = 0; j < 4; ++j) gv[j] = ((const f32x4*)F.g_fin)[lane + 64 * j];
#pragma unroll
        for (int j = 0; j < 4; ++j) {
            { const v2u xr = hr[j];
              hv[j][0] = bf2f(xr[0] & 0xffffu); hv[j][1] = __uint_as_float(xr[0] & 0xffff0000u); hv[j][2] = bf2f(xr[1] & 0xffffu); hv[j][3] = __uint_as_float(xr[1] & 0xffff0000u); }
#pragma unroll
            for (int i = 0; i < 4; ++i) { hv[j][i] += acc[4 * j + i]; s2 += hv[j][i] * hv[j][i]; } }
        s2 = wave_sum(s2); const float rstd3 = 1.0f / sqrtf(s2 * (1.0f / DM) + EPS);
#pragma unroll
        for (int j = 0; j < 4; ++j) orow[64 * j] = hv[j] * rstd3 * gv[j];
#pragma unroll
        for (int j = 0; j < 8; ++j) { const v2u t = b0[j]; b0[j] = b2[j]; b1[j] = t; }
        asm volatile("" ::: "memory");
    }
}

constexpr int CW_BAR = 4096;
static_assert((CW_BAR + XCD_BAR_WORDS) * 4 <= (int)CTL_ZERO_BYTES, "barrier words inside the zeroed region");

__global__ void __launch_bounds__(NTHR, 2) hybrid_fwd(Params prm) {
    extern __shared__ __attribute__((aligned(16))) unsigned char lds_raw[];
    Frame F;
    F.lds = (LAS unsigned char*)lds_raw;
    F.tid = threadIdx.x; F.lane = F.tid & 63; F.wave = __builtin_amdgcn_readfirstlane(F.tid >> 6);
    F.G = gridDim.x; { const int bx = blockIdx.x; F.vcu = (F.G % 8 == 0) ? (bx % 8) * (F.G / 8) + bx / 8 : bx; }
    F.x = prm.in[0]; F.meta = prm.in[1]; F.g_mix = prm.in[2]; F.w_in = prm.in[3]; F.conv_w = prm.in[4]; F.conv_b = prm.in[5]; F.w_qm = prm.in[6]; F.w_km = prm.in[7];
    F.b_i = prm.in[8]; F.b_f = prm.in[9]; F.skip = prm.in[10]; F.gn_g = prm.in[11]; F.sb_g = prm.in[12]; F.w_out = prm.in[13]; F.g_ffn = prm.in[14]; F.w_query = prm.in[15];
    F.sub_keys = prm.in[16]; F.eu = prm.in[17]; F.ev = prm.in[18]; F.g_fin = prm.in[19]; F.out = prm.out; F.ws = prm.ws;
    volatile LAS unsigned* MISC = (volatile LAS unsigned*)(F.lds + LDSCTL_OFF);
    if (F.tid < 64) MISC[F.tid] = 0u;
    __syncthreads();
    XcdBarrier bar = xcd_barrier_post((unsigned*)(F.ws + WS_CTL) + CW_BAR, MISC + 8);

    p0_prologue(F);
    xcd_barrier(bar);
    {
        pg8::Gemm g{WSP(bf16, WS_XB), WSP(bf16, WS_WINT), MROWS, NPROJ, DM, DM, DM}; pg8::StaticOrder S; S.init(MROWS, NPROJ, F.G, (int)blockIdx.x);
        pg8::EpiRowScaleBf16<0> E{WSP(bf16, WS_PR), NPROJ, WSP(float, WS_RSTD1), EPS};
        pg8::gemm_phase<pg8::EpiRowScaleBf16<0>, pg8::StaticOrder, PG8_ALIGN, PG8_SP2>(F.lds, g, S, E);
        p1_meta_tail(F);
    }
    xcd_barrier(bar);
    p2_mlstm_local(F);
    p2_sb_attention(F);
    xcd_barrier(bar);
    p3_scan(F);
    xcd_barrier(bar);
    p4_mlstm_out(F);
    xcd_barrier(bar);
    {
        pg8::Gemm g{WSP(bf16, WS_PR) + CO_, WSP(bf16, WS_WOUTT), MROWS, DM, DM, NPROJ, DM}; pg8::StaticOrder S; S.init(MROWS, DM, F.G, (int)blockIdx.x);
        pg8::EpiResidual E{F.x, F.out, WSP(bf16, WS_H1B), WSP(float, WS_SSQ), DM};
        pg8::gemm_phase<pg8::EpiResidual, pg8::StaticOrder, PG8_ALIGN, PG8_SP2>(F.lds, g, S, E);
    }
    xcd_barrier(bar);
    {
        pg8::Gemm g{WSP(bf16, WS_H1B), WSP(bf16, WS_WQT), MROWS, 2048, DM, DM, DM}; pg8::StaticOrder S; S.init(MROWS, 2048, F.G, (int)blockIdx.x);
        pg8::EpiRowScaleBf16<1> E{WSP(bf16, WS_QP), 2048, WSP(float, WS_SSQ), EPS};
        pg8::gemm_phase<pg8::EpiRowScaleBf16<1>, pg8::StaticOrder, PG8_ALIGN, PG8_SP2>(F.lds, g, S, E);
    }
    xcd_barrier(bar);
    p7_topk(F);
    p8_gather(F);
}

extern "C" void kernel_launch(void* const* d_in, const int* in_sizes, int n_in, void* d_out, int out_size, void* d_ws, size_t ws_size, hipStream_t stream) {
    static int grid = 0;
    if (grid == 0) {
        if (n_in != 20 || in_sizes[0] != MROWS * DM || out_size != MROWS * DM || ws_size < WS_END) {
            fprintf(stderr, "kernel_launch: unexpected shapes (n_in %d, in0 %d, out %d, ws %zu < %zu); nothing launched\n", n_in, n_in > 0 ? in_sizes[0] : -1, out_size, ws_size, (size_t)WS_END); grid = -1; return; }
        int dev = 0, cus = 0, per_cu = 0;
        if (hipGetDevice(&dev) != hipSuccess || hipDeviceGetAttribute(&cus, hipDeviceAttributeMultiprocessorCount, dev) != hipSuccess) { fprintf(stderr, "kernel_launch: device query failed\n"); grid = -1; return; }
        if (hipFuncSetAttribute((const void*)hybrid_fwd, hipFuncAttributeMaxDynamicSharedMemorySize, LDS_BYTES) != hipSuccess) { fprintf(stderr, "kernel_launch: hipFuncSetAttribute failed\n"); grid = -1; return; }
        if (hipOccupancyMaxActiveBlocksPerMultiprocessor(&per_cu, (const void*)hybrid_fwd, NTHR, LDS_BYTES) != hipSuccess || per_cu < 1) { fprintf(stderr, "kernel_launch: occupancy query says %d blocks/CU\n", per_cu); (void)hipGetLastError(); grid = -1; return; }
        grid = cus;
        if (grid != 256) { fprintf(stderr, "kernel_launch: this kernel is built for a 256-CU device (got %d)\n", grid); grid = -1; return; }
    }
    if (grid < 0) return;
    if (hipMemsetAsync((char*)d_ws + WS_CTL, 0, CTL_ZERO_BYTES, stream) != hipSuccess) { fprintf(stderr, "kernel_launch: memset failed\n"); return; }
    Params p{};
    for (int i = 0; i < 20; ++i) p.in[i] = (const float*)d_in[i];
    p.out = (float*)d_out; p.ws = (unsigned char*)d_ws;
    void* args[] = {&p};
    const hipError_t e = hipLaunchCooperativeKernel((const void*)hybrid_fwd, dim3(grid), dim3(NTHR), args, LDS_BYTES, stream);
    if (e != hipSuccess) fprintf(stderr, "kernel_launch: cooperative launch failed: %s\n", hipGetErrorString(e));
}
```

```cpp
#include <hip/hip_runtime.h>
#include <hip/hip_cooperative_groups.h>
#include <cstdio>
#include <cstdint>
namespace cg = cooperative_groups;

namespace pg8 {
#define PG8_LAS __attribute__((address_space(3)))
typedef unsigned short bf16_t;
typedef short bf16x8 __attribute__((ext_vector_type(8)));
typedef float f32x4 __attribute__((ext_vector_type(4)));
typedef unsigned u32x4 __attribute__((ext_vector_type(4)));
typedef unsigned u32x2 __attribute__((ext_vector_type(2)));
constexpr int BM = 256, BK = 64, HALF = 128, HTB = HALF * BK * 2  , STAGE_BYTES = 8 * HTB, NXCD = 8, WGM = 8;

__host__ __device__ __forceinline__ int lds_byte(int r, int c) { const int st = (r >> 4) * 2 + (c >> 5), rr = r & 15, cc = c & 31, ob = rr * 64 + cc * 2; return st * 1024 + (ob ^ (((ob >> 9) & 1) << 5)); }
__host__ __device__ __forceinline__ void stage_rc(int b, int& R, int& C) { const int st = b / 1024, sb = b % 1024, swz = sb ^ (((sb >> 9) & 1) << 5); R = (st >> 1) * 16 + swz / 64; C = (st & 1) * 32 + (swz % 64) / 2; }
__host__ __device__ __forceinline__ int perm32(int rho) { const int n = rho >> 4, i = rho & 15; return 8 * (i >> 2) + 4 * n + (i & 3); }

struct Unit { int pm, pn; };
struct Gemm { const bf16_t* A; const bf16_t* Bt; int M, N, K, lda, ldb; };

struct StaticOrder {
    int nM, nN, nwg, G, c;
    __host__ __device__ void init(int M, int N, int G_, int c_) { nM = M / BM; nN = N / BM; nwg = nM * nN; G = G_; c = c_; }
    __host__ __device__ bool next(int i, Unit& u) const {
        const long L = (long)i * G + c; if (L >= nwg) return false;
        int wgid = (int)L; { const int q = nwg / NXCD, r = nwg % NXCD, xcd = wgid % NXCD, off = wgid / NXCD; wgid = (xcd < r ? xcd * (q + 1) : r * (q + 1) + (xcd - r) * q) + off; }
        const int nig = WGM * nN, gid = wgid / nig, fm = gid * WGM, gsz = (nM - fm) < WGM ? (nM - fm) : WGM;
        u.pm = fm + ((wgid % nig) % gsz); u.pn = (wgid % nig) / gsz; return true;
    }
    __device__ __forceinline__ void a_ready(const Unit&) const {}
    __device__ __forceinline__ void done(const Unit&) const {}
};

typedef float f32x2p __attribute__((ext_vector_type(2))); typedef __bf16 bf16x2p __attribute__((ext_vector_type(2)));
__device__ __forceinline__ unsigned cvt_pk_bf16(float lo, float hi) { const f32x2p v = {lo, hi}; return __builtin_bit_cast(unsigned, __builtin_convertvector(v, bf16x2p)); }

template <int MODE> struct EpiRowScaleBf16 {
    static constexpr bool PERM = true, AFTER_DRAIN = false;
    bf16_t* O; int ldc; const float* rs; float eps;
    __device__ __forceinline__ void operator()(const f32x4 (&acc)[2][2][4][2], const Unit& u, int wr, int wc, int fr, int fq) const {
        const int row0 = u.pm * BM + wr * 64 + fr; const int col0 = u.pn * BM + wc * 32 + 8 * fq;
#pragma unroll
        for (int ai = 0; ai < 2; ++ai)
#pragma unroll
            for (int m = 0; m < 4; ++m) { const int row = row0 + ai * HALF + m * 16; float sc;
                if (MODE == 0) sc = rs[row];
                else { const f32x4* q = (const f32x4*)(rs + (size_t)row * 16); const f32x4 a = q[0], b = q[1], c = q[2], d = q[3];
                       const float s = ((a[0] + a[1]) + (a[2] + a[3])) + ((b[0] + b[1]) + (b[2] + b[3])) + ((c[0] + c[1]) + (c[2] + c[3])) + ((d[0] + d[1]) + (d[2] + d[3]));
                       sc = __builtin_amdgcn_rsqf(s * (1.0f / 1024.0f) + eps); }
                bf16_t* rowp = O + (size_t)row * ldc + col0;
#pragma unroll
                for (int bj = 0; bj < 2; ++bj) { const f32x4 v0 = acc[ai][bj][m][0] * sc, v1 = acc[ai][bj][m][1] * sc;
                    u32x4 w; w.x = cvt_pk_bf16(v0[0], v0[1]); w.y = cvt_pk_bf16(v0[2], v0[3]); w.z = cvt_pk_bf16(v1[0], v1[1]); w.w = cvt_pk_bf16(v1[2], v1[3]);
                    asm volatile("s_nop 4\n\tglobal_store_dwordx4 %0, %1, off sc1\n\ts_nop 2" :: "v"(rowp + bj * HALF), "v"(w) : "memory"); } }
    }
};
struct EpiResidual {
    static constexpr bool PERM = false, AFTER_DRAIN = false;
    const float* base; float* out; bf16_t* outb; float* ssq; int ldc;
    __device__ __forceinline__ void operator()(const f32x4 (&acc)[2][2][4][2], const Unit& u, int wr, int wc, int fr, int fq) const {
        const int col0 = u.pn * BM + wc * 32 + 4 * fq;
#pragma unroll
        for (int ai = 0; ai < 2; ++ai)
#pragma unroll
            for (int m = 0; m < 4; ++m) { const int row = u.pm * BM + ai * HALF + wr * 64 + m * 16 + fr; const size_t off = (size_t)row * ldc + col0; float s = 0.f;
#pragma unroll
                for (int bj = 0; bj < 2; ++bj) { u32x2 wn[2];
#pragma unroll
                    for (int n = 0; n < 2; ++n) { const size_t o = off + bj * HALF + n * 16; const f32x4 h = __builtin_nontemporal_load((const f32x4*)(base + o)) + acc[ai][bj][m][n];
                        wn[n].x = cvt_pk_bf16(h[0], h[1]); wn[n].y = cvt_pk_bf16(h[2], h[3]);
                        s += (h[0] * h[0] + h[1] * h[1]) + (h[2] * h[2] + h[3] * h[3]); }
                    const u32x2 px = __builtin_amdgcn_permlane16_swap(wn[0].x, wn[1].x, false, false), py = __builtin_amdgcn_permlane16_swap(wn[0].y, wn[1].y, false, false);
                    u32x4 w; w.x = px.x; w.y = py.x; w.z = px.y; w.w = py.y;
                    asm volatile("s_nop 4\n\tglobal_store_dwordx4 %0, %1, off sc1\n\ts_nop 2" :: "v"(outb + off + bj * HALF + ((fq & 1) ? 12 : 0)), "v"(w) : "memory"); }
                s += __shfl_xor(s, 16); s += __shfl_xor(s, 32);
                if (fq == 0) ssq[(size_t)row * 16 + u.pn * 4 + wc] = s; }
    }
};
template <class Epi, class Sched, bool ALIGN_EPI = false, bool SP2 = false>
__device__ __forceinline__ void gemm_phase(PG8_LAS unsigned char* lds, const Gemm g, const Sched& S, const Epi& E) {
    int tid_ = threadIdx.x; asm volatile("" : "+v"(tid_));
    const int tid = tid_, wid = __builtin_amdgcn_readfirstlane(tid >> 6), lane = tid & 63, wr = wid >> 2, wc = wid & 3, fr = lane & 15, fq = lane >> 4;
    const int K = g.K, nt = K / BK;
    unsigned voffA[2], voffB[2];
#pragma unroll
    for (int i = 0; i < 2; ++i) { int R, C; stage_rc(tid * 16 + i * 8192, R, C); const int Rb = Epi::PERM ? ((R & ~31) + perm32(R & 31)) : R;
        voffA[i] = (unsigned)(R * g.lda + C) * 2u; voffB[i] = (unsigned)(Rb * g.ldb + C) * 2u; }
    const size_t kstep = (size_t)(BK * 2);
    const size_t hstepA = (size_t)HALF * g.lda * 2, hstepB = (size_t)HALF * g.ldb * 2;
    const size_t tstepA = 2 * hstepA, tstepB = 2 * hstepB;
    const unsigned ldsw = (unsigned)wid * 1024u;
    const int aoff = lds_byte(wr * 64 + fr, fq * 8), boff = lds_byte(wc * 32 + fr, fq * 8);
#define PG8_SA(b, h) (((b) * 2 + (h)) * HTB)
#define PG8_SB(b, h) ((4 + (b) * 2 + (h)) * HTB)
#define PG8_STAGE(bufoff, gbase, voff) do { _Pragma("unroll") for (int _i = 0; _i < 2; ++_i) \
        __builtin_amdgcn_global_load_lds((const unsigned*)((const char*)(gbase) + (voff)[_i]), (PG8_LAS unsigned*)(lds + (bufoff) + ldsw + _i * 8192), 16, 0, 0); } while (0)
#define PG8_LDA(dst, b, h) do { _Pragma("unroll") for (int m = 0; m < 4; ++m) _Pragma("unroll") for (int k = 0; k < 2; ++k) dst[m][k] = *(const PG8_LAS bf16x8*)(lds + PG8_SA(b, h) + aoff + m * 2048 + k * 1024); } while (0)
#define PG8_LDB(dst, b, h) do { _Pragma("unroll") for (int n = 0; n < 2; ++n) _Pragma("unroll") for (int k = 0; k < 2; ++k) dst[n][k] = *(const PG8_LAS bf16x8*)(lds + PG8_SB(b, h) + boff + n * 2048 + k * 1024); } while (0)
#define PG8_MMA(ai, bj, At, Bt) do { __builtin_amdgcn_s_setprio(1); _Pragma("unroll") for (int m = 0; m < 4; ++m) _Pragma("unroll") for (int n = 0; n < 2; ++n) _Pragma("unroll") for (int k = 0; k < 2; ++k) \
        acc[ai][bj][m][n] = __builtin_amdgcn_mfma_f32_16x16x32_bf16(Bt[n][k], At[m][k], acc[ai][bj][m][n], 0, 0, 0); __builtin_amdgcn_s_setprio(0); } while (0)
#define PG8_WAIT_V(n) asm volatile("s_waitcnt vmcnt(" #n ")" ::: "memory")
#define PG8_WAIT_L(n) asm volatile("s_waitcnt lgkmcnt(" #n ")" ::: "memory")
#define PG8_BAR __builtin_amdgcn_s_barrier()
#define PG8_SCHED __builtin_amdgcn_sched_barrier(0)
    Unit cur, nxt; int ui = 0;
    if (!S.next(0, cur)) return;
    f32x4 acc[2][2][4][2];
#pragma unroll
    for (int a = 0; a < 2; ++a)
#pragma unroll
        for (int b = 0; b < 2; ++b)
#pragma unroll
            for (int m = 0; m < 4; ++m)
#pragma unroll
                for (int n = 0; n < 2; ++n) acc[a][b][m][n] = (f32x4){0.f, 0.f, 0.f, 0.f};
    bf16x8 At[4][2], B0[2][2], B1[2][2];
    const char* cA = (const char*)g.A + (size_t)cur.pm * tstepA; const char* cB = (const char*)g.Bt + (size_t)cur.pn * tstepB;
    S.a_ready(cur);
    if constexpr (SP2) {
        PG8_STAGE(PG8_SB(0, 0), cB, voffB); PG8_STAGE(PG8_SB(0, 1), cB + hstepB, voffB); PG8_STAGE(PG8_SA(0, 0), cA, voffA); PG8_STAGE(PG8_SA(0, 1), cA + hstepA, voffA);
        if (wr == 1) PG8_BAR;
        PG8_WAIT_V(2); PG8_BAR;
        PG8_STAGE(PG8_SB(1, 0), cB + kstep, voffB); PG8_STAGE(PG8_SA(1, 0), cA + kstep, voffA); PG8_STAGE(PG8_SB(1, 1), cB + hstepB + kstep, voffB);
        PG8_WAIT_V(6); PG8_BAR;
    } else {
        PG8_STAGE(PG8_SB(0, 0), cB, voffB); PG8_STAGE(PG8_SA(0, 0), cA, voffA); PG8_STAGE(PG8_SB(0, 1), cB + hstepB, voffB); PG8_STAGE(PG8_SA(0, 1), cA + hstepA, voffA);
        if (wr == 1) PG8_BAR;
        PG8_WAIT_V(4); PG8_BAR;
        PG8_STAGE(PG8_SB(1, 0), cB + kstep, voffB); PG8_STAGE(PG8_SA(1, 0), cA + kstep, voffA); PG8_STAGE(PG8_SB(1, 1), cB + hstepB + kstep, voffB);
        PG8_WAIT_V(6); PG8_BAR;
    }
    for (;;) {
        const bool has_next = S.next(ui + 1, nxt);
        const char* nA = has_next ? (const char*)g.A + (size_t)nxt.pm * tstepA : cA; const char* nB = has_next ? (const char*)g.Bt + (size_t)nxt.pn * tstepB : cB;
        for (int t = 0; t < nt; t += 2) {
            const bool last = (t == nt - 2);
            const char* a1 = cA + (size_t)(t + 1) * kstep;
            const char* a2 = last ? nA : cA + (size_t)(t + 2) * kstep; const char* b2 = last ? nB : cB + (size_t)(t + 2) * kstep;
            const char* a3 = a2 + kstep; const char* b3 = b2 + kstep;
            if (last && has_next) S.a_ready(nxt);
            if constexpr (SP2) {
            PG8_LDB(B0, 0, 0); PG8_LDB(B1, 0, 1); PG8_SCHED; PG8_LDA(At, 0, 0); PG8_STAGE(PG8_SA(1, 1), a1 + hstepA, voffA);
            PG8_WAIT_V(8); PG8_WAIT_L(0); PG8_BAR; PG8_MMA(0, 0, At, B0); PG8_MMA(0, 1, At, B1); PG8_BAR; PG8_SCHED;
            PG8_LDA(At, 0, 1); PG8_STAGE(PG8_SB(0, 0), b2, voffB); PG8_STAGE(PG8_SB(0, 1), b2 + hstepB, voffB); PG8_STAGE(PG8_SA(0, 0), a2, voffA);
            PG8_WAIT_V(8); PG8_WAIT_L(0); PG8_BAR; PG8_MMA(1, 0, At, B0); PG8_MMA(1, 1, At, B1); PG8_BAR; PG8_SCHED;
            PG8_LDB(B0, 1, 0); PG8_LDB(B1, 1, 1); PG8_SCHED; PG8_LDA(At, 1, 0); PG8_STAGE(PG8_SA(0, 1), a2 + hstepA, voffA);
            PG8_WAIT_V(8); PG8_WAIT_L(0); PG8_BAR; PG8_MMA(0, 0, At, B0); PG8_MMA(0, 1, At, B1); PG8_BAR; PG8_SCHED;
            PG8_LDA(At, 1, 1); PG8_STAGE(PG8_SB(1, 0), b3, voffB); PG8_STAGE(PG8_SB(1, 1), b3 + hstepB, voffB); PG8_STAGE(PG8_SA(1, 0), a3, voffA);
            PG8_WAIT_V(8); PG8_WAIT_L(0); PG8_BAR; PG8_MMA(1, 0, At, B0); PG8_MMA(1, 1, At, B1); PG8_BAR; PG8_SCHED;
            } else {
            PG8_LDB(B0, 0, 0); PG8_SCHED; PG8_LDA(At, 0, 0); PG8_STAGE(PG8_SA(1, 1), a1 + hstepA, voffA);
            PG8_WAIT_L(8); PG8_BAR; PG8_WAIT_L(0); PG8_MMA(0, 0, At, B0); PG8_BAR; PG8_SCHED;
            PG8_LDB(B1, 0, 1); PG8_STAGE(PG8_SB(0, 0), b2, voffB);
            PG8_BAR; PG8_WAIT_L(0); PG8_MMA(0, 1, At, B1); PG8_BAR;
            PG8_LDA(At, 0, 1); PG8_STAGE(PG8_SA(0, 0), a2, voffA);
            PG8_BAR; PG8_WAIT_L(0); PG8_MMA(1, 0, At, B0); PG8_BAR; PG8_SCHED;
            PG8_STAGE(PG8_SB(0, 1), b2 + hstepB, voffB);
            PG8_WAIT_V(6); PG8_BAR; PG8_MMA(1, 1, At, B1); PG8_BAR;
            PG8_LDB(B0, 1, 0); PG8_SCHED; PG8_LDA(At, 1, 0); PG8_STAGE(PG8_SA(0, 1), a2 + hstepA, voffA);
            PG8_WAIT_L(8); PG8_BAR; PG8_WAIT_L(0); PG8_MMA(0, 0, At, B0); PG8_BAR; PG8_SCHED;
            PG8_LDB(B1, 1, 1); PG8_STAGE(PG8_SB(1, 0), b3, voffB);
            PG8_BAR; PG8_WAIT_L(0); PG8_MMA(0, 1, At, B1); PG8_BAR;
            PG8_LDA(At, 1, 1); PG8_STAGE(PG8_SA(1, 0), a3, voffA);
            PG8_BAR; PG8_WAIT_L(0); PG8_MMA(1, 0, At, B0); PG8_BAR; PG8_SCHED;
            PG8_STAGE(PG8_SB(1, 1), b3 + hstepB, voffB);
            PG8_WAIT_V(6); PG8_BAR; PG8_MMA(1, 1, At, B1); PG8_BAR;
            }
        }
        if constexpr (ALIGN_EPI) { if (wr == 0) PG8_BAR; }
        if constexpr (!Epi::AFTER_DRAIN) { E(acc, cur, wr, wc, fr, fq); S.done(cur); }
        if (!has_next) break;
#pragma unroll
        for (int a = 0; a < 2; ++a)
#pragma unroll
            for (int b = 0; b < 2; ++b)
#pragma unroll
                for (int m = 0; m < 4; ++m)
#pragma unroll
                    for (int n = 0; n < 2; ++n) acc[a][b][m][n] = (f32x4){0.f, 0.f, 0.f, 0.f};
        cur = nxt; cA = nA; cB = nB; ++ui;
        if constexpr (ALIGN_EPI) { if (wr == 1) PG8_BAR; }
    }
    PG8_WAIT_V(0);
    if constexpr (!ALIGN_EPI) { if (wr == 0) PG8_BAR; }
    PG8_BAR;
    if constexpr (Epi::AFTER_DRAIN) { E.fused(acc, cur, wr, wc, fr, fq, lds, wid, lane); S.done(cur); }
#undef PG8_SA
#undef PG8_SB
#undef PG8_STAGE
#undef PG8_LDA
#undef PG8_LDB
#undef PG8_MMA
#undef PG8_WAIT_V
#undef PG8_WAIT_L
#undef PG8_BAR
#undef PG8_SCHED
}
}
#define PG8_SP2 true
#define PG8_ALIGN true

#define GAS __attribute__((address_space(1)))
#define LAS __attribute__((address_space(3)))
typedef unsigned short bf16;
typedef unsigned v4u __attribute__((ext_vector_type(4)));
typedef unsigned v2u __attribute__((ext_vector_type(2)));
typedef float f32x4 __attribute__((ext_vector_type(4)));
typedef float f32x2 __attribute__((ext_vector_type(2)));
typedef short bf16x8 __attribute__((ext_vector_type(8)));
#define RLX_AGENT __ATOMIC_RELAXED, __HIP_MEMORY_SCOPE_AGENT

constexpr int NWAVES = 8, NTHR = 512;
constexpr int SEQ = 8192, DM = 1024, MROWS = 16384, NMETA = 16;
constexpr int NIN = 3080, NPROJ = 3072;
constexpr int CU_ = 0, CV_ = 512, CO_ = 1024, CQS = 1536, CKS = 2048, CVS = 2560;
constexpr int OU_ = 0, OV_ = 512, OI_ = 1536, OF_ = 1540, OKS = 2056, OVS = 2568;
constexpr float EPS = 1e-6f;
constexpr int NEXP = 16384;

constexpr size_t KiB = 1024, MiB = 1024 * 1024;
constexpr size_t WS_CTL = 0, CTL_ZERO_BYTES = 64 * KiB;
constexpr size_t WS_RSTD1 = 64 * KiB;
constexpr size_t WS_SSQ   = WS_RSTD1 + 64 * KiB;
constexpr size_t WS_GI    = WS_SSQ + 1 * MiB;
constexpr size_t WS_GF    = WS_GI + 256 * KiB;
constexpr size_t WS_BT    = WS_GF + 256 * KiB;
constexpr size_t WS_NU    = WS_BT + 256 * KiB;
constexpr size_t WS_NS    = WS_NU + 512 * KiB;
constexpr size_t WS_AC    = WS_NS + 512 * KiB;
constexpr size_t WS_BC    = WS_AC + 4 * KiB;
constexpr size_t WS_MIN   = WS_BC + 4 * KiB;
constexpr size_t WS_PRM   = WS_MIN + 4 * KiB;
constexpr size_t WS_KM    = WS_PRM + 196 * KiB;
constexpr size_t WS_WQMT  = WS_KM + 32 * KiB;
constexpr size_t WS_WKMT  = WS_WQMT + 128 * KiB;
constexpr size_t WS_SKB   = WS_WKMT + 128 * KiB;
constexpr size_t WS_RSTDM = WS_SKB + 64 * KiB;
constexpr size_t WS_RS2 = WS_RSTDM + 4 * KiB;
constexpr size_t WS_ESC = WS_RS2 + 64 * KiB;
constexpr size_t WS_SMALL_END = WS_ESC + 128 * KiB;
static_assert(WS_SMALL_END <= 4 * MiB, "small region");
constexpr size_t WS_WINT = 4 * MiB, WS_WOUTT = 10 * MiB, WS_WQT = 12 * MiB;
constexpr size_t WS_EU = 16 * MiB, WS_EV = 32 * MiB;
constexpr size_t WS_PR = 80 * MiB;
constexpr size_t WS_QP = WS_PR;
constexpr size_t WS_QK = 176 * MiB;
constexpr size_t WS_XB = WS_QK, WS_H1B = WS_QK;
constexpr size_t WS_U = 208 * MiB;
constexpr size_t WS_PRMP = WS_U, WS_TK = WS_U;
constexpr size_t WS_CB = 240 * MiB;
constexpr size_t WS_END = 256 * MiB;

constexpr int LDS_BYTES = 148480, LDSCTL_OFF = LDS_BYTES - 256;

typedef float f32x2c __attribute__((ext_vector_type(2))); typedef __bf16 bf16x2c __attribute__((ext_vector_type(2)));
__device__ __forceinline__ unsigned pk2(float lo, float hi) { const f32x2c v = {lo, hi}; return __builtin_bit_cast(unsigned, __builtin_convertvector(v, bf16x2c)); }
__device__ __forceinline__ unsigned f2bf(float f) { return pk2(f, f) & 0xffffu; }
__device__ __forceinline__ void st16_wt(void* p, v4u w) { asm volatile("s_nop 4\n\tglobal_store_dwordx4 %0, %1, off sc1\n\ts_nop 2" :: "v"(p), "v"(w) : "memory"); }
__device__ __forceinline__ unsigned pk_fp8x4(f32x4 v) {
    const float a = fminf(fmaxf(v[0], -448.f), 448.f), b = fminf(fmaxf(v[1], -448.f), 448.f), c = fminf(fmaxf(v[2], -448.f), 448.f), d = fminf(fmaxf(v[3], -448.f), 448.f);
    int r = __builtin_amdgcn_cvt_pk_fp8_f32(a, b, 0, false); r = __builtin_amdgcn_cvt_pk_fp8_f32(c, d, r, true); return (unsigned)r; }
__device__ __forceinline__ unsigned pk_fp4x8(f32x4 a, f32x4 b) {
    unsigned r = 0u; r = __builtin_amdgcn_cvt_scalef32_pk_fp4_f32(r, a[0], a[1], 1.0f, 0); r = __builtin_amdgcn_cvt_scalef32_pk_fp4_f32(r, a[2], a[3], 1.0f, 1);
    r = __builtin_amdgcn_cvt_scalef32_pk_fp4_f32(r, b[0], b[1], 1.0f, 2); r = __builtin_amdgcn_cvt_scalef32_pk_fp4_f32(r, b[2], b[3], 1.0f, 3); return r; }
__device__ __forceinline__ float bf2f(unsigned h) { return __builtin_bit_cast(float, h << 16); }
template <int CTRL> __device__ __forceinline__ float dpp_f(float v) { return __builtin_bit_cast(float, __builtin_amdgcn_update_dpp(0, __builtin_bit_cast(int, v), CTRL, 0xf, 0xf, true)); }
__device__ __forceinline__ float rdl_f(float v, int l) { return __builtin_bit_cast(float, __builtin_amdgcn_readlane(__builtin_bit_cast(int, v), l)); }
__device__ __forceinline__ float wave_sum(float v) {
    v += dpp_f<0xB1>(v); v += dpp_f<0x4E>(v); v += dpp_f<0x124>(v); v += dpp_f<0x128>(v);
    return (rdl_f(v, 0) + rdl_f(v, 16)) + (rdl_f(v, 32) + rdl_f(v, 48));
}
__device__ __forceinline__ float wave_max(float v) {
    v = fmaxf(v, dpp_f<0xB1>(v)); v = fmaxf(v, dpp_f<0x4E>(v)); v = fmaxf(v, dpp_f<0x124>(v)); v = fmaxf(v, dpp_f<0x128>(v));
    return fmaxf(fmaxf(rdl_f(v, 0), rdl_f(v, 16)), fmaxf(rdl_f(v, 32), rdl_f(v, 48)));
}
__device__ __forceinline__ float row16_sum(float v) { v += dpp_f<0xB1>(v); v += dpp_f<0x4E>(v); v += dpp_f<0x124>(v); v += dpp_f<0x128>(v); return v; }
__device__ __forceinline__ float row16_min(float v) { v = fminf(v, dpp_f<0xB1>(v)); v = fminf(v, dpp_f<0x4E>(v)); v = fminf(v, dpp_f<0x124>(v)); v = fminf(v, dpp_f<0x128>(v)); return v; }
template <int CTRL> __device__ __forceinline__ float dpp_shr(float v, float idv) { return __builtin_bit_cast(float, __builtin_amdgcn_update_dpp(__builtin_bit_cast(int, idv), __builtin_bit_cast(int, v), CTRL, 0xf, 0xf, false)); }
__device__ __forceinline__ float wave_scan_sum(float v, int lane) {
    v += dpp_shr<0x111>(v, 0.f); v += dpp_shr<0x112>(v, 0.f); v += dpp_shr<0x114>(v, 0.f); v += dpp_shr<0x118>(v, 0.f);
    const float r0 = rdl_f(v, 15), r1 = rdl_f(v, 31), r2 = rdl_f(v, 47);
    return v + (lane < 16 ? 0.f : lane < 32 ? r0 : lane < 48 ? r0 + r1 : (r0 + r1) + r2);
}
__device__ __forceinline__ float wave_scan_max(float v, int lane) {
    const float NI = -3.0e38f;
    v = fmaxf(v, dpp_shr<0x111>(v, NI)); v = fmaxf(v, dpp_shr<0x112>(v, NI)); v = fmaxf(v, dpp_shr<0x114>(v, NI)); v = fmaxf(v, dpp_shr<0x118>(v, NI));
    const float r0 = rdl_f(v, 15), r1 = rdl_f(v, 31), r2 = rdl_f(v, 47);
    return fmaxf(v, lane < 16 ? NI : lane < 32 ? r0 : lane < 48 ? fmaxf(r0, r1) : fmaxf(fmaxf(r0, r1), r2));
}
__device__ __forceinline__ float logsigmoidf_(float a) { return fminf(a, 0.f) - __logf(1.f + __expf(-fabsf(a))); }
__device__ __forceinline__ float siluf_(float a) { return a * __builtin_amdgcn_rcpf(1.f + __expf(-a)); }
template <int KS> __device__ __forceinline__ f32x4 mma_rows(const LAS bf16* a, const LAS bf16* b, f32x4 acc) {
#pragma unroll
    for (int k = 0; k < KS; ++k) { const bf16x8 av = *(const LAS bf16x8*)(a + 32 * k), bv = *(const LAS bf16x8*)(b + 32 * k); acc = __builtin_amdgcn_mfma_f32_16x16x32_bf16(av, bv, acc, 0, 0, 0); }
    return acc;
}
#define XB_TMO      128
#define XB_XCNT(j)  (256  + 64 * (j))
#define XB_XSUB(j)  (1280 + 64 * (j))
#define XB_XGEN(j)  (2304 + 64 * (j))
#define XB_TOP      3328
#define XB_TOPGEN   3392
#define XCD_BAR_WORDS 3456
#define XB_SPIN_CAP (1u << 18)

__device__ __forceinline__ unsigned xb_ld(unsigned* p)              { return __hip_atomic_load(p, __ATOMIC_RELAXED, __HIP_MEMORY_SCOPE_AGENT); }
__device__ __forceinline__ unsigned xb_add(unsigned* p, unsigned v) { return __hip_atomic_fetch_add(p, v, __ATOMIC_RELAXED, __HIP_MEMORY_SCOPE_AGENT); }
__device__ __forceinline__ unsigned xb_xcc_id() { return (unsigned)__builtin_amdgcn_s_getreg((3 << 11) | 20) & 0xFu; }
#define XB_SPIN(cond, bar) do { unsigned _sp = 0; while (cond) { __builtin_amdgcn_s_sleep(1); \
    if ((++_sp & 255u) == 0u) { if (xb_ld(&(bar)[XB_TMO])) break; if (_sp > XB_SPIN_CAP) { atomicAdd(&(bar)[XB_TMO], 1u); break; } } } } while (0)

struct XcdBarrier {
    unsigned* bar; unsigned x;
    volatile LAS unsigned* st;
};

__device__ __forceinline__ XcdBarrier xcd_barrier_post(unsigned* bar, volatile LAS unsigned* st) {
    XcdBarrier b; b.bar = bar; b.x = xb_xcc_id(); b.st = st;
    if (threadIdx.x == 0) (void)xb_add(&bar[XB_XCNT(b.x)], 1u);
    return b;
}
__device__ __forceinline__ void xcd_barrier_complete(unsigned* bar, unsigned x, unsigned& nloc, unsigned& nx) {
    const unsigned G = gridDim.x * gridDim.y * gridDim.z;
    unsigned sum, cnt, mine, sp = 0u;
    for (;;) {
        sum = 0u; cnt = 0u; mine = 0u;
#pragma unroll
        for (unsigned j = 0; j < 16; ++j) { const unsigned c = xb_ld(&bar[XB_XCNT(j)]); sum += c; cnt += (c > 0u) ? 1u : 0u; mine = (j == x) ? c : mine; }
        if (sum == G) break;
        __builtin_amdgcn_s_sleep(1);
        if ((++sp & 255u) == 0u) { if (xb_ld(&bar[XB_TMO])) break; if (sp > XB_SPIN_CAP) { atomicAdd(&bar[XB_TMO], 1u); break; } }
    }
    nloc = mine > 0u ? mine : 1u; nx = cnt > 0u ? cnt : 1u;
}

__device__ __forceinline__ void xcd_barrier(const XcdBarrier& b) {
    asm volatile("s_waitcnt vmcnt(0)" ::: "memory");
    __syncthreads();
    if (threadIdx.x == 0) {
        unsigned* bar = b.bar;
        __builtin_amdgcn_s_waitcnt(0);
        unsigned nloc = b.st[0], nx = b.st[1];
        if (nloc == 0u) { xcd_barrier_complete(bar, b.x, nloc, nx); b.st[0] = nloc; b.st[1] = nx; }
        const unsigned old = xb_add(&bar[XB_XSUB(b.x)], 1u);
        const unsigned gen = old / nloc;
        if (old + 1u == (gen + 1u) * nloc) {
            __builtin_amdgcn_fence(__ATOMIC_RELEASE, "agent");
            asm volatile("s_waitcnt vmcnt(0)" ::: "memory");
            const unsigned og = xb_add(&bar[XB_TOP], 1u);
            const unsigned tg = og / nx;
            if (og + 1u == (tg + 1u) * nx) xb_add(&bar[XB_TOPGEN], 1u);
            else XB_SPIN(xb_ld(&bar[XB_TOPGEN]) == tg, bar);
            __builtin_amdgcn_fence(__ATOMIC_ACQUIRE, "agent");
            xb_add(&bar[XB_XGEN(b.x)], 1u);
            asm volatile("s_waitcnt vmcnt(0)" ::: "memory");
        } else {
            XB_SPIN(xb_ld(&bar[XB_XGEN(b.x)]) == gen, bar);
            __builtin_amdgcn_fence(__ATOMIC_ACQUIRE, "agent");
            asm volatile("s_waitcnt vmcnt(0)" ::: "memory");
        }
    }
    __syncthreads();
}
template <class WORK> __device__ __forceinline__ void xcd_barrier_w(const XcdBarrier& b, const WORK& work) {
    asm volatile("s_waitcnt vmcnt(0)" ::: "memory");
    __syncthreads();
    if (threadIdx.x == 0) {
        unsigned* bar = b.bar;
        __builtin_amdgcn_s_waitcnt(0);
        unsigned nloc = b.st[0], nx = b.st[1];
        if (nloc == 0u) { xcd_barrier_complete(bar, b.x, nloc, nx); b.st[0] = nloc; b.st[1] = nx; }
        const unsigned old = xb_add(&bar[XB_XSUB(b.x)], 1u);
        const unsigned gen = old / nloc;
        if (old + 1u == (gen + 1u) * nloc) {
            __builtin_amdgcn_fence(__ATOMIC_RELEASE, "agent");
            asm volatile("s_waitcnt vmcnt(0)" ::: "memory");
            __builtin_amdgcn_fence(__ATOMIC_ACQUIRE, "agent");
            const unsigned og = xb_add(&bar[XB_TOP], 1u);
            const unsigned tg = og / nx;
            if (og + 1u == (tg + 1u) * nx) xb_add(&bar[XB_TOPGEN], 1u);
            else XB_SPIN(xb_ld(&bar[XB_TOPGEN]) == tg, bar);
            xb_add(&bar[XB_XGEN(b.x)], 1u);
            asm volatile("s_waitcnt vmcnt(0)" ::: "memory");
        } else {
            __builtin_amdgcn_fence(__ATOMIC_ACQUIRE, "agent");
            XB_SPIN(xb_ld(&bar[XB_XGEN(b.x)]) == gen, bar);
            asm volatile("s_waitcnt vmcnt(0)" ::: "memory");
        }
    }
    else work();
    __syncthreads();
}

struct Params { const float* in[20]; float* out; unsigned char* ws; };
struct Frame {
    LAS unsigned char* lds;
    int tid, lane, wave, vcu, G;
    const float *x, *meta, *g_mix, *w_in, *conv_w, *conv_b, *w_qm, *w_km, *b_i, *b_f, *skip, *gn_g, *sb_g, *w_out, *g_ffn, *w_query, *sub_keys, *eu, *ev, *g_fin;
    float* out; unsigned char* ws;
};
#define WSP(T, off) ((T*)(F.ws + (off)))

__device__ __forceinline__ void p0_transpose_item(const float* W, int ldw, int k0, int srccol0, bf16* WT, int K, int dstrow0, const float* gk, float cs, LAS float* scr, int lane, const float* META, float* PRMP) {
    {
        float wv[32], sv[32];
#pragma unroll
        for (int i = 0; i < 32; ++i) { const int kk = 2 * i + (lane >> 5); wv[i] = W[(size_t)(k0 + kk) * ldw + srccol0 + (lane & 31)]; sv[i] = gk ? gk[k0 + kk] * cs : cs; }
#pragma unroll
        for (int i = 0; i < 32; ++i) { const int kk = 2 * i + (lane >> 5); scr[kk * 33 + (lane & 31)] = wv[i] * sv[i]; } }
    if (META) { LAS float* mb = scr + 64 * 33;
#pragma unroll
        for (int i = 0; i < 16; ++i) mb[i * 64 + lane] = META[(size_t)i * DM + k0 + lane]; }
    const int c = lane & 7;
#pragma unroll
    for (int j = 0; j < 4; ++j) { const int n = (lane >> 3) + 8 * j; const LAS float* s = scr + (8 * c) * 33 + n;
        v4u o; o.x = pk2(s[0 * 33], s[1 * 33]); o.y = pk2(s[2 * 33], s[3 * 33]); o.z = pk2(s[4 * 33], s[5 * 33]); o.w = pk2(s[6 * 33], s[7 * 33]);
        st16_wt(WT + (size_t)(dstrow0 + n) * K + k0 + 8 * c, o); }
    if (META) { const LAS float* mb = scr + 64 * 33; const int n = lane & 31, r0 = (lane >> 5) * 8; float acc[8];
#pragma unroll
        for (int r = 0; r < 8; ++r) acc[r] = 0.f;
#pragma unroll 4
        for (int kk = 0; kk < 64; kk += 4) { const float w0 = scr[kk * 33 + n], w1 = scr[(kk + 1) * 33 + n], w2 = scr[(kk + 2) * 33 + n], w3 = scr[(kk + 3) * 33 + n];
#pragma unroll
            for (int r = 0; r < 8; ++r) { const f32x4 m = *(const LAS f32x4*)(mb + (r0 + r) * 64 + kk); acc[r] += (m[0] * w0 + m[1] * w1) + (m[2] * w2 + m[3] * w3); } }
#pragma unroll
        for (int r = 0; r < 8; ++r) PRMP[((size_t)(k0 >> 6) * 16 + r0 + r) * NIN + srccol0 + n] = acc[r]; }
}

__device__ __forceinline__ void p0_pack_row_i4(Frame& F, f32x4 (&a)[4], const f32x4 (&gf)[4], int r, int lane) {
    const bool isu = r < NEXP; float ss = 0.f;
#pragma unroll
    for (int j = 0; j < 4; ++j) { if (isu) a[j] = a[j] * gf[j]; ss += (a[j][0] * a[j][0] + a[j][1] * a[j][1]) + (a[j][2] * a[j][2] + a[j][3] * a[j][3]); }
    ss = wave_sum(ss);
    const float rms = sqrtf(ss * (1.0f / DM)); const float step = rms > 0.f ? 0.3125f * rms : 1.0f, inv = 1.0f / step;
    v2u o;
#pragma unroll
    for (int d = 0; d < 2; ++d) { unsigned w = 0u;
#pragma unroll
        for (int n = 0; n < 8; ++n) { const int i = 8 * d + n; const float q = floorf(a[i >> 2][i & 3] * inv); const int k = (int)fminf(fmaxf(q, -8.f), 7.f); w |= ((unsigned)k & 0xfu) << (4 * n); }
        o[d] = w; }
    *((v2u*)(F.ws + (isu ? WS_EU : WS_EV) + (size_t)(r & (NEXP - 1)) * (DM / 2)) + lane) = o;
    if (lane == 0) WSP(float, WS_ESC)[r] = step;
}

__device__ __forceinline__ void expert_rows_in_barrier(Frame& F, int k) {
    int lane_ = threadIdx.x & 63; asm volatile("" : "+v"(lane_)); const int lane = lane_;
    const int NW = F.G * 7, wv = F.vcu * 7 + (F.wave - 1);
    const int per = (2 * NEXP + NW - 1) / NW, chunk = (per + 5) / 6;
    f32x4 gf[4];
#pragma unroll
    for (int j = 0; j < 4; ++j) gf[j] = ((const f32x4*)F.g_ffn)[lane + 64 * j];
    for (int i = k * chunk; i < (k + 1) * chunk && i < per; i += 4) {
        int rr[4]; f32x4 a[4][4];
#pragma unroll
        for (int q = 0; q < 4; ++q) { rr[q] = (i + q < (k + 1) * chunk && i + q < per) ? (i + q) * NW + wv : 2 * NEXP;
            if (rr[q] < 2 * NEXP) { const f32x4* s1 = (const f32x4*)((rr[q] >= NEXP ? F.ev : F.eu) + (size_t)(rr[q] & (NEXP - 1)) * DM) + lane;
#pragma unroll
                for (int j = 0; j < 4; ++j) a[q][j] = s1[64 * j]; } }
#pragma unroll
        for (int q = 0; q < 4; ++q) if (rr[q] < 2 * NEXP) { const int r = rr[q];
            if (r < NEXP) p0_pack_row_i4(F, a[q], gf, r, lane);
            else { v2u o; o[0] = pk_fp4x8(a[q][0] * 4.0f, a[q][1] * 4.0f); o[1] = pk_fp4x8(a[q][2] * 4.0f, a[q][3] * 4.0f); *((v2u*)(F.ws + WS_EV + (size_t)(r - NEXP) * (DM / 2)) + lane) = o; } }
    }
}

__device__ __forceinline__ void p0_prologue(Frame& F) {
    LAS float* scr = (LAS float*)(F.lds + 32768 + F.wave * 14336);
    LAS float* wg = (LAS float*)F.lds;
    const int gw = F.vcu * NWAVES + F.wave, NGW = F.G * NWAVES, lane = F.lane;
    { float wa[16], ga[16];
#pragma unroll
      for (int q = 0; q < 16; ++q) { const int i = F.tid + NTHR * q; const int jj = i >> 10, k = i & 1023; wa[q] = F.w_in[(size_t)k * NIN + OI_ + jj]; ga[q] = F.g_mix[k]; }
#pragma unroll
      for (int q = 0; q < 16; ++q) wg[F.tid + NTHR * q] = wa[q] * ga[q]; }
    {
        constexpr int I_IN = 16 * 96, I_OUT = 16 * 32, I_Q = 16 * 64, I_M = 2 * 4;
        constexpr int NITEMS = I_IN + I_OUT + I_Q + 8 * I_M;
        for (int it = gw; it < NITEMS; it += NGW) {
            int r = it;
            if (r < I_IN) { const int kb = r / 96, nb = r % 96; const int n0 = 32 * nb; p0_transpose_item(F.w_in, NIN, 64 * kb, n0 + (n0 >= 1536 ? 8 : 0), WSP(bf16, WS_WINT), DM, n0, F.g_mix, 1.f, scr, lane, F.meta, WSP(float, WS_PRMP)); continue; } r -= I_IN;
            if (r < I_OUT) { const int kb = r / 32, nb = r % 32; p0_transpose_item(F.w_out, DM, 64 * kb, 32 * nb, WSP(bf16, WS_WOUTT), DM, 32 * nb, nullptr, 1.f, scr, lane, nullptr, nullptr); continue; } r -= I_OUT;
            if (r < I_Q) { const int kb = r / 64, nb = r % 64; p0_transpose_item(F.w_query, 2048, 64 * kb, 32 * nb, WSP(bf16, WS_WQT), DM, 32 * nb, F.g_ffn, 1.f, scr, lane, nullptr, nullptr); continue; } r -= I_Q;
            { const int mat = r / I_M, q = r % I_M, kb = q / 4, nb = q % 4, h = mat & 3;
              const float* W = (mat < 4 ? F.w_qm : F.w_km) + (size_t)h * 16384; bf16* WT = WSP(bf16, mat < 4 ? WS_WQMT : WS_WKMT) + (size_t)h * 16384;
              p0_transpose_item(W, 128, 64 * kb, 32 * nb, WT, 128, 32 * nb, nullptr, mat < 4 ? 1.f : 0.08838834764831845f, scr, lane, nullptr, nullptr); }
        }
        for (int i = gw * 64 + lane; i < 32768 / 4; i += NGW * 64) { const f32x4 v = ((const f32x4*)F.sub_keys)[i]; v2u o; o.x = pk2(v[0], v[1]); o.y = pk2(v[2], v[3]); ((v2u*)WSP(bf16, WS_SKB))[i] = o; }
    }
    __syncthreads();
    {
        float bi[4], bfv[4];
#pragma unroll
        for (int j = 0; j < 4; ++j) { bi[j] = F.b_i[j]; bfv[j] = F.b_f[j]; }
        f32x4 v[4], vn[4];
        { const f32x4* xr = (const f32x4*)(F.x + (size_t)gw * DM) + lane;
#pragma unroll
          for (int j = 0; j < 4; ++j) v[j] = xr[64 * j]; }
        for (int m = gw; m < MROWS + NMETA; m += NGW) {
            const int mn = m + NGW;
            if (mn < MROWS + NMETA) { const f32x4* xr = (const f32x4*)(mn < MROWS ? F.x + (size_t)mn * DM : F.meta + (size_t)(mn - MROWS) * DM) + lane;
#pragma unroll
                for (int j = 0; j < 4; ++j) vn[j] = xr[64 * j]; }
            float ss = 0.f; float g8[8];
#pragma unroll
            for (int jj = 0; jj < 8; ++jj) g8[jj] = 0.f;
#pragma unroll
            for (int j = 0; j < 4; ++j) ss += (v[j][0] * v[j][0] + v[j][1] * v[j][1]) + (v[j][2] * v[j][2] + v[j][3] * v[j][3]);
#pragma unroll
            for (int j = 0; j < 4; ++j)
#pragma unroll
                for (int jj = 0; jj < 8; ++jj) { const f32x4 w = *(const LAS f32x4*)(wg + jj * 1024 + 256 * j + 4 * lane); g8[jj] += (v[j][0] * w[0] + v[j][1] * w[1]) + (v[j][2] * w[2] + v[j][3] * w[3]); }
            ss = wave_sum(ss);
#pragma unroll
            for (int jj = 0; jj < 8; ++jj) g8[jj] = wave_sum(g8[jj]);
            const float rstd = __builtin_amdgcn_rsqf(ss * (1.0f / DM) + EPS);
            if (m < MROWS) {
                v2u* o8 = (v2u*)(WSP(bf16, WS_XB) + (size_t)m * DM) + lane;
#pragma unroll
                for (int j = 0; j < 4; ++j) { v2u o; o.x = pk2(v[j][0], v[j][1]); o.y = pk2(v[j][2], v[j][3]); o8[64 * j] = o; }
                if (lane == 0) WSP(float, WS_RSTD1)[m] = rstd;
#pragma unroll
                for (int jj = 0; jj < 1; ++jj) if (lane < 4) {
                    const float gi_ = lane == 0 ? g8[0] : lane == 1 ? g8[1] : lane == 2 ? g8[2] : g8[3], gf_ = lane == 0 ? g8[4] : lane == 1 ? g8[5] : lane == 2 ? g8[6] : g8[7];
                    const float bi_ = lane == 0 ? bi[0] : lane == 1 ? bi[1] : lane == 2 ? bi[2] : bi[3], bf_ = lane == 0 ? bfv[0] : lane == 1 ? bfv[1] : lane == 2 ? bfv[2] : bfv[3];
                    WSP(float, WS_GI)[m * 4 + lane] = gi_ * rstd + bi_; WSP(float, WS_GF)[m * 4 + lane] = logsigmoidf_(gf_ * rstd + bf_); }
            } else {
                const int r = m - MROWS;
                if (lane == 0) WSP(float, WS_RSTDM)[r] = rstd;
#pragma unroll
                for (int jj = 0; jj < 8; ++jj) if (lane == jj) WSP(float, WS_PRM)[(size_t)r * NIN + OI_ + jj] = g8[jj] * rstd;
            }
#pragma unroll
            for (int j = 0; j < 4; ++j) v[j] = vn[j];
        }
    }
}

__device__ __forceinline__ void p1_meta_tail(Frame& F) {
    const float* P = WSP(float, WS_PRMP); int tid_ = F.tid; asm volatile("" : "+v"(tid_)); const int tid = tid_;
    const int nrounds = (96 + F.G - 1) / F.G;
    for (int rnd = 0; rnd < nrounds; ++rnd) { const int item = F.vcu + rnd * F.G; if (item >= 96) break;
        if (item < 64) {
            const int h = item >> 4, t = item & 15;
            LAS float* um = (LAS float*)F.lds; LAS float* cm = um + 512; LAS float* part = cm + 128;
            __syncthreads();
            { const int j = tid >> 7, ch = tid & 127, tt = t - 3 + j; float s = 0.f;
              if (tt >= 0) {
#pragma unroll
                  for (int kp = 0; kp < 16; ++kp) s += P[(size_t)(kp * 16 + tt) * NIN + OU_ + h * 128 + ch];
                  s *= WSP(float, WS_RSTDM)[tt]; }
              um[j * 128 + ch] = s; }
            __syncthreads();
            if (tid < 128) { const int c = h * 128 + tid; float s = F.conv_b[c];
#pragma unroll
                for (int j = 0; j < 4; ++j) { if (t - 3 + j >= 0) s += F.conv_w[j * 512 + c] * um[j * 128 + tid]; }
                cm[tid] = siluf_(s); }
            __syncthreads();
            { const int e = tid & 127, dp = tid >> 7; float s = 0.f;
#pragma unroll
              for (int d = 32 * dp; d < 32 * dp + 32; ++d) s += cm[d] * F.w_km[(size_t)h * 16384 + d * 128 + e];
              part[dp * 128 + e] = s; }
            __syncthreads();
            if (tid < 128) WSP(float, WS_KM)[(h * 16 + t) * 128 + tid] = ((part[tid] + part[128 + tid]) + (part[256 + tid] + part[384 + tid])) * 0.08838834764831845f;
        } else {
            const int part = item - 64, per = 16 * NIN / 32;
            for (int i = part * per + tid; i < (part + 1) * per; i += NTHR) { const int r = i / NIN, n = i - r * NIN; if (n >= OI_ && n < OI_ + 8) continue; float s = 0.f;
#pragma unroll
                for (int kp = 0; kp < 16; ++kp) s += P[(size_t)kp * 16 * NIN + i];
                WSP(float, WS_PRM)[i] = s * WSP(float, WS_RSTDM)[r]; }
        }
    }
    __syncthreads();
}

constexpr int L2_WQ = 0, L2_WK = 34816, L2_C = 69632, L2_KT = 87040, L2_WV = 105472, L2_U = 123904, L2_TAB = 141056;
__device__ __forceinline__ void p2_mlstm_local(Frame& F) {
    const int bh = F.vcu >> 5, b = bh >> 2, h = bh & 3, tid = F.tid, lane = F.lane, wave = F.wave, g = lane >> 4, l15 = lane & 15;
    LAS bf16* WQ = (LAS bf16*)(F.lds + L2_WQ); LAS bf16* WK = (LAS bf16*)(F.lds + L2_WK); LAS bf16* Cs = (LAS bf16*)(F.lds + L2_C);
    LAS bf16* KT = (LAS bf16*)(F.lds + L2_KT); LAS bf16* WV = (LAS bf16*)(F.lds + L2_WV); LAS bf16* Us = (LAS bf16*)(F.lds + L2_U);
    LAS float* TAB = (LAS float*)(F.lds + L2_TAB);
    const bf16* PR = WSP(bf16, WS_PR); const float* PRM = WSP(float, WS_PRM);
#pragma unroll
    for (int i = tid; i < 2048; i += NTHR) { const int e = i >> 4, c8 = (i & 15) * 8;
        *(LAS v4u*)(WQ + e * 136 + c8) = *(const v4u*)(WSP(bf16, WS_WQMT) + (size_t)h * 16384 + e * 128 + c8);
        *(LAS v4u*)(WK + e * 136 + c8) = *(const v4u*)(WSP(bf16, WS_WKMT) + (size_t)h * 16384 + e * 128 + c8); }
    v4u ur[3], vr[2]; float gli = 0.f, glf = 0.f;
#define P2_FETCH_U(chunkx) do { const int _m0 = b * SEQ + (chunkx) * 64; _Pragma("unroll") for (int _k = 0; _k < 3; ++_k) { const int _i = tid + NTHR * _k; if (_i < 67 * 16) { const int _rr = _i >> 4, _c8 = (_i & 15) * 8, _t = _rr - 3; \
            if ((chunkx) == 0 && _t < 0) { const float* _s = PRM + (size_t)(NMETA + _t) * NIN + OU_ + h * 128 + _c8; ur[_k].x = pk2(_s[0], _s[1]); ur[_k].y = pk2(_s[2], _s[3]); ur[_k].z = pk2(_s[4], _s[5]); ur[_k].w = pk2(_s[6], _s[7]); } \
            else ur[_k] = *(const v4u*)(PR + (size_t)(_m0 + _t) * NPROJ + CU_ + h * 128 + _c8); } } \
        if (tid < 64) { gli = WSP(float, WS_GI)[(_m0 + tid) * 4 + h]; glf = WSP(float, WS_GF)[(_m0 + tid) * 4 + h]; } } while (0)
#define P2_FETCH_V(chunkx) do { const int _m0 = b * SEQ + (chunkx) * 64; _Pragma("unroll") for (int _k = 0; _k < 2; ++_k) { const int _i = tid + NTHR * _k; vr[_k] = *(const v4u*)(PR + (size_t)(_m0 + (_i >> 4)) * NPROJ + CV_ + h * 128 + (_i & 15) * 8); } } while (0)
    P2_FETCH_U(F.vcu & 31); P2_FETCH_V(F.vcu & 31);
    for (int ui = 0; ui < 4; ++ui) {
        const int chunk = (F.vcu & 31) + 32 * ui; const int m0 = b * SEQ + chunk * 64;
        __syncthreads();
#pragma unroll
        for (int k = 0; k < 3; ++k) { const int i = tid + NTHR * k; if (i < 67 * 16) *(LAS v4u*)(Us + (i >> 4) * 128 + (i & 15) * 8) = ur[k]; }
        if (tid < 64) { TAB[tid] = gli; TAB[64 + tid] = glf; }
        if (ui + 1 < 4) P2_FETCH_U(chunk + 32);
        __syncthreads();
        { const int ch = tid & 127, c = h * 128 + ch; const float w0 = F.conv_w[c], w1 = F.conv_w[512 + c], w2 = F.conv_w[1024 + c], w3 = F.conv_w[1536 + c], cb = F.conv_b[c];
#pragma unroll 4
          for (int jj = 0; jj < 16; ++jj) { const int t = (tid >> 7) + 4 * jj;
              const float s = cb + w0 * bf2f(Us[t * 128 + ch]) + w1 * bf2f(Us[(t + 1) * 128 + ch]) + w2 * bf2f(Us[(t + 2) * 128 + ch]) + w3 * bf2f(Us[(t + 3) * 128 + ch]);
              const unsigned cv = f2bf(siluf_(s)); Cs[t * 136 + ch] = (bf16)cv; } }
        if (wave == 0) {
            const float li = TAB[lane], lf = TAB[64 + lane]; float bs = lf;
            bs = wave_scan_sum(bs, lane);
            const float bL = rdl_f(bs, 63); const float gg = bL - bs + li; const float Bc = wave_max(gg);
            TAB[128 + lane] = bs; TAB[192 + lane] = __expf(gg - Bc);
            WSP(float, WS_BT)[(m0 + lane) * 4 + h] = bs;
            if (lane == 0) { WSP(float, WS_AC)[bh * 128 + chunk] = bL; WSP(float, WS_BC)[bh * 128 + chunk] = Bc; }
        }
        __syncthreads();
        {
            bf16* Qg = WSP(bf16, WS_QK); bf16* Kg = Qg + (size_t)MROWS * 512;
#pragma unroll
            for (int tt = 0; tt < 4; ++tt) {
                f32x4 aq = {0.f, 0.f, 0.f, 0.f}, ak = {0.f, 0.f, 0.f, 0.f};
                aq = mma_rows<4>(WQ + (16 * wave + l15) * 136 + 8 * g, Cs + (16 * tt + l15) * 136 + 8 * g, aq);
                ak = mma_rows<4>(WK + (16 * wave + l15) * 136 + 8 * g, Cs + (16 * tt + l15) * 136 + 8 * g, ak);
                const int t = 16 * tt + l15, e0 = 16 * wave + 4 * g; const size_t go = (size_t)(m0 + t) * 512 + h * 128 + e0;
                v2u oq; oq.x = pk2(aq[0], aq[1]); oq.y = pk2(aq[2], aq[3]); *(v2u*)(Qg + go) = oq;
                v2u ok; ok.x = pk2(ak[0], ak[1]); ok.y = pk2(ak[2], ak[3]); *(v2u*)(Kg + go) = ok;
                KT[(e0 + 0) * 72 + t] = (bf16)(ok.x & 0xffffu); KT[(e0 + 1) * 72 + t] = (bf16)(ok.x >> 16); KT[(e0 + 2) * 72 + t] = (bf16)(ok.y & 0xffffu); KT[(e0 + 3) * 72 + t] = (bf16)(ok.y >> 16);
            }
            for (int i = tid; i < 1024; i += NTHR) { const int t = i >> 4, c8 = (i & 15) * 8; *(v4u*)(WSP(bf16, WS_CB) + (size_t)(m0 + t) * 512 + h * 128 + c8) = *(const LAS v4u*)(Cs + t * 136 + c8); }
#pragma unroll
            for (int k = 0; k < 2; ++k) { const int i = tid + NTHR * k; const int s = i >> 4, e8 = (i & 15) * 8; const v4u pv = vr[k]; const float w = TAB[192 + s];
#pragma unroll
                for (int q = 0; q < 4; ++q) { const int ss = s ^ (8 * ((lane >> 1) & 3));
                    WV[(e8 + 2 * q) * 72 + ss] = (bf16)f2bf(bf2f(pv[q] & 0xffffu) * w); WV[(e8 + 2 * q + 1) * 72 + ss] = (bf16)f2bf(__uint_as_float(pv[q] & 0xffff0000u) * w); } }
            if (ui + 1 < 4) P2_FETCH_V(chunk + 32);
        }
        __syncthreads();
        {
            bf16* Ug = WSP(bf16, WS_U) + (size_t)(bh * 128 + chunk) * 16384;
#pragma unroll
            for (int et = 0; et < 8; ++et) { f32x4 a = {0.f, 0.f, 0.f, 0.f};
                a = mma_rows<2>(KT + (16 * wave + l15) * 72 + 8 * g, WV + (16 * et + l15) * 72 + 8 * (g ^ (et & 3)), a);
                v2u o; o.x = pk2(a[0], a[1]); o.y = pk2(a[2], a[3]); *(v2u*)(Ug + (size_t)(16 * et + l15) * 128 + 16 * wave + 4 * g) = o; }
            { const int d = tid >> 2, q4 = tid & 3; float s = 0.f;
#pragma unroll
              for (int t = 16 * q4; t < 16 * q4 + 16; ++t) s += bf2f(KT[d * 72 + t]) * TAB[192 + t];
              s += dpp_f<0xB1>(s); s += dpp_f<0x4E>(s);
              if (q4 == 0) WSP(float, WS_NU)[(size_t)(bh * 128 + chunk) * 128 + d] = s; }
        }
    }
#undef P2_FETCH_U
#undef P2_FETCH_V
    __syncthreads();
}

constexpr int L3_K = 0, L3_VT = 9216, L3_MIN = 18432;
__device__ __forceinline__ void p2_sb_attention(Frame& F) {
    const int tid = F.tid, lane = F.lane, wave = F.wave, g = lane >> 4, l15 = lane & 15;
    LAS bf16* Ks = (LAS bf16*)(F.lds + L3_K); LAS bf16* VT = (LAS bf16*)(F.lds + L3_VT); LAS float* MINR = (LAS float*)(F.lds + L3_MIN);
    bf16* PR = WSP(bf16, WS_PR); const float* PRM = WSP(float, WS_PRM);
    const int bhd = F.vcu >> 4, b = bhd >> 3, hd = bhd & 7;
    for (int ui = 0; ui < 4; ++ui) {
        const int qb = (F.vcu & 15) + 16 * ui;
        const int tq = 128 * qb + 16 * wave + l15;
        const size_t qrow = (size_t)(b * SEQ + tq) * NPROJ;
        const bf16x8 q0 = *(const bf16x8*)(PR + qrow + CQS + hd * 64 + 8 * g), q1 = *(const bf16x8*)(PR + qrow + CQS + hd * 64 + 32 + 8 * g);
        f32x4 o[4];
#pragma unroll
        for (int i = 0; i < 4; ++i) o[i] = (f32x4){0.f, 0.f, 0.f, 0.f};
        float R = 0.f;
        const int kr = tid >> 3, c8 = (tid & 7) * 8;
        v4u kn, vn;
#define SB_FETCH(jbx) do { if ((jbx) >= 0) { const size_t _ro = (size_t)(b * SEQ + 64 * (jbx) + kr) * NPROJ + hd * 64 + c8; kn = *(const v4u*)(PR + _ro + CKS); vn = *(const v4u*)(PR + _ro + CVS); } \
            else if (kr < NMETA) { const float* _sk = PRM + (size_t)kr * NIN + OKS + hd * 64 + c8; const float* _sv = PRM + (size_t)kr * NIN + OVS + hd * 64 + c8; \
                kn.x = pk2(_sk[0], _sk[1]); kn.y = pk2(_sk[2], _sk[3]); kn.z = pk2(_sk[4], _sk[5]); kn.w = pk2(_sk[6], _sk[7]); vn.x = pk2(_sv[0], _sv[1]); vn.y = pk2(_sv[2], _sv[3]); vn.z = pk2(_sv[4], _sv[5]); vn.w = pk2(_sv[6], _sv[7]); } \
            else { kn = (v4u){0u, 0u, 0u, 0u}; vn = kn; } } while (0)
        SB_FETCH(2 * qb + 1);
        for (int jb = 2 * qb + 1; jb >= -1; --jb) {
            __syncthreads();
            if (jb < 2 * qb + 1) { float mn = MINR[0];
#pragma unroll
                for (int w = 1; w < 8; ++w) mn = fminf(mn, MINR[w]);
                if (mn >= 90.f) break; }
            { const v4u kv = kn, vv = vn;
              *(LAS v4u*)(Ks + kr * 72 + c8) = kv;
              const int krs = kr ^ (16 * ((tid >> 1) & 3));
              VT[(c8 + 0) * 72 + krs] = (bf16)(vv.x & 0xffffu); VT[(c8 + 1) * 72 + krs] = (bf16)(vv.x >> 16); VT[(c8 + 2) * 72 + krs] = (bf16)(vv.y & 0xffffu); VT[(c8 + 3) * 72 + krs] = (bf16)(vv.y >> 16);
              VT[(c8 + 4) * 72 + krs] = (bf16)(vv.z & 0xffffu); VT[(c8 + 5) * 72 + krs] = (bf16)(vv.z >> 16); VT[(c8 + 6) * 72 + krs] = (bf16)(vv.w & 0xffffu); VT[(c8 + 7) * 72 + krs] = (bf16)(vv.w >> 16); }
            if (jb > -1) SB_FETCH(jb - 1);
            __syncthreads();
            if (jb == 2 * qb + 1 && wave < 4) { if (lane == 0) MINR[wave] = 0.f; continue; }
            float z[16];
#pragma unroll
            for (int i = 0; i < 4; ++i) { const LAS bf16* kp = Ks + (16 * (l15 >> 2) + 4 * i + (l15 & 3)) * 72 + 8 * g;
                f32x4 a = {0.f, 0.f, 0.f, 0.f};
                a = __builtin_amdgcn_mfma_f32_16x16x32_bf16(*(const LAS bf16x8*)kp, q0, a, 0, 0, 0);
                a = __builtin_amdgcn_mfma_f32_16x16x32_bf16(*(const LAS bf16x8*)(kp + 32), q1, a, 0, 0, 0);
                z[4 * i + 0] = a[0] * 0.125f; z[4 * i + 1] = a[1] * 0.125f; z[4 * i + 2] = a[2] * 0.125f; z[4 * i + 3] = a[3] * 0.125f; }
            const int kbase = (jb >= 0) ? 64 * jb + 16 * g : 16 * g;
            float bp[16]; float P = 1.f;
#pragma unroll
            for (int n = 15; n >= 0; --n) { const bool ok = (jb >= 0) ? (kbase + n < tq) : (kbase + n < NMETA);
                const float e = ok ? __expf(fminf(z[n], 80.f)) : 0.f; const float r = __builtin_amdgcn_rcpf(1.f + e);
                bp[n] = (e * r) * P; P *= r; }
            const float run = -__logf(P);
            const float t1 = __shfl(run, (lane + 16) & 63), t2 = __shfl(run, (lane + 32) & 63), t3 = __shfl(run, (lane + 48) & 63);
            const float higher = (g < 3 ? t1 : 0.f) + (g < 2 ? t2 : 0.f) + (g < 1 ? t3 : 0.f);
            const float lower = (g >= 1 ? t3 : 0.f) + (g >= 2 ? t2 : 0.f) + (g >= 3 ? t1 : 0.f);
            const float S = __expf(-(R + higher));
            float av[16];
#pragma unroll
            for (int n = 0; n < 16; ++n) av[n] = bp[n] * S;
            R += run + higher + lower;
#pragma unroll
            for (int ks = 0; ks < 2; ++ks) { v4u bw; bw.x = pk2(av[8 * ks + 0], av[8 * ks + 1]); bw.y = pk2(av[8 * ks + 2], av[8 * ks + 3]); bw.z = pk2(av[8 * ks + 4], av[8 * ks + 5]); bw.w = pk2(av[8 * ks + 6], av[8 * ks + 7]);
                const bf16x8 bfr = __builtin_bit_cast(bf16x8, bw);
#pragma unroll
                for (int et = 0; et < 4; ++et) { const bf16x8 afr = *(const LAS bf16x8*)(VT + (16 * et + l15) * 72 + 16 * (g ^ et) + 8 * ks); o[et] = __builtin_amdgcn_mfma_f32_16x16x32_bf16(afr, bfr, o[et], 0, 0, 0); } }
            const float rm = row16_min(R);
            if (lane == 0) MINR[wave] = rm;
        }
        float ss = 0.f;
#pragma unroll
        for (int et = 0; et < 4; ++et) ss += (o[et][0] * o[et][0] + o[et][1] * o[et][1]) + (o[et][2] * o[et][2] + o[et][3] * o[et][3]);
        ss += __shfl_xor(ss, 16); ss += __shfl_xor(ss, 32);
        const float rstd = __builtin_amdgcn_rsqf(ss * (1.0f / 64.0f) + EPS);
#pragma unroll
        for (int et = 0; et < 4; ++et) { const int e = 16 * et + 4 * g; const f32x4 gg = *(const f32x4*)(F.sb_g + hd * 64 + e);
            v2u w; w.x = pk2(o[et][0] * rstd * gg[0], o[et][1] * rstd * gg[1]); w.y = pk2(o[et][2] * rstd * gg[2], o[et][3] * rstd * gg[3]);
            *(v2u*)(PR + qrow + CQS + hd * 64 + e) = w; }
    }
#undef SB_FETCH
    __syncthreads();
}

__device__ __forceinline__ void p3_scan(Frame& F) {
    const int bh = F.vcu >> 5, h = bh & 3, tid = F.tid, lane = F.lane;
    LAS float* DEC = (LAS float*)F.lds; LAS float* SCL = DEC + 128; LAS float* WM = DEC + 256;
    const float* PRM = WSP(float, WS_PRM);
    __syncthreads();
    if (F.wave == 0) {
        float li = -INFINITY, lf = 0.f;
        if (lane < NMETA) { li = PRM[(size_t)lane * NIN + OI_ + h] + F.b_i[h]; lf = logsigmoidf_(PRM[(size_t)lane * NIN + OF_ + h] + F.b_f[h]); }
        float bs = lf;
        bs = wave_scan_sum(bs, lane);
        const float bL = rdl_f(bs, 63); const float gg = bL - bs + li; float M = fmaxf(bL, wave_max(gg));
        if (lane < NMETA) WM[lane] = __expf(gg - M);
        const float* AC = WSP(float, WS_AC) + bh * 128; const float* BC = WSP(float, WS_BC) + bh * 128;
        const float a0 = AC[lane], a1 = AC[64 + lane], c0v = BC[lane], c1v = BC[64 + lane];
        float m0 = 0.f, m1 = 0.f, n0 = 0.f, n1 = 0.f;
#pragma unroll 8
        for (int c = 0; c < 64; ++c) { const float a = rdl_f(a0, c), bc = rdl_f(c0v, c); const float Mn = fmaxf(M + a, bc); if (lane == c) { m0 = M; n0 = Mn; } M = Mn; }
#pragma unroll 8
        for (int c = 0; c < 64; ++c) { const float a = rdl_f(a1, c), bc = rdl_f(c1v, c); const float Mn = fmaxf(M + a, bc); if (lane == c) { m1 = M; n1 = Mn; } M = Mn; }
        DEC[lane] = __expf(a0 + m0 - n0); SCL[lane] = __expf(c0v - n0); DEC[64 + lane] = __expf(a1 + m1 - n1); SCL[64 + lane] = __expf(c1v - n1);
        if ((F.vcu & 31) == 0) { WSP(float, WS_MIN)[bh * 128 + lane] = m0; WSP(float, WS_MIN)[bh * 128 + 64 + lane] = m1; }
    }
    __syncthreads();
    const int elem = (F.vcu & 31) * 512 + tid, e = elem >> 7, d = elem & 127;
    const float* KM = WSP(float, WS_KM) + (size_t)h * 16 * 128;
    float C = 0.f;
#pragma unroll
    for (int s = 0; s < NMETA; ++s) C += WM[s] * PRM[(size_t)s * NIN + OV_ + h * 128 + e] * KM[s * 128 + d];
    bf16* U = WSP(bf16, WS_U) + (size_t)bh * 128 * 16384 + elem;
    for (int c0 = 0; c0 < 128; c0 += 16) {
        unsigned short u[16];
#pragma unroll
        for (int j = 0; j < 16; ++j) u[j] = U[(size_t)(c0 + j) * 16384];
#pragma unroll
        for (int j = 0; j < 16; ++j) { U[(size_t)(c0 + j) * 16384] = (bf16)f2bf(C); C = DEC[c0 + j] * C + SCL[c0 + j] * bf2f(u[j]); }
    }
    if ((F.vcu & 31) == 0) {
        LAS float* NUL = (LAS float*)F.lds + 1024;
        const float* NUg = WSP(float, WS_NU) + (size_t)bh * 128 * 128;
#pragma unroll
        for (int i = tid; i < 4096; i += NTHR) ((LAS f32x4*)NUL)[i] = ((const f32x4*)NUg)[i];
        __syncthreads();
        if (tid < 128) {
            float n = 0.f;
#pragma unroll
            for (int s = 0; s < NMETA; ++s) n += WM[s] * KM[s * 128 + tid];
            float* NS = WSP(float, WS_NS) + (size_t)bh * 128 * 128 + tid;
#pragma unroll 8
            for (int c = 0; c < 128; ++c) { NS[c * 128] = n; n = DEC[c] * n + SCL[c] * NUL[c * 128 + tid]; }
        }
    }
    __syncthreads();
}

constexpr int L4_Q = 0, L4_K = 17408, L4_VT = 34816, L4_CS = 53248, L4_S = 88064, L4_TAB = 97280;
__device__ __forceinline__ void p4_mlstm_out(Frame& F) {
    const int bh = F.vcu >> 5, b = bh >> 2, h = bh & 3, tid = F.tid, lane = F.lane, wave = F.wave, g = lane >> 4, l15 = lane & 15;
    LAS bf16* Qs = (LAS bf16*)(F.lds + L4_Q); LAS bf16* Ks = (LAS bf16*)(F.lds + L4_K); LAS bf16* VT = (LAS bf16*)(F.lds + L4_VT);
    LAS bf16* CS = (LAS bf16*)(F.lds + L4_CS); LAS bf16* Ss = (LAS bf16*)(F.lds + L4_S); LAS float* T = (LAS float*)(F.lds + L4_TAB);
    bf16* PR = WSP(bf16, WS_PR);
    const bf16* Qg = WSP(bf16, WS_QK); const bf16* Kg = Qg + (size_t)MROWS * 512;
    v4u rq[2], rk[2], rc[4], rv[2]; float rT0 = 0.f, rT1 = 0.f, rNS = 0.f, rMin;
#define P4_FETCH(UI) do { const int _chunk = (F.vcu & 31) + 32 * (UI); const int _m0 = b * SEQ + _chunk * 64; const int _uc = bh * 128 + _chunk; \
        _Pragma("unroll") for (int _k = 0; _k < 2; ++_k) { const int _i = tid + NTHR * _k; const int _t = _i >> 4, _c8 = (_i & 15) * 8; const size_t _go = (size_t)(_m0 + _t) * 512 + h * 128 + _c8; rq[_k] = *(const v4u*)(Qg + _go); rk[_k] = *(const v4u*)(Kg + _go); \
            rv[_k] = *(const v4u*)(PR + (size_t)(_m0 + _t) * NPROJ + CV_ + h * 128 + _c8); } \
        _Pragma("unroll") for (int _k = 0; _k < 4; ++_k) { const int _i = tid + NTHR * _k; const int _e = _i >> 4, _c8 = (_i & 15) * 8; rc[_k] = *(const v4u*)(WSP(bf16, WS_U) + (size_t)_uc * 16384 + _e * 128 + _c8); } \
        if (tid < 64) { rT0 = WSP(float, WS_BT)[(_m0 + tid) * 4 + h]; rT1 = WSP(float, WS_GI)[(_m0 + tid) * 4 + h]; } \
        if (tid >= 128 && tid < 256) rNS = WSP(float, WS_NS)[(size_t)_uc * 128 + tid - 128]; \
        rMin = WSP(float, WS_MIN)[_uc]; } while (0)
    P4_FETCH(0);
    for (int ui = 0; ui < 4; ++ui) {
        const int chunk = (F.vcu & 31) + 32 * ui; const int m0 = b * SEQ + chunk * 64;
        __syncthreads();
#pragma unroll
        for (int k = 0; k < 2; ++k) { const int i = tid + NTHR * k; const int t = i >> 4, c8 = (i & 15) * 8; *(LAS v4u*)(Qs + t * 136 + c8) = rq[k]; *(LAS v4u*)(Ks + t * 136 + c8) = rk[k];
            const v4u pv = rv[k];
#pragma unroll
            for (int q = 0; q < 4; ++q) { const int ts = t ^ (8 * ((lane >> 1) & 3));
                VT[(c8 + 2 * q) * 72 + ts] = (bf16)(pv[q] & 0xffffu); VT[(c8 + 2 * q + 1) * 72 + ts] = (bf16)(pv[q] >> 16); } }
#pragma unroll
        for (int k = 0; k < 4; ++k) { const int i = tid + NTHR * k; const int e = i >> 4, c8 = (i & 15) * 8; *(LAS v4u*)(CS + e * 136 + c8) = rc[k]; }
        if (tid < 64) { T[tid] = rT0; T[64 + tid] = rT1; }
        if (tid >= 128 && tid < 256) T[640 + tid - 128] = rNS;
        const float Min = rMin;
        P4_FETCH(ui + 1 < 4 ? ui + 1 : 3);
        __syncthreads();
        if (wave == 0) {
            const float bt = T[lane], li = T[64 + lane]; float pm = li - bt;
            pm = wave_scan_max(pm, lane);
            const float Mt = bt + fmaxf(Min, pm);
            T[128 + lane] = Mt; T[192 + lane] = __expf(bt + Min - Mt);
        }
        { const int t = tid >> 3, part = tid & 7; float s = 0.f;
#pragma unroll
          for (int j = 0; j < 16; ++j) s += bf2f(Qs[t * 136 + part * 16 + j]) * T[640 + part * 16 + j];
          s += dpp_f<0xB1>(s); s += dpp_f<0x4E>(s); s += dpp_f<0x124>(s);
          if (part == 0) T[256 + t] = s; }
        __syncthreads();
#pragma unroll
        for (int j = 0; j < 2; ++j) { const int tt = wave >> 1, st = 2 * (wave & 1) + j; f32x4 a = {0.f, 0.f, 0.f, 0.f};
            a = mma_rows<4>(Qs + (16 * tt + l15) * 136 + 8 * g, Ks + (16 * st + l15) * 136 + 8 * g, a);
            const int s = 16 * st + l15; const float cs = T[64 + s] - T[s];
#pragma unroll
            for (int r = 0; r < 4; ++r) { const int t = 16 * tt + 4 * g + r; const float wgt = (s <= t) ? __expf(T[t] + cs - T[128 + t]) : 0.f; const float v = a[r] * wgt;
                Ss[t * 72 + s] = (bf16)f2bf(v); const float rs = row16_sum(v);
                if (l15 == 0) T[384 + st * 64 + t] = rs; } }
        __syncthreads();
        if (tid < 64) { const float den = T[192 + tid] * T[256 + tid] + (T[384 + tid] + T[448 + tid]) + (T[512 + tid] + T[576 + tid]); T[320 + tid] = 1.0f / fmaxf(fabsf(den), __expf(-T[128 + tid])); }
        f32x4 acc[4];
        const int tt = wave >> 1, tl = 16 * tt + l15;
#pragma unroll
        for (int j = 0; j < 4; ++j) { const int et = 4 * (wave & 1) + j; f32x4 a = {0.f, 0.f, 0.f, 0.f};
            a = mma_rows<4>(CS + (16 * et + l15) * 136 + 8 * g, Qs + (16 * tt + l15) * 136 + 8 * g, a);
            a = a * T[192 + tl];
            a = mma_rows<2>(VT + (16 * et + l15) * 72 + 8 * (g ^ (et & 3)), Ss + (16 * tt + l15) * 72 + 8 * g, a);
            acc[j] = a; }
        __syncthreads();
        float ps = 0.f, pq = 0.f; const float invd = T[320 + tl];
        const size_t orow = (size_t)(m0 + tl) * NPROJ + CO_ + h * 128, crow = (size_t)(m0 + tl) * 512 + h * 128;
#pragma unroll
        for (int j = 0; j < 4; ++j) { const int e0 = 16 * (4 * (wave & 1) + j) + 4 * g; const v2u opk = *(const v2u*)(PR + orow + e0);
            const float op[4] = {bf2f(opk[0] & 0xffffu), __uint_as_float(opk[0] & 0xffff0000u), bf2f(opk[1] & 0xffffu), __uint_as_float(opk[1] & 0xffff0000u)};
#pragma unroll
            for (int r = 0; r < 4; ++r) { const float hv = acc[j][r] * invd * __builtin_amdgcn_rcpf(1.f + __expf(-op[r]));     acc[j][r] = hv; ps += hv; pq += hv * hv; } }
        ps += __shfl_xor(ps, 16); ps += __shfl_xor(ps, 32); pq += __shfl_xor(pq, 16); pq += __shfl_xor(pq, 32);
        if (g == 0) { T[768 + (wave & 1) * 64 + tl] = ps; T[896 + (wave & 1) * 64 + tl] = pq; }
        __syncthreads();
        { const float mu = (T[768 + tl] + T[832 + tl]) * (1.f / 128.f); const float var = (T[896 + tl] + T[960 + tl]) * (1.f / 128.f) - mu * mu; const float rsd = __builtin_amdgcn_rsqf(fmaxf(var, 0.f) + EPS);
#pragma unroll
          for (int j = 0; j < 4; ++j) { const int e0 = 16 * (4 * (wave & 1) + j) + 4 * g; const f32x4 gn = *(const f32x4*)(F.gn_g + h * 128 + e0), sk = *(const f32x4*)(F.skip + h * 128 + e0);
              const v2u cpk = *(const v2u*)(WSP(bf16, WS_CB) + crow + e0);
              const float cv[4] = {bf2f(cpk[0] & 0xffffu), __uint_as_float(cpk[0] & 0xffff0000u), bf2f(cpk[1] & 0xffffu), __uint_as_float(cpk[1] & 0xffff0000u)};
              float y[4];
#pragma unroll
              for (int r = 0; r < 4; ++r) y[r] = (acc[j][r] - mu) * rsd * gn[r] + sk[r] * cv[r];
              v2u o; o[0] = pk2(y[0], y[1]); o[1] = pk2(y[2], y[3]); *(v2u*)(PR + orow + e0) = o; } }
    }
    __syncthreads();
}

constexpr int L7_SK = 0, L7_LS = 69632;
__device__ __forceinline__ int pack_key(float v, int idx, unsigned mask) { int k = (int)((__builtin_bit_cast(unsigned, v) & ~mask) | (unsigned)idx); return k < 0 ? (k ^ 0x7fffffff) : k; }
__device__ __forceinline__ float key_val(int k, unsigned mask) { const int u = k < 0 ? (k ^ 0x7fffffff) : k; return __builtin_bit_cast(float, (unsigned)u & ~mask); }
__device__ __forceinline__ int key_idx(int k, unsigned mask) { const int u = k < 0 ? (k ^ 0x7fffffff) : k; return (int)((unsigned)u & mask); }
__device__ __forceinline__ void bitonic_sort16_desc(int (&t)[16]) {
#pragma unroll
    for (int k = 2; k <= 16; k <<= 1)
#pragma unroll
        for (int j = k >> 1; j > 0; j >>= 1)
#pragma unroll
            for (int i = 0; i < 16; ++i) { const int l = i ^ j; if (l > i) { const bool desc = ((i & k) == 0); const int hi = max(t[i], t[l]), lo = min(t[i], t[l]); t[i] = desc ? hi : lo; t[l] = desc ? lo : hi; } }
}
__device__ __forceinline__ void bitonic_merge16_desc(int (&t)[16]) {
#pragma unroll
    for (int j = 8; j > 0; j >>= 1)
#pragma unroll
        for (int i = 0; i < 16; ++i) { const int l = i ^ j; if (l > i) { const int hi = max(t[i], t[l]), lo = min(t[i], t[l]); t[i] = hi; t[l] = lo; } }
}
#define TOPK_INS(t, x) do { int _x = (x); _Pragma("unroll") for (int _i = 0; _i < 16; ++_i) { const int _hi = max(t[_i], _x); _x = min(t[_i], _x); t[_i] = _hi; } } while (0)
__device__ __forceinline__ void p7_stage_sk(Frame& F) {
    LAS bf16* SK = (LAS bf16*)(F.lds + L7_SK);
    const int t = F.tid - 64;
    v4u tv[10];
#pragma unroll
    for (int j = 0; j < 9; ++j) { const int i = t + 448 * j; tv[j] = *(const v4u*)(WSP(bf16, WS_SKB) + (size_t)(i >> 4) * 128 + (i & 15) * 8); }
    if (t < 64) { const int i = t + 4032; tv[9] = *(const v4u*)(WSP(bf16, WS_SKB) + (size_t)(i >> 4) * 128 + (i & 15) * 8); }
#pragma unroll
    for (int j = 0; j < 9; ++j) { const int i = t + 448 * j; *(LAS v4u*)(SK + (i >> 4) * 136 + (i & 15) * 8) = tv[j]; }
    if (t < 64) { const int i = t + 4032; *(LAS v4u*)(SK + (i >> 4) * 136 + (i & 15) * 8) = tv[9]; }
}
__device__ __forceinline__ void p7_topk(Frame& F) {
    const int tid = F.tid, lane = F.lane, wave = F.wave, g = lane >> 4, l15 = lane & 15;
    LAS bf16* SK = (LAS bf16*)(F.lds + L7_SK); LAS int* LS = (LAS int*)(F.lds + L7_LS); LAS int* HIST = (LAS int*)(F.lds + L7_LS + 69888);
    const bf16* QP = WSP(bf16, WS_QP);
    for (int unit = F.vcu; unit < MROWS / 64; unit += F.G) {
        const int tok0 = unit * 64, h = wave;
        for (int i = tid; i < 64 * 33; i += NTHR) HIST[i] = 0;
        bf16x8 qf[4], qn[4];
        { const bf16* qrow = QP + (size_t)(tok0 + l15) * 2048 + h * 256 + 8 * g;
#pragma unroll
          for (int k = 0; k < 4; ++k) qf[k] = *(const bf16x8*)(qrow + 32 * k); }
#pragma unroll 1
        for (int it = 0; it < 8; ++it) {
            const int p = it >> 2, tt = it & 3;
            if (it + 1 < 8) { const int p2 = (it + 1) >> 2, tt2 = (it + 1) & 3; const bf16* qrow = QP + (size_t)(tok0 + 16 * tt2 + l15) * 2048 + h * 256 + p2 * 128 + 8 * g;
#pragma unroll
                for (int k = 0; k < 4; ++k) qn[k] = *(const bf16x8*)(qrow + 32 * k); }
            int ta[16], tb[16];
#pragma unroll
            for (int kt = 0; kt < 8; ++kt) { f32x4 a = {0.f, 0.f, 0.f, 0.f}; const LAS bf16* sk = SK + (p * 128 + 16 * kt + l15) * 136 + 8 * g;
#pragma unroll
                for (int k = 0; k < 4; ++k) a = __builtin_amdgcn_mfma_f32_16x16x32_bf16(*(const LAS bf16x8*)(sk + 32 * k), qf[k], a, 0, 0, 0);
#pragma unroll
                for (int r = 0; r < 4; ++r) { const int key = pack_key(a[r], 16 * kt + 4 * g + r, 127u); if (kt < 4) ta[4 * kt + r] = key; else tb[4 * (kt - 4) + r] = key; } }
            bitonic_sort16_desc(ta); bitonic_sort16_desc(tb);
#pragma unroll
            for (int i = 0; i < 16; ++i) ta[i] = max(ta[i], tb[15 - i]);
            bitonic_merge16_desc(ta);
#pragma unroll
            for (int dd = 16; dd <= 32; dd <<= 1) {
#pragma unroll
                for (int i = 0; i < 16; ++i) tb[i] = __shfl_xor(ta[i], dd);
#pragma unroll
                for (int i = 0; i < 16; ++i) ta[i] = max(ta[i], tb[15 - i]);
                bitonic_merge16_desc(ta); }
            if (g == 0) { LAS int* dst = LS + (16 * tt + l15) * 273 + (h * 2 + p) * 17;
#pragma unroll
                for (int i = 0; i < 16; ++i) dst[i] = ta[i]; }
#pragma unroll
            for (int k = 0; k < 4; ++k) qf[k] = qn[k];
        }
        __syncthreads();
        { const int tok = tid >> 3, h2 = tid & 7; const LAS int* la = LS + tok * 273 + h2 * 34; const LAS int* lb = la + 17;
          float av[16], bv[16];
#pragma unroll
          for (int i = 0; i < 16; ++i) { av[i] = key_val(la[i], 127u); bv[i] = key_val(lb[i], 127u); }
          int top[16];
#pragma unroll
          for (int i = 0; i < 16; ++i) top[i] = (int)0x80000000;
#pragma unroll
          for (int i = 0; i < 16; ++i)
#pragma unroll
              for (int j = 0; j < 16; ++j) if ((i + 1) * (j + 1) <= 16) TOPK_INS(top, pack_key(av[i] + bv[j], i * 16 + j, 255u));
          const float vmax = key_val(top[0], 255u); float ev[16]; float z = 0.f;
#pragma unroll
          for (int k = 0; k < 16; ++k) { ev[k] = __expf(key_val(top[k], 255u) - vmax); z += ev[k]; }
          const float rz = __builtin_amdgcn_rcpf(z);
          int eidx[16]; float gate[16];
#pragma unroll
          for (int k = 0; k < 16; ++k) { const int ij = key_idx(top[k], 255u); const int ei = key_idx(la[ij >> 4], 127u), ej = key_idx(lb[ij & 15], 127u);
              eidx[k] = ei * 128 + ej; gate[k] = ev[k] * rz; __hip_atomic_fetch_add(HIST + tok * 33 + (eidx[k] >> 9), 1, __ATOMIC_RELAXED, __HIP_MEMORY_SCOPE_WORKGROUP); }
          __syncthreads();
          if (tid < 64) { int run = 0;
#pragma unroll
              for (int b = 0; b < 32; ++b) { const int c = HIST[tid * 33 + b]; HIST[tid * 33 + b] = run; run += c; } }
          __syncthreads();
          if (h2 == 0) { const f32x4* q = (const f32x4*)(WSP(float, WS_SSQ) + (size_t)(tok0 + tok) * 16); float ssq = 0.f;
#pragma unroll
              for (int j = 0; j < 4; ++j) { const f32x4 a = q[j]; ssq += (a[0] + a[1]) + (a[2] + a[3]); }
              WSP(float, WS_RS2)[tok0 + tok] = __builtin_amdgcn_rsqf(ssq * (1.0f / DM) + EPS); }
          v2u* tk = (v2u*)WSP(unsigned, WS_TK) + (size_t)(tok0 + tok) * 128;
#pragma unroll
          for (int k = 0; k < 16; ++k) { const int pos = __hip_atomic_fetch_add(HIST + tok * 33 + (eidx[k] >> 9), 1, __ATOMIC_RELAXED, __HIP_MEMORY_SCOPE_WORKGROUP);
              v2u o; o.x = (unsigned)eidx[k]; o.y = __builtin_bit_cast(unsigned, gate[k]); tk[pos] = o; } }
        asm volatile("s_waitcnt vmcnt(0)" ::: "memory");
        __syncthreads();
    }
}

__device__ __forceinline__ float gelu_erf(float v) { return 0.5f * v * (1.0f + erff(v * 0.70710678118654752f)); }
typedef float f32x2v __attribute__((ext_vector_type(2)));
#define P8_LOAD8(RB, G) P8_LOAD8X(RB, G, e0.x, e1.x)
#define P8_LOAD8X(RB, G, EX0, EX1) do { if ((G) < 32) { const unsigned char* _tab = ((G) < 16) ? EU : EV; _Pragma("unroll") for (int _j = 0; _j < 8; ++_j) { const int _k = 8 * ((G) & 15) + _j; const unsigned _s = (_k < 64) ? (EX0) : (EX1); \
        const unsigned _ei = (unsigned)__builtin_amdgcn_readlane((int)_s, _k & 63); RB[_j] = *(const v2u*)(_tab + (size_t)_ei * (DM / 2) + 8 * lane); } } } while (0)
__device__ __forceinline__ float gelu_as(float v) {
    const float av = fabsf(v), t = __builtin_amdgcn_rcpf(av * 0.2316418882f + 1.0f);
    float q = t * 0.5307027145f + (-0.7265760135f); q = q * t + 0.7107068705f; q = q * t + (-0.142248368f); q = q * t + 0.127414796f; q = q * t;
    const float m = v * (q * __builtin_amdgcn_exp2f((v * v) * (-0.72134752044f)));
    return v < 0.f ? m : v - m;
}
__device__ __forceinline__ float reduce8_butterfly(const float (&d)[8], int lane) {
    const bool b5 = (lane & 32) != 0, b4 = (lane & 16) != 0, b3 = (lane & 8) != 0;
    float k4[4];
#pragma unroll
    for (int i = 0; i < 4; ++i) { const float snd = b5 ? d[i] : d[i + 4], kp = b5 ? d[i + 4] : d[i]; k4[i] = kp + __shfl_xor(snd, 32); }
    float k2[2];
#pragma unroll
    for (int i = 0; i < 2; ++i) { const float snd = b4 ? k4[i] : k4[i + 2], kp = b4 ? k4[i + 2] : k4[i]; k2[i] = kp + __shfl_xor(snd, 16); }
    float k1; { const float snd = b3 ? k2[0] : k2[1], kp = b3 ? k2[1] : k2[0]; k1 = kp + __shfl_xor(snd, 8); }
    k1 += __shfl_xor(k1, 4); k1 += __shfl_xor(k1, 2); k1 += __shfl_xor(k1, 1);
    return k1;
}
#define P8_UDOT(UB, G) do { _Pragma("unroll") for (int _j = 0; _j < 8; ++_j) { \
            int _sh = __builtin_amdgcn_sdot8((int)UB[_j][0], (int)xh0, 0, false); _sh = __builtin_amdgcn_sdot8((int)UB[_j][1], (int)xh1, _sh, false); \
            int _sl = __builtin_amdgcn_sdot8((int)UB[_j][0], (int)xl0, 0, false); _sl = __builtin_amdgcn_sdot8((int)UB[_j][1], (int)xl1, _sl, false); const int _s = (_sh << 4) + _sl; \
            red[(8 * ((G) & 7) + _j) * 65 + lane] = (float)_s; } \
        if (((G) & 7) == 7) { float _t0 = 0.f, _t1 = 0.f, _t2 = 0.f, _t3 = 0.f; _Pragma("unroll") for (int _i = 0; _i < 64; _i += 4) { _t0 += red[lane * 65 + _i]; _t1 += red[lane * 65 + _i + 1]; _t2 += red[lane * 65 + _i + 2]; _t3 += red[lane * 65 + _i + 3]; } \
            const float _dl = (_t0 + _t1) + (_t2 + _t3); const bool _c1 = (G) >= 8; const float _gl = __uint_as_float(_c1 ? e1.y : e0.y), _su = __uint_as_float(_c1 ? s1x : s0x); \
            const float _cv = _gl * gelu_as((_dl + hsx) * _su * rsx) * 0.25f; if (_c1) c1 = _cv; else c0 = _cv; } } while (0)
#define P8_FP4ACC(w, sel, i0) { const f32x2v _f = __builtin_amdgcn_cvt_scalef32_pk_f32_fp4((w), 1.0f, sel); acc[i0] += _c * _f[0]; acc[(i0) + 1] += _c * _f[1]; }
#define P8_VACC(VB, G) do { const int _g = (G) - 16; const float _csrc = (_g < 8) ? c0 : c1; _Pragma("unroll") for (int _j = 0; _j < 8; ++_j) { \
            asm volatile("" : "+v"(VB[_j][0]), "+v"(VB[_j][1]) : "v"(acc[0]), "v"(acc[5]), "v"(acc[10]), "v"(acc[15])); \
            const float _c = __uint_as_float((unsigned)__builtin_amdgcn_readlane((int)__float_as_uint(_csrc), 8 * (_g & 7) + _j)); \
            P8_FP4ACC(VB[_j][0], 0, 0) P8_FP4ACC(VB[_j][0], 1, 2) P8_FP4ACC(VB[_j][0], 2, 4) P8_FP4ACC(VB[_j][0], 3, 6) P8_FP4ACC(VB[_j][1], 0, 8) P8_FP4ACC(VB[_j][1], 1, 10) P8_FP4ACC(VB[_j][1], 2, 12) P8_FP4ACC(VB[_j][1], 3, 14) } } while (0)
typedef int v8i __attribute__((ext_vector_type(8)));
#define P8_CLOAD_V(RB, PC, H) do { _Pragma("unroll") for (int _r = 0; _r < 8; ++_r) RB[_r] = *(const v4u*)(EV + (size_t)vofv[H][_r] + 128 * (PC)); } while (0)
#define P8_SLAB(RB, PC, H, FIRST) do { \
        _Pragma("unroll") for (int _r = 0; _r < 8; ++_r) { v4u _w = RB[_r]; if (_r >= 4) { const unsigned _t0 = _w[0], _t1 = _w[1]; _w[0] = _w[2]; _w[1] = _w[3]; _w[2] = _t0; _w[3] = _t1; } \
            *(LAS v4u*)(SLB + ((_r & 1) ? wa1 : wa0) + 1024 * _r) = _w; } \
        _Pragma("unroll") for (int _i = 0; _i < 16; ++_i) { const int _cb = 4 * (_i & 3) + (_i >> 2); const int _ta = (tb ^ (16 * (_cb >> 1))) ^ (8 * (_cb & 1)); \
            const v2i_t _t0 = __builtin_amdgcn_ds_read_tr4_b64_v2i32((LAS v2i_t*)(SLB + _ta)); const v2i_t _t1 = __builtin_amdgcn_ds_read_tr4_b64_v2i32((LAS v2i_t*)(SLB + _ta + 2048)); \
            v8i _b, _a; _b[0] = _t0[0]; _b[1] = _t0[1]; _b[2] = _t1[0]; _b[3] = _t1[1]; _b[4] = 0; _b[5] = 0; _b[6] = 0; _b[7] = 0; \
            const bool _keep = (ln >> 2) == (_cb & 3); _a[0] = _keep ? (int)ah[H][0] : 0; _a[1] = _keep ? (int)ah[H][1] : 0; _a[2] = _keep ? (int)ah[H][2] : 0; _a[3] = _keep ? (int)ah[H][3] : 0; _a[4] = 0; _a[5] = 0; _a[6] = 0; _a[7] = 0; \
            if ((FIRST) && (_cb & 3) == 0) { const f32x4 _z = {0.f, 0.f, 0.f, 0.f}; vacc[_cb >> 2] = _z; } \
            vacc[_cb >> 2] = __builtin_amdgcn_mfma_scale_f32_16x16x128_f8f6f4(_a, _b, vacc[_cb >> 2], 0, 4, 0, 0, 0, 0); } } while (0)
#define P8_VOUT(PC) do { _Pragma("unroll") for (int _a = 0; _a < 4; ++_a) OT[oto + 64 * (PC) + 16 * _a] = vacc[_a][0] + vacc[_a][1]; } while (0)
typedef int v2i_t __attribute__((ext_vector_type(2)));
__device__ __forceinline__ void p8_gather(Frame& F) {
    const int lane = F.lane; const int gw = F.vcu * NWAVES + F.wave, NGW = F.G * NWAVES;
    const unsigned char* EU = F.ws + WS_EU; const unsigned char* EV = F.ws + WS_EV; const bf16* H1B = WSP(bf16, WS_H1B);
    const unsigned long long* tkb = (const unsigned long long*)WSP(unsigned, WS_TK);
    unsigned long long nt0 = tkb[(size_t)(gw * 8) * 128 + lane], nt1 = tkb[(size_t)(gw * 8) * 128 + 64 + lane];
    v2u nx[4];
#pragma unroll
    for (int j = 0; j < 4; ++j) nx[j] = *(const v2u*)(H1B + (size_t)(gw * 8) * DM + 256 * j + 4 * lane);
    float nrs = WSP(float, WS_RS2)[gw * 8];
    const float* esc = WSP(float, WS_ESC);
    LAS float* red = (LAS float*)(F.lds + F.wave * 16640);
    LAS unsigned char* WL = F.lds + F.wave * 16640;
    LAS unsigned char* CTB = WL; LAS float* OT = (LAS float*)(WL + 1024); LAS unsigned char* SLB = WL + 8192;
    const int lq = lane >> 4, ln = lane & 15;
    const int cta = ((ln & 3) < 2 ? 128 * (ln & 3) : 256) + 16 * lq;
    const int wa0 = 128 * (lane >> 3) + 16 * ((lane & 7) ^ (lane >> 4)), wa1 = 128 * (lane >> 3) + 16 * ((lane & 7) ^ (4 + (lane >> 4)));
    const int tb = (32 * (lq & 1) + ln) * 128 + 16 * ((ln >> 1) & 7) + 8 * (lq & 1);
    const int oto = 256 * (ln >> 2) + 4 * lq + (ln & 3);
    f32x4 vacc[4];
    __syncthreads();
    float ns0x = esc[(unsigned)nt0], ns1x = esc[(unsigned)nt1];
    v2u b0[8], b1[8], b2[8];
    P8_LOAD8X(b0, 0, (unsigned)nt0, (unsigned)nt1); P8_LOAD8X(b1, 1, (unsigned)nt0, (unsigned)nt1);
    for (int tok = gw * 8; tok < gw * 8 + 8; ++tok) {
        float xf[16];
#pragma unroll
        for (int j = 0; j < 4; ++j) { const v2u xr = nx[j];
            xf[4 * j] = bf2f(xr[0] & 0xffffu); xf[4 * j + 1] = __uint_as_float(xr[0] & 0xffff0000u); xf[4 * j + 2] = bf2f(xr[1] & 0xffffu); xf[4 * j + 3] = __uint_as_float(xr[1] & 0xffff0000u); }
        v2u e0, e1; e0.x = (unsigned)nt0; e0.y = (unsigned)(nt0 >> 32); e1.x = (unsigned)nt1; e1.y = (unsigned)(nt1 >> 32);
        const unsigned s0x = __float_as_uint(ns0x), s1x = __float_as_uint(ns1x);
        float amax = 0.f;
#pragma unroll
        for (int i = 0; i < 16; ++i) amax = fmaxf(amax, fabsf(xf[i]));
        amax = wave_max(amax); const float sx = amax > 0.f ? 119.0f * __builtin_amdgcn_rcpf(amax) : 1.0f;
        int sxl = 0; unsigned xh0 = 0u, xh1 = 0u, xl0 = 0u, xl1 = 0u;
#pragma unroll
        for (int i = 0; i < 16; ++i) { const int q = (int)rintf(xf[i] * sx); sxl += q; const int l = ((q + 8) & 15) - 8, h = (q - l) >> 4;
            if (i < 8) { xl0 |= ((unsigned)l & 15u) << (4 * i); xh0 |= ((unsigned)h & 15u) << (4 * i); } else { xl1 |= ((unsigned)l & 15u) << (4 * (i - 8)); xh1 |= ((unsigned)h & 15u) << (4 * (i - 8)); } }
        const float hsx = 0.5f * wave_sum((float)sxl);
        const float rsx = nrs * __builtin_amdgcn_rcpf(sx);
        float c0 = 0.f, c1 = 0.f;
        P8_LOAD8(b2, 2); P8_UDOT(b0, 0);
        P8_LOAD8(b0, 3); P8_UDOT(b1, 1);
        P8_LOAD8(b1, 4); P8_UDOT(b2, 2);
        P8_LOAD8(b2, 5); P8_UDOT(b0, 3);
        P8_LOAD8(b0, 6); P8_UDOT(b1, 4);
        P8_LOAD8(b1, 7); P8_UDOT(b2, 5);
        P8_LOAD8(b2, 8); P8_UDOT(b0, 6);
        P8_LOAD8(b0, 9); P8_UDOT(b1, 7);
        P8_LOAD8(b1, 10); P8_UDOT(b2, 8);
        P8_LOAD8(b2, 11); P8_UDOT(b0, 9);
        P8_LOAD8(b0, 12); P8_UDOT(b1, 10);
        P8_LOAD8(b1, 13); P8_UDOT(b2, 11);
        P8_LOAD8(b2, 14); P8_UDOT(b0, 12);
        P8_LOAD8(b0, 15); P8_UDOT(b1, 13);
        unsigned vofv[2][8];
#pragma unroll
        for (int h = 0; h < 2; ++h)
#pragma unroll
            for (int r = 0; r < 8; ++r) vofv[h][r] = (unsigned)__builtin_amdgcn_ds_bpermute(4 * (8 * r + (lane >> 3)), (int)(h ? e1.x : e0.x)) * 512u + 16u * (lane & 7);
        v4u sa[8], sb[8];
        P8_CLOAD_V(sa, 0, 0);
        P8_UDOT(b2, 14);
        P8_CLOAD_V(sb, 0, 1);
        P8_UDOT(b0, 15);
        asm volatile("" ::: "memory");
        const int tokn = tok + 1 < gw * 8 + 8 ? tok + 1 : tok;
        nt0 = tkb[(size_t)tokn * 128 + lane]; nt1 = tkb[(size_t)tokn * 128 + 64 + lane];
#pragma unroll
        for (int j = 0; j < 4; ++j) nx[j] = *(const v2u*)(H1B + (size_t)tokn * DM + 256 * j + 4 * lane);
        nrs = WSP(float, WS_RS2)[tokn];
        const float cmax = wave_max(fmaxf(fabsf(c0), fabsf(c1))); const float sc = cmax > 0.f ? 256.0f * __builtin_amdgcn_rcpf(cmax) : 1.0f, rsc = __builtin_amdgcn_rcpf(sc);
        { const float a0 = c0 * sc, a1 = c1 * sc; const int h = __builtin_amdgcn_cvt_pk_fp8_f32(a0, a1, 0, false);
          const f32x2v rb = __builtin_amdgcn_cvt_pk_f32_fp8(h, false); const int l = __builtin_amdgcn_cvt_pk_fp8_f32(a0 - rb[0], a1 - rb[1], 0, false);
          CTB[lane] = (unsigned char)(h & 0xff); CTB[64 + lane] = (unsigned char)((h >> 8) & 0xff); CTB[128 + lane] = (unsigned char)(l & 0xff); CTB[192 + lane] = (unsigned char)((l >> 8) & 0xff);
          if (lane < 8) { v4u z; z[0] = 0u; z[1] = 0u; z[2] = 0u; z[3] = 0u; *(LAS v4u*)(CTB + 256 + 16 * lane) = z; } }
        v4u ah[2];
#pragma unroll
        for (int h = 0; h < 2; ++h) ah[h] = *(const LAS v4u*)(CTB + cta + 64 * h);
        P8_SLAB(sa, 0, 0, true);  P8_CLOAD_V(sa, 1, 0);
        P8_SLAB(sb, 0, 1, false); P8_CLOAD_V(sb, 1, 1);  P8_VOUT(0);
        P8_SLAB(sa, 1, 0, true);  P8_CLOAD_V(sa, 2, 0);
        P8_SLAB(sb, 1, 1, false); P8_CLOAD_V(sb, 2, 1);  P8_VOUT(1);
        P8_SLAB(sa, 2, 0, true);  P8_CLOAD_V(sa, 3, 0);
        P8_SLAB(sb, 2, 1, false); P8_CLOAD_V(sb, 3, 1);  P8_VOUT(2);
        ns0x = esc[(unsigned)nt0]; ns1x = esc[(unsigned)nt1];
        v2u hr[4];
#pragma unroll
        for (int j = 0; j < 4; ++j) hr[j] = *(const v2u*)(H1B + (size_t)tok * DM + 256 * j + 4 * lane);
        P8_LOAD8X(b2, 0, (unsigned)nt0, (unsigned)nt1);
        P8_SLAB(sa, 3, 0, true);
        P8_LOAD8X(b0, 1, (unsigned)nt0, (unsigned)nt1);
        P8_SLAB(sb, 3, 1, false); P8_VOUT(3);
        float acc[16];
#pragma unroll
        for (int j = 0; j < 4; ++j) { const f32x4 t = *(const LAS f32x4*)(OT + 256 * j + 4 * lane); acc[4 * j] = t[0] * rsc; acc[4 * j + 1] = t[1] * rsc; acc[4 * j + 2] = t[2] * rsc; acc[4 * j + 3] = t[3] * rsc; }
        f32x4* orow = (f32x4*)(F.out + (size_t)tok * DM) + lane; f32x4 hv[4]; float s2 = 0.f;
        f32x4 gv[4];
#pragma unroll
        for (int j = 0; j < 4; ++j) gv[j] = ((const f32x4*)F.g_fin)[lane + 64 * j];
#pragma unroll
        for (int j = 0; j < 4; ++j) {
            { const v2u xr = hr[j];
              hv[j][0] = bf2f(xr[0] & 0xffffu); hv[j][1] = __uint_as_float(xr[0] & 0xffff0000u); hv[j][2] = bf2f(xr[1] & 0xffffu); hv[j][3] = __uint_as_float(xr[1] & 0xffff0000u); }
#pragma unroll
            for (int i = 0; i < 4; ++i) { hv[j][i] += acc[4 * j + i]; s2 += hv[j][i] * hv[j][i]; } }
        s2 = wave_sum(s2); const float rstd3 = __builtin_amdgcn_rsqf(s2 * (1.0f / DM) + EPS);
#pragma unroll
        for (int j = 0; j < 4; ++j) { const f32x4 ov = hv[j] * rstd3 * gv[j];
            asm volatile("s_nop 4\n\tglobal_store_dwordx4 %0, %1, off sc1\n\ts_nop 2" :: "v"(orow + 64 * j), "v"(ov) : "memory"); }
#pragma unroll
        for (int j = 0; j < 8; ++j) { const v2u t = b0[j]; b0[j] = b2[j]; b1[j] = t; }
        asm volatile("" ::: "memory");
    }
}

constexpr int CW_BAR = 4096;
static_assert((CW_BAR + XCD_BAR_WORDS) * 4 <= (int)CTL_ZERO_BYTES, "barrier words inside the zeroed region");

__global__ void __launch_bounds__(NTHR, 2) hybrid_fwd(Params prm) {
    extern __shared__ __attribute__((aligned(16))) unsigned char lds_raw[];
    Frame F;
    F.lds = (LAS unsigned char*)lds_raw;
    F.tid = threadIdx.x; F.lane = F.tid & 63; F.wave = __builtin_amdgcn_readfirstlane(F.tid >> 6);
    F.G = gridDim.x; { const int bx = blockIdx.x; F.vcu = (F.G % 8 == 0) ? (bx % 8) * (F.G / 8) + bx / 8 : bx; }
    F.x = prm.in[0]; F.meta = prm.in[1]; F.g_mix = prm.in[2]; F.w_in = prm.in[3]; F.conv_w = prm.in[4]; F.conv_b = prm.in[5]; F.w_qm = prm.in[6]; F.w_km = prm.in[7];
    F.b_i = prm.in[8]; F.b_f = prm.in[9]; F.skip = prm.in[10]; F.gn_g = prm.in[11]; F.sb_g = prm.in[12]; F.w_out = prm.in[13]; F.g_ffn = prm.in[14]; F.w_query = prm.in[15];
    F.sub_keys = prm.in[16]; F.eu = prm.in[17]; F.ev = prm.in[18]; F.g_fin = prm.in[19]; F.out = prm.out; F.ws = prm.ws;
    volatile LAS unsigned* MISC = (volatile LAS unsigned*)(F.lds + LDSCTL_OFF);
    if (F.tid < 64) MISC[F.tid] = 0u;
    __syncthreads();
    XcdBarrier bar = xcd_barrier_post((unsigned*)(F.ws + WS_CTL) + CW_BAR, MISC + 8);

    p0_prologue(F);
    xcd_barrier_w(bar, [&]() { if (F.wave >= 1) expert_rows_in_barrier(F, 0); });
    {
        pg8::Gemm g{WSP(bf16, WS_XB), WSP(bf16, WS_WINT), MROWS, NPROJ, DM, DM, DM}; pg8::StaticOrder S; S.init(MROWS, NPROJ, F.G, (int)blockIdx.x);
        pg8::EpiRowScaleBf16<0> E{WSP(bf16, WS_PR), NPROJ, WSP(float, WS_RSTD1), EPS};
        pg8::gemm_phase<pg8::EpiRowScaleBf16<0>, pg8::StaticOrder, PG8_ALIGN, PG8_SP2>(F.lds, g, S, E);
        p1_meta_tail(F);
    }
    xcd_barrier_w(bar, [&]() { if (F.wave >= 1) expert_rows_in_barrier(F, 1); });
    p2_mlstm_local(F);
    p2_sb_attention(F);
    xcd_barrier_w(bar, [&]() { if (F.wave >= 1) expert_rows_in_barrier(F, 2); });
    p3_scan(F);
    xcd_barrier_w(bar, [&]() { if (F.wave >= 1) expert_rows_in_barrier(F, 3); });
    p4_mlstm_out(F);
    xcd_barrier_w(bar, [&]() { if (F.wave >= 1) expert_rows_in_barrier(F, 4); });
    {
        pg8::Gemm g{WSP(bf16, WS_PR) + CO_, WSP(bf16, WS_WOUTT), MROWS, DM, DM, NPROJ, DM}; pg8::StaticOrder S; S.init(MROWS, DM, F.G, (int)blockIdx.x);
        pg8::EpiResidual E{F.x, F.out, WSP(bf16, WS_H1B), WSP(float, WS_SSQ), DM};
        pg8::gemm_phase<pg8::EpiResidual, pg8::StaticOrder, PG8_ALIGN, PG8_SP2>(F.lds, g, S, E);
    }
    xcd_barrier_w(bar, [&]() { if (F.wave >= 1) expert_rows_in_barrier(F, 5); });
    {
        pg8::Gemm g{WSP(bf16, WS_H1B), WSP(bf16, WS_WQT), MROWS, 2048, DM, DM, DM}; pg8::StaticOrder S; S.init(MROWS, 2048, F.G, (int)blockIdx.x);
        pg8::EpiRowScaleBf16<1> E{WSP(bf16, WS_QP), 2048, WSP(float, WS_SSQ), EPS};
        pg8::gemm_phase<pg8::EpiRowScaleBf16<1>, pg8::StaticOrder, PG8_ALIGN, PG8_SP2>(F.lds, g, S, E);
    }
    xcd_barrier_w(bar, [&]() { if (F.wave >= 1) p7_stage_sk(F); });
    p7_topk(F);
    p8_gather(F);
}

extern "C" void kernel_launch(void* const* d_in, const int* in_sizes, int n_in, void* d_out, int out_size, void* d_ws, size_t ws_size, hipStream_t stream) {
    static int grid = 0;
    if (grid == 0) {
        if (n_in != 20 || in_sizes[0] != MROWS * DM || out_size != MROWS * DM || ws_size < WS_END) {
            fprintf(stderr, "kernel_launch: unexpected shapes (n_in %d, in0 %d, out %d, ws %zu < %zu); nothing launched\n", n_in, n_in > 0 ? in_sizes[0] : -1, out_size, ws_size, (size_t)WS_END); grid = -1; return; }
        int dev = 0, cus = 0, per_cu = 0;
        if (hipGetDevice(&dev) != hipSuccess || hipDeviceGetAttribute(&cus, hipDeviceAttributeMultiprocessorCount, dev) != hipSuccess) { fprintf(stderr, "kernel_launch: device query failed\n"); grid = -1; return; }
        if (hipFuncSetAttribute((const void*)hybrid_fwd, hipFuncAttributeMaxDynamicSharedMemorySize, LDS_BYTES) != hipSuccess) { fprintf(stderr, "kernel_launch: hipFuncSetAttribute failed\n"); grid = -1; return; }
        if (hipOccupancyMaxActiveBlocksPerMultiprocessor(&per_cu, (const void*)hybrid_fwd, NTHR, LDS_BYTES) != hipSuccess || per_cu < 1) { fprintf(stderr, "kernel_launch: occupancy query says %d blocks/CU\n", per_cu); (void)hipGetLastError(); grid = -1; return; }
        grid = cus;
        if (grid != 256) { fprintf(stderr, "kernel_launch: this kernel is built for a 256-CU device (got %d)\n", grid); grid = -1; return; }
    }
    if (grid < 0) return;
    if (hipMemsetAsync((char*)d_ws + WS_CTL, 0, CTL_ZERO_BYTES, stream) != hipSuccess) { fprintf(stderr, "kernel_launch: memset failed\n"); return; }
    Params p{};
    for (int i = 0; i < 20; ++i) p.in[i] = (const float*)d_in[i];
    p.out = (float*)d_out; p.ws = (unsigned char*)d_ws;
    void* args[] = {&p};
    const hipError_t e = hipLaunchCooperativeKernel((const void*)hybrid_fwd, dim3(grid), dim3(NTHR), args, LDS_BYTES, stream);
    if (e != hipSuccess) fprintf(stderr, "kernel_launch: cooperative launch failed: %s\n", hipGetErrorString(e));
}
```
